# Optimizing an MI355X kernel written in HIP

```python
import jax, jax.numpy as jnp
from jax import lax
import numpy as np

D_MODEL = 1024
BATCH = 2
SEQ = 16384
DEPTH = 2
DEC_BATCH = 8
DEC_SEQ = 32
PAST_LEN = 1024

CHUNK = 64
Q_BLOCK = 128
N_EVEN = (DEPTH + 1) // 2
N_ODD = DEPTH // 2
FOX_HEADS = 8
FOX_DH = 64
FOX_W = FOX_HEADS * FOX_DH
FOX_FORGET_BIAS = 4.0
GDN_HEADS = 4
GDN_DK = 128
GDN_DV = 128
GDN_QK = GDN_HEADS * GDN_DK
GDN_VW = GDN_HEADS * GDN_DV
GDN_CONV_DIM = 2 * GDN_QK + GDN_VW
CONV_W = 4
S5_WIDTH = D_MODEL
S5_GROUP = 16
S5_GROUPS = S5_WIDTH // S5_GROUP
S5_STATE = 64
D_FF = ((8 * D_MODEL // 3 + 127) // 128) * 128
ALPHA = (2.0 * DEPTH) ** 0.25
BETA_INIT = (8.0 * DEPTH) ** -0.25
LN_EPS = 1e-5
NORM_EPS = 1e-6
EVEN_SPLITS = (FOX_W, FOX_W, FOX_W, FOX_HEADS, GDN_CONV_DIM, GDN_HEADS, GDN_HEADS, GDN_VW)
EVEN_IN = sum(EVEN_SPLITS)
MIX_W = FOX_W + GDN_VW
F32 = jnp.float32

kernel_name = 'hybrid_fox_gdn_s5_stream_step'


def layer_norm(x, g, b):
    xf = x.astype(F32)
    mu = jnp.mean(xf, -1, keepdims=True)
    var = jnp.mean(jnp.square(xf - mu), -1, keepdims=True)
    return ((xf - mu) * lax.rsqrt(var + LN_EPS) * g.astype(F32) + b.astype(F32)).astype(x.dtype)


def swiglu(x, w_in, w_out):
    a, b = jnp.split(x @ w_in, 2, axis=-1)
    return (jax.nn.silu(a) * b) @ w_out


def macaron_half(x, w_in, w_out, g, b):
    return layer_norm(ALPHA * x + 0.5 * swiglu(x, w_in, w_out), g, b)


def split_cols(y, sizes):
    return jnp.split(y, np.cumsum(sizes)[:-1].tolist(), axis=-1)


def l2norm(x):
    return x * lax.rsqrt(jnp.sum(jnp.square(x), -1, keepdims=True) + NORM_EPS)


def fox_prompt(q, k, v, logf):
    B, T, H, dh = q.shape
    nblk = T // Q_BLOCK
    c = jnp.cumsum(logf, axis=1).transpose(0, 2, 1)
    qb = q.reshape(B, nblk, Q_BLOCK, H, dh).transpose(1, 0, 2, 3, 4)
    cb = c.reshape(B, H, nblk, Q_BLOCK).transpose(2, 0, 1, 3)
    kpos = jnp.arange(T)

    def block(args):
        i, q_i, c_i = args
        s = jnp.einsum('bqhd,bkhd->bhqk', q_i, k, preferred_element_type=F32) * (dh ** -0.5)
        s = s + c_i[..., :, None] - c[..., None, :]
        mask = kpos[None, :] <= (i * Q_BLOCK + jnp.arange(Q_BLOCK))[:, None]
        p = jax.nn.softmax(jnp.where(mask, s, -jnp.inf), axis=-1)
        return jnp.einsum('bhqk,bkhd->bqhd', p.astype(v.dtype), v)

    o = lax.map(block, (jnp.arange(nblk), qb, cb))
    return o.transpose(1, 0, 2, 3, 4).reshape(B, T, H, dh)


def fox_sample(q, k, v, logf, past_k, past_v, past_logf):
    T = q.shape[1]
    P = past_k.shape[1]
    kk = jnp.concatenate([past_k.astype(k.dtype), k], 1)
    vv = jnp.concatenate([past_v.astype(v.dtype), v], 1)
    c = jnp.cumsum(jnp.concatenate([past_logf.astype(F32), logf], 1), axis=1).transpose(0, 2, 1)
    s = jnp.einsum('bqhd,bkhd->bhqk', q, kk, preferred_element_type=F32) * (FOX_DH ** -0.5)
    s = s + c[..., P:, None] - c[..., None, :]
    mask = jnp.arange(P + T)[None, :] <= (P + jnp.arange(T))[:, None]
    p = jax.nn.softmax(jnp.where(mask, s, -jnp.inf), axis=-1)
    return jnp.einsum('bhqk,bkhd->bqhd', p.astype(vv.dtype), vv)


def causal_conv(x, buf, w):
    xp = jnp.concatenate([buf.astype(x.dtype), x], 1)
    y = lax.conv_general_dilated(xp, w[:, None, :].astype(x.dtype), window_strides=(1,), padding='VALID',
                                 dimension_numbers=('NWC', 'WIO', 'NWC'), feature_group_count=x.shape[-1])
    return y, xp[:, -(CONV_W - 1):]


def gdn_chunked(q, k, v, g, beta, s0, L):
    B, T, H, _ = q.shape
    dv = v.shape[-1]
    n = T // L

    def chunks(x):
        return jnp.moveaxis(x.reshape((B, n, L, H) + x.shape[3:]), 3, 2)

    qc, kc, vc, gc, bc = chunks(q), chunks(k), chunks(v), chunks(g), chunks(beta)
    gcum = jnp.cumsum(gc, -1)
    diff = gcum[..., :, None] - gcum[..., None, :]
    tril = jnp.tril(jnp.ones((L, L), bool))
    strict = jnp.tril(jnp.ones((L, L), bool), -1)
    decay = jnp.where(tril, jnp.exp(jnp.where(tril, diff, 0.0)), 0.0)
    kb = kc * bc[..., None]
    nmat = jnp.where(strict, jnp.einsum('bnhid,bnhjd->bnhij', kb, kc) * decay, 0.0)
    eye = jnp.eye(L, dtype=F32)
    tmat = lax.linalg.triangular_solve(nmat, jnp.broadcast_to(eye, nmat.shape), left_side=True,
                                       lower=True, unit_diagonal=True)
    u = tmat @ (vc * bc[..., None])
    w = tmat @ (kb * jnp.exp(gcum)[..., None])
    attn = jnp.einsum('bnhid,bnhjd->bnhij', qc, kc) * decay
    qg = qc * jnp.exp(gcum)[..., None]
    kdec = kc * jnp.exp(gcum[..., -1:] - gcum)[..., None]
    glast = jnp.exp(gcum[..., -1])

    def step(s, inp):
        u_i, w_i, a_i, qg_i, kd_i, gl_i = inp
        v_new = u_i - w_i @ s
        o_i = qg_i @ s + a_i @ v_new
        s = s * gl_i[..., None, None] + jnp.swapaxes(kd_i, -1, -2) @ v_new
        return s, o_i

    xs = tuple(jnp.moveaxis(t, 1, 0) for t in (u, w, attn, qg, kdec, glast))
    s_fin, o = lax.scan(step, s0, xs)
    return o.transpose(1, 0, 3, 2, 4).reshape(B, T, H, dv), s_fin


def even_mixer(h, fox_past, gdn_s0, gdn_buf, w_in, b_f, conv_w, a_log, dt_bias, norm_g, w_out):
    Bt, T, _ = h.shape
    fq, fk, fv, ff, gqkv, ga, gb, gz = split_cols(h @ w_in, EVEN_SPLITS)
    fq = fq.reshape(Bt, T, FOX_HEADS, FOX_DH)
    fk = fk.reshape(Bt, T, FOX_HEADS, FOX_DH)
    fv = fv.reshape(Bt, T, FOX_HEADS, FOX_DH)
    logf = jax.nn.log_sigmoid((ff + b_f).astype(F32))
    if fox_past is None:
        o_fox = fox_prompt(fq, fk, fv, logf)
    else:
        o_fox = fox_sample(fq, fk, fv, logf, *fox_past)
    conv_out, new_buf = causal_conv(gqkv, gdn_buf, conv_w)
    gq, gk, gv = split_cols(jax.nn.silu(conv_out.astype(F32)), (GDN_QK, GDN_QK, GDN_VW))
    gq = l2norm(gq.reshape(Bt, T, GDN_HEADS, GDN_DK)) * (GDN_DK ** -0.5)
    gk = l2norm(gk.reshape(Bt, T, GDN_HEADS, GDN_DK))
    gv = gv.reshape(Bt, T, GDN_HEADS, GDN_DV)
    g = -jnp.exp(a_log.astype(F32)) * jax.nn.softplus(ga.astype(F32) + dt_bias.astype(F32))
    beta = jax.nn.sigmoid(gb.astype(F32))
    o_gdn, s_new = gdn_chunked(gq, gk, gv, g, beta, gdn_s0.astype(F32), min(T, CHUNK))
    z = gz.reshape(Bt, T, GDN_HEADS, GDN_DV).astype(F32)
    o_gdn = o_gdn * lax.rsqrt(jnp.mean(jnp.square(o_gdn), -1, keepdims=True) + NORM_EPS) * norm_g.astype(F32) * jax.nn.silu(z)
    mixed = jnp.concatenate([o_fox.reshape(Bt, T, FOX_W).astype(h.dtype),
                             o_gdn.reshape(Bt, T, GDN_VW).astype(h.dtype)], -1)
    return mixed @ w_out, (fk, fv, logf, s_new, new_buf)


def s5_scan(u, h0_re, h0_im, lam_re, lam_im, log_step, b_re, b_im, c_re, c_im, d):
    Bt, T, _ = u.shape
    L = min(T, CHUNK)
    n = T // L
    lam = lax.complex(lam_re.astype(F32), lam_im.astype(F32))
    lam_bar = jnp.exp(lam * jnp.exp(log_step.astype(F32))[:, None])
    b_bar = ((lam_bar - 1.0) / lam)[..., None] * lax.complex(b_re.astype(F32), b_im.astype(F32))
    c_mat = lax.complex(c_re.astype(F32), c_im.astype(F32))
    uc = u.reshape(Bt, n, L, S5_GROUPS, S5_GROUP).transpose(1, 0, 2, 3, 4).astype(jnp.complex64)

    def combine(e1, e2):
        a1, b1 = e1
        a2, b2 = e2
        return a1 * a2, a2 * b1 + b2

    def step(hc, u_i):
        bu = jnp.einsum('gpc,blgc->blgp', b_bar, u_i)
        bu = bu.at[:, 0].add(lam_bar * hc)
        _, states = lax.associative_scan(combine, (jnp.broadcast_to(lam_bar, bu.shape), bu), axis=1)
        y = jnp.real(jnp.einsum('gcp,blgp->blgc', c_mat, states))
        return states[:, -1], y

    h_fin, ys = lax.scan(step, lax.complex(h0_re.astype(F32), h0_im.astype(F32)), uc)
    y = ys.transpose(1, 0, 2, 3, 4).reshape(Bt, T, S5_WIDTH) + d.astype(F32) * u
    return y, jnp.real(h_fin), jnp.imag(h_fin)


def odd_mixer(h, h0_re, h0_im, w_in, lam_re, lam_im, log_step, b_re, b_im, c_re, c_im, d, glu_w, glu_b, w_out):
    u = (h @ w_in).astype(F32)
    y, h_re, h_im = s5_scan(u, h0_re, h0_im, lam_re, lam_im, log_step, b_re, b_im, c_re, c_im, d)
    zz = jax.nn.gelu(y)
    gated = zz * jax.nn.sigmoid(zz @ glu_w.astype(F32) + glu_b.astype(F32))
    return gated.astype(h.dtype) @ w_out, (h_re, h_im)


def stack_field(states, idx):
    return jnp.stack([s[idx] for s in states])


def setup_inputs(seed: int = 0) -> dict:
    key = jax.random.key(seed)
    ks = iter(jax.random.split(key, 40))

    def nrm(shape, scale):
        return scale * jax.random.normal(next(ks), shape, F32)

    def unif(shape, lo, hi):
        return jax.random.uniform(next(ks), shape, F32, lo, hi)

    x_prompt = nrm((BATCH, SEQ, D_MODEL), 1.0)
    x_sample = nrm((DEC_BATCH, DEC_SEQ, D_MODEL), 1.0)
    cache_fox_k = nrm((N_EVEN, DEC_BATCH, PAST_LEN, FOX_HEADS, FOX_DH), 1.0)
    cache_fox_v = nrm((N_EVEN, DEC_BATCH, PAST_LEN, FOX_HEADS, FOX_DH), 1.0)
    cache_fox_logf = jax.nn.log_sigmoid(FOX_FORGET_BIAS + nrm((N_EVEN, DEC_BATCH, PAST_LEN, FOX_HEADS), 1.0))
    state_gdn = nrm((N_EVEN, DEC_BATCH, GDN_HEADS, GDN_DK, GDN_DV), 0.1)
    state_gdn_conv = nrm((N_EVEN, DEC_BATCH, CONV_W - 1, GDN_CONV_DIM), 1.0)
    state_s5_re = nrm((N_ODD, DEC_BATCH, S5_GROUPS, S5_STATE), 0.1)
    state_s5_im = nrm((N_ODD, DEC_BATCH, S5_GROUPS, S5_STATE), 0.1)
    ffn_w_in = nrm((DEPTH, 2, D_MODEL, 2 * D_FF), D_MODEL ** -0.5)
    ffn_w_out = nrm((DEPTH, 2, D_FF, D_MODEL), BETA_INIT * D_FF ** -0.5)
    ln_g = 1.0 + nrm((DEPTH, 3, D_MODEL), 0.02)
    ln_b = nrm((DEPTH, 3, D_MODEL), 0.02)
    even_w_in = nrm((N_EVEN, D_MODEL, EVEN_IN), D_MODEL ** -0.5)
    fox_b_f = FOX_FORGET_BIAS + nrm((N_EVEN, FOX_HEADS), 0.1)
    gdn_conv_w = nrm((N_EVEN, CONV_W, GDN_CONV_DIM), CONV_W ** -0.5)
    gdn_a_log = jnp.log(unif((N_EVEN, GDN_HEADS), 1.0, 16.0))
    dt = jnp.exp(unif((N_EVEN, GDN_HEADS), float(np.log(1e-3)), float(np.log(1e-1))))
    gdn_dt_bias = dt + jnp.log(-jnp.expm1(-dt))
    gdn_norm_g = 1.0 + nrm((N_EVEN, GDN_DV), 0.02)
    even_w_out = nrm((N_EVEN, MIX_W, D_MODEL), BETA_INIT * MIX_W ** -0.5)
    odd_w_in = nrm((N_ODD, D_MODEL, S5_WIDTH), D_MODEL ** -0.5)
    s5_lam_re = -0.5 + nrm((N_ODD, S5_GROUPS, S5_STATE), 0.01)
    s5_lam_im = float(np.pi) * jnp.arange(S5_STATE, dtype=F32) + nrm((N_ODD, S5_GROUPS, S5_STATE), 0.01)
    s5_log_step = unif((N_ODD, S5_GROUPS), float(np.log(1e-3)), float(np.log(1e-1)))
    s5_b_re = nrm((N_ODD, S5_GROUPS, S5_STATE, S5_GROUP), (2.0 * S5_GROUP) ** -0.5)
    s5_b_im = nrm((N_ODD, S5_GROUPS, S5_STATE, S5_GROUP), (2.0 * S5_GROUP) ** -0.5)
    s5_c_re = nrm((N_ODD, S5_GROUPS, S5_GROUP, S5_STATE), (2.0 * S5_STATE) ** -0.5)
    s5_c_im = nrm((N_ODD, S5_GROUPS, S5_GROUP, S5_STATE), (2.0 * S5_STATE) ** -0.5)
    s5_d = nrm((N_ODD, S5_WIDTH), 1.0)
    s5_glu_w = nrm((N_ODD, S5_WIDTH, S5_WIDTH), S5_WIDTH ** -0.5)
    s5_glu_b = nrm((N_ODD, S5_WIDTH), 0.02)
    odd_w_out = nrm((N_ODD, S5_WIDTH, D_MODEL), BETA_INIT * S5_WIDTH ** -0.5)
    return {'x_prompt': x_prompt, 'x_sample': x_sample, 'cache_fox_k': cache_fox_k, 'cache_fox_v': cache_fox_v,
            'cache_fox_logf': cache_fox_logf, 'state_gdn': state_gdn, 'state_gdn_conv': state_gdn_conv,
            'state_s5_re': state_s5_re, 'state_s5_im': state_s5_im, 'ffn_w_in': ffn_w_in, 'ffn_w_out': ffn_w_out,
            'ln_g': ln_g, 'ln_b': ln_b, 'even_w_in': even_w_in, 'fox_b_f': fox_b_f, 'gdn_conv_w': gdn_conv_w,
            'gdn_a_log': gdn_a_log, 'gdn_dt_bias': gdn_dt_bias, 'gdn_norm_g': gdn_norm_g, 'even_w_out': even_w_out,
            'odd_w_in': odd_w_in, 's5_lam_re': s5_lam_re, 's5_lam_im': s5_lam_im, 's5_log_step': s5_log_step,
            's5_b_re': s5_b_re, 's5_b_im': s5_b_im, 's5_c_re': s5_c_re, 's5_c_im': s5_c_im, 's5_d': s5_d,
            's5_glu_w': s5_glu_w, 's5_glu_b': s5_glu_b, 'odd_w_out': odd_w_out}


def reference(x_prompt, x_sample, cache_fox_k, cache_fox_v, cache_fox_logf, state_gdn, state_gdn_conv,
              state_s5_re, state_s5_im, ffn_w_in, ffn_w_out, ln_g, ln_b, even_w_in, fox_b_f, gdn_conv_w,
              gdn_a_log, gdn_dt_bias, gdn_norm_g, even_w_out, odd_w_in, s5_lam_re, s5_lam_im, s5_log_step,
              s5_b_re, s5_b_im, s5_c_re, s5_c_im, s5_d, s5_glu_w, s5_glu_b, odd_w_out):
    xp, xs = x_prompt, x_sample
    bp = xp.shape[0]
    even_p, even_s, odd_p, odd_s = [], [], [], []
    for layer in range(DEPTH):
        xp = macaron_half(xp, ffn_w_in[layer, 0], ffn_w_out[layer, 0], ln_g[layer, 0], ln_b[layer, 0])
        xs = macaron_half(xs, ffn_w_in[layer, 0], ffn_w_out[layer, 0], ln_g[layer, 0], ln_b[layer, 0])
        j = layer // 2
        if layer % 2 == 0:
            ew = (even_w_in[j], fox_b_f[j], gdn_conv_w[j], gdn_a_log[j], gdn_dt_bias[j], gdn_norm_g[j], even_w_out[j])
            s0 = jnp.zeros((bp, GDN_HEADS, GDN_DK, GDN_DV), F32)
            buf0 = jnp.zeros((bp, CONV_W - 1, GDN_CONV_DIM), xp.dtype)
            mp, st_p = even_mixer(xp, None, s0, buf0, *ew)
            ms, st_s = even_mixer(xs, (cache_fox_k[j], cache_fox_v[j], cache_fox_logf[j]),
                                  state_gdn[j], state_gdn_conv[j], *ew)
            even_p.append(st_p)
            even_s.append(st_s)
        else:
            ow = (odd_w_in[j], s5_lam_re[j], s5_lam_im[j], s5_log_step[j], s5_b_re[j], s5_b_im[j],
                  s5_c_re[j], s5_c_im[j], s5_d[j], s5_glu_w[j], s5_glu_b[j], odd_w_out[j])
            h0 = jnp.zeros((bp, S5_GROUPS, S5_STATE), F32)
            mp, st_p = odd_mixer(xp, h0, h0, *ow)
            ms, st_s = odd_mixer(xs, state_s5_re[j], state_s5_im[j], *ow)
            odd_p.append(st_p)
            odd_s.append(st_s)
        xp = layer_norm(ALPHA * xp + mp, ln_g[layer, 1], ln_b[layer, 1])
        xs = layer_norm(ALPHA * xs + ms, ln_g[layer, 1], ln_b[layer, 1])
        xp = macaron_half(xp, ffn_w_in[layer, 1], ffn_w_out[layer, 1], ln_g[layer, 2], ln_b[layer, 2])
        xs = macaron_half(xs, ffn_w_in[layer, 1], ffn_w_out[layer, 1], ln_g[layer, 2], ln_b[layer, 2])
    y_prompt, y_sample = xp, xs
    fox_k_prompt = stack_field(even_p, 0)
    fox_v_prompt = stack_field(even_p, 1)
    fox_logf_prompt = stack_field(even_p, 2)
    gdn_state_prompt = stack_field(even_p, 3)
    gdn_conv_prompt = stack_field(even_p, 4)
    s5_re_prompt = stack_field(odd_p, 0)
    s5_im_prompt = stack_field(odd_p, 1)
    fox_k_sample = stack_field(even_s, 0)
    fox_v_sample = stack_field(even_s, 1)
    fox_logf_sample = stack_field(even_s, 2)
    gdn_state_sample = stack_field(even_s, 3)
    gdn_conv_sample = stack_field(even_s, 4)
    s5_re_sample = stack_field(odd_s, 0)
    s5_im_sample = stack_field(odd_s, 1)
    return (y_prompt, y_sample, fox_k_prompt, fox_v_prompt, fox_logf_prompt, gdn_state_prompt, gdn_conv_prompt,
            s5_re_prompt, s5_im_prompt, fox_k_sample, fox_v_sample, fox_logf_sample, gdn_state_sample,
            gdn_conv_sample, s5_re_sample, s5_im_sample)
```

```cpp
#include <hip/hip_runtime.h>
#include <hip/hip_cooperative_groups.h>
#include <cstdio>
#include <cstdint>
namespace cg = cooperative_groups;

typedef unsigned short bf16_t;
typedef short bf16x8 __attribute__((ext_vector_type(8)));
typedef short bf16x4 __attribute__((ext_vector_type(4)));
typedef float f32x4 __attribute__((ext_vector_type(4)));
typedef float f32x2 __attribute__((ext_vector_type(2)));
typedef float f32x16 __attribute__((ext_vector_type(16)));
typedef unsigned u32x4 __attribute__((ext_vector_type(4)));
typedef unsigned u32x2 __attribute__((ext_vector_type(2)));

#define DEV __device__ __forceinline__

constexpr int D = 1024, T = 16384, MP = 32768, MS = 256, M = MP + MS, DFF = 2816;
constexpr int MT2 = M / 256;
constexpr float ALPHA = 1.41421356237f;
constexpr float LOG2E = 1.44269504089f;
constexpr int LDS_BYTES = 73728;
constexpr int NPREP = 2048 + 32;

constexpr size_t O_Y = 0;
constexpr size_t O_FKP = 33816576, O_FVP = 50593792, O_FLP = 67371008, O_GSP = 67633152, O_GCP = 67764224;
constexpr size_t O_S5RP = 67773440, O_S5IP = 67781632, O_FKS = 67789824, O_FVS = 67920896, O_FLS = 68051968;
constexpr size_t O_GSS = 68054016, O_GCS = 68578304, O_S5RS = 68615168, O_S5IS = 68647936;

constexpr size_t MB = 1u << 20;
constexpr size_t W_FFN_IN = 0;
constexpr size_t SZ_FFN_IN = (size_t)5632 * 1024 * 2;
constexpr size_t W_FFN_OUT = W_FFN_IN + 4 * SZ_FFN_IN;
constexpr size_t SZ_FFN_OUT = (size_t)1024 * 2816 * 2;
constexpr size_t W_EVEN_IN = W_FFN_OUT + 4 * SZ_FFN_OUT;
constexpr size_t W_EVEN_OUT = W_EVEN_IN + (size_t)3712 * 1024 * 2;
constexpr size_t W_ODD_IN = W_EVEN_OUT + 2 * MB;
constexpr size_t W_GLU = W_ODD_IN + 2 * MB;
constexpr size_t W_ODD_OUT = W_GLU + 2 * MB;
constexpr size_t W_S5B = W_ODD_OUT + 2 * MB;
constexpr size_t W_S5C = W_S5B + 262144;
constexpr size_t W_LAMB = W_S5C + 262144;
constexpr size_t W_LAM256 = W_LAMB + 32768;
constexpr size_t W_CTR = W_LAM256 + 32768;
constexpr size_t W_END = W_CTR + 4096;
static_assert(W_END < 90 * MB, "weights region");
constexpr size_t A_XB = 90 * MB;
constexpr size_t SZ_XB = (size_t)M * 1024 * 2;
constexpr size_t A_PW = A_XB;
constexpr size_t A_PQG = A_PW + (size_t)NPREP * 8192 * 2;
constexpr size_t A_PKDT = A_PQG + (size_t)NPREP * 8192 * 2;
constexpr size_t A_PUT = A_PKDT + (size_t)NPREP * 8192 * 2;
constexpr size_t A_PATT = A_PUT + (size_t)NPREP * 8192 * 2;
constexpr size_t A_PGL = A_PATT + (size_t)NPREP * 4096 * 2;
constexpr size_t A_PEND = A_PGL + 16384;
constexpr size_t A_GATED = A_XB + 70 * MB;
static_assert(A_PEND < 90 * MB + 154 * MB, "prep region");
static_assert(A_GATED + SZ_XB < 90 * MB + 154 * MB, "gated region");
constexpr size_t R0 = 244 * MB;
constexpr size_t R_ACT = R0;
constexpr size_t R_MIX = R0;
constexpr size_t R_KB = R_MIX + SZ_XB;
constexpr size_t R_VT = R_KB + (size_t)M * 512 * 2;
constexpr size_t R_GB = R_VT + (size_t)16 * 64 * 16384 * 2;
constexpr size_t R_LOGF = R_GB + (size_t)M * 1536 * 2;
constexpr size_t R_CUM = R_LOGF + (size_t)M * 8 * 4;
constexpr size_t R_GG = R_CUM + (size_t)M * 8 * 4;
constexpr size_t R_BETA = R_GG + (size_t)M * 4 * 4;
constexpr size_t R_QS = R_BETA + (size_t)M * 4 * 4;
constexpr size_t R_EVEN_END = R_QS + (size_t)256 * 512 * 4;
constexpr size_t R_U = R0;
constexpr size_t R_ZZB = R_U + (size_t)M * 1024 * 4;
constexpr size_t R_E = R_ZZB + SZ_XB;
constexpr size_t R_ODD_END = R_E + (size_t)2 * 64 * 4096 * 8;
constexpr size_t WS_NEED = 490 * MB;
static_assert(R_EVEN_END < WS_NEED && R_ODD_END < WS_NEED && R_ACT + (size_t)M * DFF * 2 < WS_NEED, "ws");

struct P {
  const float* in[32];
  float* out;
  unsigned char* ws;
};

DEV int ltid() { int t = threadIdx.x; asm volatile("" : "+v"(t)); return t; }
DEV bf16_t f2bf(float f) {
  unsigned u = __float_as_uint(f);
  u += 0x7fffu + ((u >> 16) & 1u);
  return (bf16_t)(u >> 16);
}
DEV float bf2f(bf16_t h) { return __uint_as_float(((unsigned)h) << 16); }
DEV unsigned pack2(float a, float b) { return (unsigned)f2bf(a) | ((unsigned)f2bf(b) << 16); }
DEV float silu_f(float x) { return x / (1.f + __expf(-x)); }
DEV float sigmoid_f(float x) { return 1.f / (1.f + __expf(-x)); }
DEV float softplus_f(float x) { return fmaxf(x, 0.f) + log1pf(__expf(-fabsf(x))); }
DEV float gelu_tanh(float x) {
  float u = 0.7978845608028654f * (x + 0.044715f * x * x * x);
  float t = 1.f - 2.f / (1.f + __expf(2.f * u));
  return 0.5f * x * (1.f + t);
}
DEV float wave_sum(float v) {
#pragma unroll
  for (int o = 32; o >= 1; o >>= 1) v += __shfl_xor(v, o);
  return v;
}
DEV float wave_max(float v) {
#pragma unroll
  for (int o = 32; o >= 1; o >>= 1) v = fmaxf(v, __shfl_xor(v, o));
  return v;
}
DEV f32x16 mfma32(bf16x8 a, bf16x8 b, f32x16 c) { return __builtin_amdgcn_mfma_f32_32x32x16_bf16(a, b, c, 0, 0, 0); }
DEV f32x4 mfma16(bf16x8 a, bf16x8 b, f32x4 c) { return __builtin_amdgcn_mfma_f32_16x16x32_bf16(a, b, c, 0, 0, 0); }

struct MapId { DEV int operator()(int n) const { return n; } };
struct MapFfnIn {
  DEV int operator()(int n) const {
    int t = n >> 7, w = n & 127;
    int wn = w >> 6, nt = (w >> 5) & 1, c = w & 31;
    return nt * DFF + t * 64 + wn * 32 + c;
  }
};
struct MapEvenIn {
  DEV int operator()(int n) const {
    if (n < 1536) return n;
    if (n < 3072) return 1544 + (n - 1536);
    if (n < 3584) return 3088 + (n - 3072);
    if (n < 3592) return 1536 + (n - 3584);
    if (n < 3600) return 3080 + (n - 3592);
    return -1;
  }
};

template <class Map>
DEV void conv_t(const float* __restrict__ src, int Nsrc, int K, bf16_t* __restrict__ dst, int Np, Map map, unsigned char* smem) {
  float* tile = (float*)smem;
  const int tid = ltid();
  const int ntn = Np >> 6, ntk = K >> 6;
  for (int t = blockIdx.x; t < ntn * ntk; t += gridDim.x) {
    const int tn = t % ntn, tk = t / ntn;
    {
      const int c = tid & 63, r0 = tid >> 6;
      const int sc = map(tn * 64 + c);
#pragma unroll
      for (int i = 0; i < 16; ++i) {
        const int k = tk * 64 + r0 + 4 * i;
        tile[(r0 + 4 * i) * 65 + c] = (sc >= 0) ? src[(size_t)k * Nsrc + sc] : 0.f;
      }
    }
    __syncthreads();
    {
      const int kk = tid & 63, n0 = tid >> 6;
#pragma unroll
      for (int i = 0; i < 16; ++i) {
        const int n = n0 + 4 * i;
        dst[(size_t)(tn * 64 + n) * K + tk * 64 + kk] = f2bf(tile[kk * 65 + n]);
      }
    }
    __syncthreads();
  }
}

DEV void phase0(const P& p, unsigned char* smem) {
  const int tid = ltid();
  const size_t gt = (size_t)blockIdx.x * 256 + tid, gn = (size_t)gridDim.x * 256;
  {
    float* X = p.out + O_Y;
    bf16_t* Xb = (bf16_t*)(p.ws + A_XB);
    const size_t n4p = (size_t)MP * D / 4, n4 = (size_t)M * D / 4;
    for (size_t i = gt; i < n4; i += gn) {
      f32x4 v = (i < n4p) ? ((const f32x4*)p.in[0])[i] : ((const f32x4*)p.in[1])[i - n4p];
      ((f32x4*)X)[i] = v;
      u32x2 o; o[0] = pack2(v[0], v[1]); o[1] = pack2(v[2], v[3]);
      ((u32x2*)Xb)[i] = o;
    }
  }
  for (int l = 0; l < 2; ++l)
    for (int f = 0; f < 2; ++f) {
      const int idx = l * 2 + f;
      conv_t(p.in[9] + (size_t)idx * 1024 * 5632, 5632, 1024, (bf16_t*)(p.ws + W_FFN_IN + idx * SZ_FFN_IN), 5632, MapFfnIn(), smem);
      conv_t(p.in[10] + (size_t)idx * 2816 * 1024, 1024, 2816, (bf16_t*)(p.ws + W_FFN_OUT + idx * SZ_FFN_OUT), 1024, MapId(), smem);
    }
  conv_t(p.in[13], 3600, 1024, (bf16_t*)(p.ws + W_EVEN_IN), 3712, MapEvenIn(), smem);
  conv_t(p.in[19], 1024, 1024, (bf16_t*)(p.ws + W_EVEN_OUT), 1024, MapId(), smem);
  conv_t(p.in[20], 1024, 1024, (bf16_t*)(p.ws + W_ODD_IN), 1024, MapId(), smem);
  conv_t(p.in[29], 1024, 1024, (bf16_t*)(p.ws + W_GLU), 1024, MapId(), smem);
  conv_t(p.in[31], 1024, 1024, (bf16_t*)(p.ws + W_ODD_OUT), 1024, MapId(), smem);
  if (gt < 4096) {
    const int g = (int)gt >> 6, pp = (int)gt & 63;
    const float step = expf(p.in[23][g]);
    const float lr = p.in[21][gt], li = p.in[22][gt];
    const float a = lr * step, b = li * step;
    const float ea = expf(a);
    float sb, cb; sincosf(b, &sb, &cb);
    const float lbr = ea * cb, lbi = ea * sb;
    const float sh = sinf(0.5f * b);
    const float nr = expm1f(a) * cb - 2.f * sh * sh, ni = lbi;
    const float dd = lr * lr + li * li;
    const float cr = (nr * lr + ni * li) / dd, ci = (ni * lr - nr * li) / dd;
    bf16_t* Bp = (bf16_t*)(p.ws + W_S5B);
    bf16_t* Cp = (bf16_t*)(p.ws + W_S5C);
    for (int c = 0; c < 16; ++c) {
      const float br = p.in[24][gt * 16 + c], bi = p.in[25][gt * 16 + c];
      Bp[((size_t)g * 128 + pp) * 16 + c] = f2bf(cr * br - ci * bi);
      Bp[((size_t)g * 128 + 64 + pp) * 16 + c] = f2bf(cr * bi + ci * br);
      Cp[((size_t)g * 16 + c) * 128 + pp] = f2bf(p.in[26][((size_t)g * 16 + c) * 64 + pp]);
      Cp[((size_t)g * 16 + c) * 128 + 64 + pp] = f2bf(-p.in[27][((size_t)g * 16 + c) * 64 + pp]);
    }
    ((f32x2*)(p.ws + W_LAMB))[gt] = (f32x2){lbr, lbi};
    float xr = lbr, xi = lbi;
    for (int i = 0; i < 8; ++i) { const float nr2 = xr * xr - xi * xi, ni2 = 2.f * xr * xi; xr = nr2; xi = ni2; }
    ((f32x2*)(p.ws + W_LAM256))[gt] = (f32x2){xr, xi};
  }
  if (gt < 64) ((unsigned*)(p.ws + W_CTR))[gt] = 0u;
}

template <class Epi>
DEV void gemm_phase(const bf16_t* __restrict__ A, int lda, const bf16_t* __restrict__ Wt, int K, int NT, Epi epi, unsigned char* smem) {
  const int tid = ltid(), lane = tid & 63, wave = tid >> 6, wm = wave >> 1, wn = wave & 1;
  const int r = lane & 31, hh = lane >> 5;
  bf16_t* As = (bf16_t*)smem;
  bf16_t* Bs = As + 2 * 256 * 40;
  const int nk = K >> 5;
  const int total = MT2 * NT;
  const int lrow = tid >> 2, lcc = tid & 3;
  for (int t = blockIdx.x; t < total; t += gridDim.x) {
    const int band = t / (43 * NT), rem = t - band * 43 * NT;
    const int tn = rem / 43, tm = band * 43 + (rem - tn * 43);
    const bf16_t* Ag = A + (size_t)(tm * 256 + lrow) * lda + lcc * 8;
    const bf16_t* Bg = Wt + (size_t)(tn * 128 + lrow) * K + lcc * 8;
    f32x16 acc[4][2];
#pragma unroll
    for (int i = 0; i < 4; ++i)
#pragma unroll
      for (int j = 0; j < 2; ++j)
#pragma unroll
        for (int q = 0; q < 16; ++q) acc[i][j][q] = 0.f;
    u32x4 ra[4], rb[2];
#pragma unroll
    for (int i = 0; i < 4; ++i) ra[i] = *(const u32x4*)(Ag + (size_t)(64 * i) * lda);
#pragma unroll
    for (int i = 0; i < 2; ++i) rb[i] = *(const u32x4*)(Bg + (size_t)(64 * i) * K);
    for (int kt = 0; kt < nk; ++kt) {
      bf16_t* as = As + (kt & 1) * 256 * 40;
      bf16_t* bs = Bs + (kt & 1) * 128 * 40;
#pragma unroll
      for (int i = 0; i < 4; ++i) *(u32x4*)(as + (lrow + 64 * i) * 40 + lcc * 8) = ra[i];
#pragma unroll
      for (int i = 0; i < 2; ++i) *(u32x4*)(bs + (lrow + 64 * i) * 40 + lcc * 8) = rb[i];
      __syncthreads();
      if (kt + 1 < nk) {
#pragma unroll
        for (int i = 0; i < 4; ++i) ra[i] = *(const u32x4*)(Ag + (size_t)(64 * i) * lda + (kt + 1) * 32);
#pragma unroll
        for (int i = 0; i < 2; ++i) rb[i] = *(const u32x4*)(Bg + (size_t)(64 * i) * K + (kt + 1) * 32);
      }
#pragma unroll
      for (int ks = 0; ks < 2; ++ks) {
        bf16x8 af[4], bfr[2];
#pragma unroll
        for (int i = 0; i < 4; ++i) af[i] = *(const bf16x8*)(as + (wm * 128 + i * 32 + r) * 40 + ks * 16 + hh * 8);
#pragma unroll
        for (int i = 0; i < 2; ++i) bfr[i] = *(const bf16x8*)(bs + (wn * 64 + i * 32 + r) * 40 + ks * 16 + hh * 8);
#pragma unroll
        for (int i = 0; i < 4; ++i)
#pragma unroll
          for (int j = 0; j < 2; ++j) acc[i][j] = mfma32(af[i], bfr[j], acc[i][j]);
      }
    }
    epi(acc, tm * 256 + wm * 128, tn, wn, lane);
    __syncthreads();
  }
}

struct EpiSwiglu {
  bf16_t* act;
  DEV void operator()(const f32x16 (&acc)[4][2], int row0, int tn, int wn, int lane) const {
    const int r = lane & 31, hh = lane >> 5;
    const int col = tn * 64 + wn * 32 + r;
#pragma unroll
    for (int mt = 0; mt < 4; ++mt)
#pragma unroll
      for (int q = 0; q < 16; ++q) {
        const int row = row0 + mt * 32 + (q & 3) + 8 * (q >> 2) + 4 * hh;
        const float a = acc[mt][0][q], b = acc[mt][1][q];
        act[(size_t)row * DFF + col] = f2bf(silu_f(a) * b);
      }
  }
};
template <class F>
struct EpiElem {
  F f;
  DEV void operator()(const f32x16 (&acc)[4][2], int row0, int tn, int wn, int lane) const {
    const int r = lane & 31, hh = lane >> 5;
#pragma unroll
    for (int mt = 0; mt < 4; ++mt)
#pragma unroll
      for (int nt = 0; nt < 2; ++nt)
#pragma unroll
        for (int q = 0; q < 16; ++q) {
          const int row = row0 + mt * 32 + (q & 3) + 8 * (q >> 2) + 4 * hh;
          const int col = tn * 128 + wn * 64 + nt * 32 + r;
          f(row, col, acc[mt][nt][q]);
        }
  }
};
struct FResid {
  float* X; float scale;
  DEV void operator()(int row, int col, float v) const {
    float* px = X + (size_t)row * D + col;
    *px = ALPHA * (*px) + scale * v;
  }
};
struct FStoreF32 {
  float* U;
  DEV void operator()(int row, int col, float v) const { U[(size_t)row * D + col] = v; }
};
struct FGlu {
  const bf16_t* zz; const float* bias; bf16_t* out;
  DEV void operator()(int row, int col, float v) const {
    const size_t i = (size_t)row * D + col;
    out[i] = f2bf(bf2f(zz[i]) * sigmoid_f(v + bias[col]));
  }
};
#define EACH_TILE(FN) FN(acc[0][0], 0, 0); FN(acc[0][1], 0, 1); FN(acc[1][0], 1, 0); FN(acc[1][1], 1, 1); FN(acc[2][0], 2, 0); FN(acc[2][1], 2, 1); FN(acc[3][0], 3, 0); FN(acc[3][1], 3, 1);
struct EpiEvenIn {
  P p;
  DEV void operator()(const f32x16 (&acc)[4][2], int row0, int tn, int wn, int lane) const {
    const int r = lane & 31, hh = lane >> 5;
    const bool samp = row0 >= MP;
    const int clb = wn * 64 + r;
    if (tn < 4) {
      bf16_t* MIX = (bf16_t*)(p.ws + R_MIX);
      float* QS = (float*)(p.ws + R_QS);
      auto fn = [&](const f32x16& a, int mt, int nt) {
        const int col = tn * 128 + clb + nt * 32;
#pragma unroll
        for (int q = 0; q < 16; ++q) {
          const int row = row0 + mt * 32 + (q & 3) + 8 * (q >> 2) + 4 * hh;
          MIX[(size_t)row * 1024 + col] = f2bf(a[q]);
          if (samp) QS[(size_t)(row - MP) * 512 + col] = a[q];
        }
      };
      EACH_TILE(fn)
    } else if (tn < 8) {
      bf16_t* KB = (bf16_t*)(p.ws + R_KB);
      float* ok = samp ? (p.out + O_FKS - (size_t)MP * 512) : (p.out + O_FKP);
      auto fn = [&](const f32x16& a, int mt, int nt) {
        const int col = (tn - 4) * 128 + clb + nt * 32;
#pragma unroll
        for (int q = 0; q < 16; ++q) {
          const int row = row0 + mt * 32 + (q & 3) + 8 * (q >> 2) + 4 * hh;
          KB[(size_t)row * 512 + col] = f2bf(a[q]);
          ok[(size_t)row * 512 + col] = a[q];
        }
      };
      EACH_TILE(fn)
    } else if (tn < 12) {
      if (!samp) {
        bf16_t* VT = (bf16_t*)(p.ws + R_VT);
        auto fn = [&](const f32x16& a, int mt, int nt) {
          const int col = (tn - 8) * 128 + clb + nt * 32;
          const int hd = col >> 6, dh = col & 63;
#pragma unroll
          for (int g = 0; g < 4; ++g) {
            const int row = row0 + mt * 32 + 8 * g + 4 * hh;
            const int b = row >> 14, tt = row & (T - 1);
            u32x2 o; o[0] = pack2(a[4 * g], a[4 * g + 1]); o[1] = pack2(a[4 * g + 2], a[4 * g + 3]);
            *(u32x2*)(VT + ((size_t)(b * 8 + hd) * 64 + dh) * T + tt) = o;
#pragma unroll
            for (int e = 0; e < 4; ++e) p.out[O_FVP + (size_t)(row + e) * 512 + col] = a[4 * g + e];
          }
        };
        EACH_TILE(fn)
      } else {
        auto fn = [&](const f32x16& a, int mt, int nt) {
          const int col = (tn - 8) * 128 + clb + nt * 32;
#pragma unroll
          for (int q = 0; q < 16; ++q) {
            const int row = row0 + mt * 32 + (q & 3) + 8 * (q >> 2) + 4 * hh;
            p.out[O_FVS + (size_t)(row - MP) * 512 + col] = a[q];
          }
        };
        EACH_TILE(fn)
      }
    } else if (tn < 24) {
      bf16_t* GB = (bf16_t*)(p.ws + R_GB);
      auto fn = [&](const f32x16& a, int mt, int nt) {
        const int col = (tn - 12) * 128 + clb + nt * 32;
#pragma unroll
        for (int q = 0; q < 16; ++q) {
          const int row = row0 + mt * 32 + (q & 3) + 8 * (q >> 2) + 4 * hh;
          const float v = a[q];
          GB[(size_t)row * 1536 + col] = f2bf(v);
          if (!samp) {
            const int tt = row & (T - 1);
            if (tt >= T - 3) p.out[O_GCP + (size_t)((row >> 14) * 3 + (tt - (T - 3))) * 1536 + col] = v;
          } else {
            const int tt = (row - MP) & 31;
            if (tt >= 29) p.out[O_GCS + (size_t)(((row - MP) >> 5) * 3 + (tt - 29)) * 1536 + col] = v;
          }
        }
      };
      EACH_TILE(fn)
    } else if (tn < 28) {
      bf16_t* MIX = (bf16_t*)(p.ws + R_MIX);
      auto fn = [&](const f32x16& a, int mt, int nt) {
        const int col = (tn - 24) * 128 + clb + nt * 32;
#pragma unroll
        for (int q = 0; q < 16; ++q) {
          const int row = row0 + mt * 32 + (q & 3) + 8 * (q >> 2) + 4 * hh;
          MIX[(size_t)row * 1024 + 512 + col] = f2bf(a[q]);
        }
      };
      EACH_TILE(fn)
    } else {
      float* LOGF = (float*)(p.ws + R_LOGF);
      float* GG = (float*)(p.ws + R_GG);
      float* BETA = (float*)(p.ws + R_BETA);
      if (wn == 0 && r < 16) {
        const int cl = r;
        float* ol = samp ? (p.out + O_FLS - (size_t)MP * 8) : (p.out + O_FLP);
        const float bias = (cl < 8) ? p.in[14][cl] : ((cl < 12) ? p.in[17][cl - 8] : 0.f);
        const float ea = (cl >= 8 && cl < 12) ? __expf(p.in[16][cl - 8]) : 0.f;
        auto fn = [&](const f32x16& a, int mt, int nt) {
          if (nt == 0) {
#pragma unroll
            for (int q = 0; q < 16; ++q) {
              const int row = row0 + mt * 32 + (q & 3) + 8 * (q >> 2) + 4 * hh;
              const float v = a[q];
              if (cl < 8) {
                const float lf = -softplus_f(-(v + bias));
                LOGF[(size_t)row * 8 + cl] = lf;
                ol[(size_t)row * 8 + cl] = lf;
              } else if (cl < 12) {
                GG[(size_t)row * 4 + (cl - 8)] = -ea * softplus_f(v + bias);
              } else {
                BETA[(size_t)row * 4 + (cl - 12)] = sigmoid_f(v);
              }
            }
          }
        };
        EACH_TILE(fn)
      }
    }
  }
};

DEV void ln_phase(float* __restrict__ X, bf16_t* __restrict__ Xb, const float* __restrict__ g, const float* __restrict__ b, bool write_bf) {
  const int tid_ = ltid();
  const int lane = tid_ & 63, wave = tid_ >> 6;
  const int gw = blockIdx.x * 4 + wave, nw = gridDim.x * 4;
  f32x4 gv[4], bv[4];
#pragma unroll
  for (int i = 0; i < 4; ++i) { gv[i] = ((const f32x4*)g)[i * 64 + lane]; bv[i] = ((const f32x4*)b)[i * 64 + lane]; }
  for (int row = gw; row < M; row += nw) {
    f32x4* xr = (f32x4*)(X + (size_t)row * D);
    f32x4 v[4];
    float s = 0.f;
#pragma unroll
    for (int i = 0; i < 4; ++i) { v[i] = xr[i * 64 + lane]; s += (v[i][0] + v[i][1]) + (v[i][2] + v[i][3]); }
    const float mu = wave_sum(s) * (1.f / D);
    float q = 0.f;
#pragma unroll
    for (int i = 0; i < 4; ++i) { v[i] = v[i] - mu; q += (v[i][0] * v[i][0] + v[i][1] * v[i][1]) + (v[i][2] * v[i][2] + v[i][3] * v[i][3]); }
    const float rs = rsqrtf(wave_sum(q) * (1.f / D) + 1e-5f);
#pragma unroll
    for (int i = 0; i < 4; ++i) {
      f32x4 o = v[i] * rs * gv[i] + bv[i];
      xr[i * 64 + lane] = o;
      if (write_bf) {
        u32x2 pk; pk[0] = pack2(o[0], o[1]); pk[1] = pack2(o[2], o[3]);
        ((u32x2*)(Xb + (size_t)row * D))[i * 64 + lane] = pk;
      }
    }
  }
}

DEV void cumsum_prompt(const P& p, int b, unsigned char* smem) {
  const float* LOGF = (const float*)(p.ws + R_LOGF) + (size_t)b * T * 8;
  float* CUM = (float*)(p.ws + R_CUM) + (size_t)b * T * 8;
  float* tot = (float*)smem;
  const int tid = ltid();
  float s[8];
#pragma unroll
  for (int h = 0; h < 8; ++h) s[h] = 0.f;
  for (int i = 0; i < 64; ++i) {
    const f32x4* r = (const f32x4*)(LOGF + (size_t)(tid * 64 + i) * 8);
    f32x4 a = r[0], c = r[1];
    s[0] += a[0]; s[1] += a[1]; s[2] += a[2]; s[3] += a[3]; s[4] += c[0]; s[5] += c[1]; s[6] += c[2]; s[7] += c[3];
  }
#pragma unroll
  for (int h = 0; h < 8; ++h) tot[tid * 8 + h] = s[h];
  __syncthreads();
  if (tid < 8) {
    float run = 0.f;
    for (int i = 0; i < 256; ++i) { const float v = tot[i * 8 + tid]; tot[i * 8 + tid] = run; run += v; }
  }
  __syncthreads();
#pragma unroll
  for (int h = 0; h < 8; ++h) s[h] = tot[tid * 8 + h];
  for (int i = 0; i < 64; ++i) {
    const f32x4* r = (const f32x4*)(LOGF + (size_t)(tid * 64 + i) * 8);
    f32x4 a = r[0], c = r[1];
    s[0] += a[0]; s[1] += a[1]; s[2] += a[2]; s[3] += a[3]; s[4] += c[0]; s[5] += c[1]; s[6] += c[2]; s[7] += c[3];
    f32x4* w = (f32x4*)(CUM + (size_t)(tid * 64 + i) * 8);
    w[0] = (f32x4){s[0], s[1], s[2], s[3]};
    w[1] = (f32x4){s[4], s[5], s[6], s[7]};
  }
  __syncthreads();
}

DEV void gdn_prep_item(const P& p, int item, unsigned char* smem) {
  const int tid = ltid(), lane = tid & 63, wave = tid >> 6;
  float* Kf = (float*)smem;
  float* Qf = Kf + 64 * 132;
  float* gc = Qf + 64 * 132;
  float* bt = gc + 64;
  float* eg = bt + 64;
  float* rk = eg + 64;
  float* rq = rk + 64;
  const bf16_t* GB = (const bf16_t*)(p.ws + R_GB);
  const float* GG = (const float*)(p.ws + R_GG);
  const float* BETA = (const float*)(p.ws + R_BETA);
  const float* cw = p.in[15];
  const bool samp = item >= 2048;
  const int h = item & 3;
  int row0, L; bool has_prev; const float* cbuf = nullptr;
  if (!samp) { const int chunk = (item >> 2) & 255, b = item >> 10; row0 = b * T + chunk * 64; L = 64; has_prev = chunk > 0; }
  else { const int sb = (item - 2048) >> 2; row0 = MP + sb * 32; L = 32; has_prev = false; cbuf = p.in[6] + (size_t)sb * 3 * 1536; }
  auto getx = [&](int i, int colg) -> float {
    if (i >= 0) return (i < L) ? bf2f(GB[(size_t)(row0 + i) * 1536 + colg]) : 0.f;
    if (samp) return cbuf[(3 + i) * 1536 + colg];
    return has_prev ? bf2f(GB[(size_t)(row0 + i) * 1536 + colg]) : 0.f;
  };
  const int c = tid & 127;
  const int half = tid >> 7;
  {
    const int colk = 512 + h * 128 + c, colq = h * 128 + c;
    const float k0 = cw[colk], k1 = cw[1536 + colk], k2 = cw[2 * 1536 + colk], k3 = cw[3 * 1536 + colk];
    const float q0 = cw[colq], q1 = cw[1536 + colq], q2 = cw[2 * 1536 + colq], q3 = cw[3 * 1536 + colq];
    const int i0 = half * 32;
    float a3 = getx(i0 - 3, colk), a2 = getx(i0 - 2, colk), a1 = getx(i0 - 1, colk);
    float b3 = getx(i0 - 3, colq), b2 = getx(i0 - 2, colq), b1 = getx(i0 - 1, colq);
#pragma unroll 8
    for (int ii = 0; ii < 32; ++ii) {
      const int i = i0 + ii;
      const float xa = getx(i, colk), xb = getx(i, colq);
      float ya = k0 * a3 + k1 * a2 + k2 * a1 + k3 * xa;
      float yb = q0 * b3 + q1 * b2 + q2 * b1 + q3 * xb;
      ya = (i < L) ? silu_f(ya) : 0.f;
      yb = (i < L) ? silu_f(yb) : 0.f;
      Kf[i * 132 + c] = ya;
      Qf[i * 132 + c] = yb;
      a3 = a2; a2 = a1; a1 = xa;
      b3 = b2; b2 = b1; b1 = xb;
    }
  }
  __syncthreads();
  for (int i = wave * 16; i < wave * 16 + 16; ++i) {
    const float a0 = Kf[i * 132 + lane], a1 = Kf[i * 132 + 64 + lane];
    const float sk = wave_sum(a0 * a0 + a1 * a1);
    const float b0 = Qf[i * 132 + lane], b1 = Qf[i * 132 + 64 + lane];
    const float sq = wave_sum(b0 * b0 + b1 * b1);
    if (lane == 0) { rk[i] = rsqrtf(sk + 1e-6f); rq[i] = rsqrtf(sq + 1e-6f) * 0.08838834764831845f; }
  }
  if (wave == 0) {
    float gi = (lane < L) ? GG[(size_t)(row0 + lane) * 4 + h] : 0.f;
    const float bi = (lane < L) ? BETA[(size_t)(row0 + lane) * 4 + h] : 0.f;
#pragma unroll
    for (int o = 1; o < 64; o <<= 1) { const float tt = __shfl_up(gi, o); if (lane >= o) gi += tt; }
    gc[lane] = gi; eg[lane] = __expf(gi); bt[lane] = bi;
  }
  __syncthreads();
  {
#pragma unroll 4
    for (int ii = 0; ii < 32; ++ii) {
      const int i = half * 32 + ii;
      Kf[i * 132 + c] *= rk[i];
      Qf[i * 132 + c] *= rq[i];
    }
  }
  __syncthreads();
  bf16_t* PW = (bf16_t*)(p.ws + A_PW) + (size_t)item * 8192;
  bf16_t* PQG = (bf16_t*)(p.ws + A_PQG) + (size_t)item * 8192;
  bf16_t* PKDT = (bf16_t*)(p.ws + A_PKDT) + (size_t)item * 8192;
  bf16_t* PUT = (bf16_t*)(p.ws + A_PUT) + (size_t)item * 8192;
  bf16_t* PATT = (bf16_t*)(p.ws + A_PATT) + (size_t)item * 4096;
  float* PGL = (float*)(p.ws + A_PGL);
  const float gl = gc[63];
  {
#pragma unroll 4
    for (int ii = 0; ii < 32; ++ii) {
      const int i = half * 32 + ii;
      PQG[i * 128 + c] = f2bf(Qf[i * 132 + c] * eg[i]);
    }
#pragma unroll
    for (int j8 = 0; j8 < 4; ++j8) {
      const int j0 = half * 32 + j8 * 8;
      float e[8];
#pragma unroll
      for (int t = 0; t < 8; ++t) e[t] = Kf[(j0 + t) * 132 + c] * __expf(gl - gc[j0 + t]);
      u32x4 o;
      o[0] = pack2(e[0], e[1]); o[1] = pack2(e[2], e[3]); o[2] = pack2(e[4], e[5]); o[3] = pack2(e[6], e[7]);
      *(u32x4*)(PKDT + c * 64 + j0) = o;
    }
    if (tid == 0) PGL[item] = __expf(gl);
  }
  const int ti = tid >> 4, tj = tid & 15;
  {
    float accA[4][4], accN[4][4];
#pragma unroll
    for (int a = 0; a < 4; ++a)
#pragma unroll
      for (int b = 0; b < 4; ++b) { accA[a][b] = 0.f; accN[a][b] = 0.f; }
#pragma unroll 2
    for (int cc = 0; cc < 128; cc += 4) {
      f32x4 qi[4], ki[4], kj[4];
#pragma unroll
      for (int a = 0; a < 4; ++a) {
        qi[a] = *(const f32x4*)(Qf + (ti + 16 * a) * 132 + cc);
        ki[a] = *(const f32x4*)(Kf + (ti + 16 * a) * 132 + cc);
        kj[a] = *(const f32x4*)(Kf + (tj + 16 * a) * 132 + cc);
      }
#pragma unroll
      for (int a = 0; a < 4; ++a)
#pragma unroll
        for (int b = 0; b < 4; ++b) {
          accA[a][b] += qi[a][0] * kj[b][0] + qi[a][1] * kj[b][1] + qi[a][2] * kj[b][2] + qi[a][3] * kj[b][3];
          accN[a][b] += ki[a][0] * kj[b][0] + ki[a][1] * kj[b][1] + ki[a][2] * kj[b][2] + ki[a][3] * kj[b][3];
        }
    }
    __syncthreads();
    float* Nl = Qf;
#pragma unroll
    for (int a = 0; a < 4; ++a)
#pragma unroll
      for (int b = 0; b < 4; ++b) {
        const int i = ti + 16 * a, j = tj + 16 * b;
        const float dec = (j <= i) ? __expf(gc[i] - gc[j]) : 0.f;
        PATT[i * 64 + j] = f2bf((j <= i) ? accA[a][b] * dec : 0.f);
        Nl[i * 68 + j] = (j < i) ? accN[a][b] * bt[i] * dec : 0.f;
      }
  }
  __syncthreads();
  {
    const float* Nl = Qf;
    float col[64];
    if (tid < 128) {
      const int colg = 1024 + h * 128 + c;
      const float w0 = cw[colg], w1 = cw[1536 + colg], w2 = cw[2 * 1536 + colg], w3 = cw[3 * 1536 + colg];
      float x3 = getx(-3, colg), x2 = getx(-2, colg), x1 = getx(-1, colg);
#pragma unroll
      for (int i = 0; i < 64; ++i) {
        const float x = getx(i, colg);
        float y = w0 * x3 + w1 * x2 + w2 * x1 + w3 * x;
        y = (i < L) ? silu_f(y) : 0.f;
        col[i] = y * bt[i];
        x3 = x2; x2 = x1; x1 = x;
      }
    } else {
#pragma unroll
      for (int i = 0; i < 64; ++i) col[i] = Kf[i * 132 + c] * bt[i] * eg[i];
    }
#pragma unroll
    for (int i = 1; i < 64; ++i) {
      float sacc = 0.f;
#pragma unroll
      for (int j4 = 0; j4 < (i + 3) / 4; ++j4) {
        const f32x4 nv = *(const f32x4*)(Nl + i * 68 + j4 * 4);
#pragma unroll
        for (int e = 0; e < 4; ++e)
          if (j4 * 4 + e < i) sacc += nv[e] * col[j4 * 4 + e];
      }
      col[i] -= sacc;
    }
    if (tid < 128) {
#pragma unroll
      for (int j8 = 0; j8 < 8; ++j8) {
        u32x4 o;
        o[0] = pack2(col[j8 * 8 + 0], col[j8 * 8 + 1]); o[1] = pack2(col[j8 * 8 + 2], col[j8 * 8 + 3]);
        o[2] = pack2(col[j8 * 8 + 4], col[j8 * 8 + 5]); o[3] = pack2(col[j8 * 8 + 6], col[j8 * 8 + 7]);
        *(u32x4*)(PUT + c * 64 + j8 * 8) = o;
      }
    } else {
#pragma unroll
      for (int i = 0; i < 64; ++i) PW[i * 128 + c] = f2bf(col[i]);
    }
  }
  __syncthreads();
}

struct GdnFr { bf16x8 w[4], qg[4], att[2], kd[2][2]; u32x2 u; float gl; };
DEV void gdn_load(GdnFr& f, const P& p, int item, int sl, int wave, int lane) {
  const int r16 = lane & 15, q4 = lane >> 4;
  const bf16_t* PW = (const bf16_t*)(p.ws + A_PW) + (size_t)item * 8192;
  const bf16_t* PQG = (const bf16_t*)(p.ws + A_PQG) + (size_t)item * 8192;
  const bf16_t* PKDT = (const bf16_t*)(p.ws + A_PKDT) + (size_t)item * 8192;
  const bf16_t* PUT = (const bf16_t*)(p.ws + A_PUT) + (size_t)item * 8192;
  const bf16_t* PATT = (const bf16_t*)(p.ws + A_PATT) + (size_t)item * 4096;
#pragma unroll
  for (int ks = 0; ks < 4; ++ks) {
    f.w[ks] = *(const bf16x8*)(PW + (wave * 16 + r16) * 128 + ks * 32 + q4 * 8);
    f.qg[ks] = *(const bf16x8*)(PQG + (wave * 16 + r16) * 128 + ks * 32 + q4 * 8);
  }
#pragma unroll
  for (int ks = 0; ks < 2; ++ks) {
    f.att[ks] = *(const bf16x8*)(PATT + (wave * 16 + r16) * 64 + ks * 32 + q4 * 8);
#pragma unroll
    for (int mt = 0; mt < 2; ++mt) f.kd[mt][ks] = *(const bf16x8*)(PKDT + (wave * 32 + mt * 16 + r16) * 64 + ks * 32 + q4 * 8);
  }
  f.u = *(const u32x2*)(PUT + (sl * 16 + r16) * 64 + wave * 16 + q4 * 4);
  f.gl = ((const float*)(p.ws + A_PGL))[item];
}

DEV void gdn_scan_chain(const P& p, int chain, unsigned char* smem) {
  const int tid = ltid(), lane = tid & 63, wave = tid >> 6;
  const int r16 = lane & 15, q4 = lane >> 4;
  bf16_t* Sb = (bf16_t*)smem;
  bf16_t* Vn = Sb + 16 * 136;
  float* ORAW = (float*)(p.ws + R_GB);
  int sl, h, nchunks, item0, rowbase, nvalid; float* sout; const float* s0 = nullptr;
  if (chain < 64) { sl = chain & 7; h = (chain >> 3) & 3; const int b = chain >> 5; nchunks = 256; item0 = b * 1024 + h; rowbase = b * T; nvalid = 64;
    sout = p.out + O_GSP + (size_t)(b * 4 + h) * 16384; }
  else { const int cs = chain - 64; sl = cs & 7; h = (cs >> 3) & 3; const int sb = cs >> 5; nchunks = 1; item0 = 2048 + sb * 4 + h; rowbase = MP + sb * 32; nvalid = 32;
    sout = p.out + O_GSS + (size_t)(sb * 4 + h) * 16384; s0 = p.in[5] + (size_t)(sb * 4 + h) * 16384; }
  f32x4 S[2];
#pragma unroll
  for (int mt = 0; mt < 2; ++mt)
#pragma unroll
    for (int e = 0; e < 4; ++e) S[mt][e] = s0 ? s0[(size_t)(wave * 32 + mt * 16 + q4 * 4 + e) * 128 + sl * 16 + r16] : 0.f;
#pragma unroll
  for (int mt = 0; mt < 2; ++mt) {
    u32x2 o; o[0] = pack2(S[mt][0], S[mt][1]); o[1] = pack2(S[mt][2], S[mt][3]);
    *(u32x2*)(Sb + r16 * 136 + wave * 32 + mt * 16 + q4 * 4) = o;
  }
  GdnFr cur, nxt;
  gdn_load(cur, p, item0, sl, wave, lane);
  __syncthreads();
  for (int ch = 0; ch < nchunks; ++ch) {
    if (ch + 1 < nchunks) gdn_load(nxt, p, item0 + (ch + 1) * 4, sl, wave, lane);
    f32x4 ws = {0.f, 0.f, 0.f, 0.f}, qs = {0.f, 0.f, 0.f, 0.f};
#pragma unroll
    for (int ks = 0; ks < 4; ++ks) {
      const bf16x8 sf = *(const bf16x8*)(Sb + r16 * 136 + ks * 32 + q4 * 8);
      ws = mfma16(cur.w[ks], sf, ws);
      qs = mfma16(cur.qg[ks], sf, qs);
    }
    f32x4 vn;
    vn[0] = bf2f((bf16_t)(cur.u[0] & 0xffff)) - ws[0];
    vn[1] = bf2f((bf16_t)(cur.u[0] >> 16)) - ws[1];
    vn[2] = bf2f((bf16_t)(cur.u[1] & 0xffff)) - ws[2];
    vn[3] = bf2f((bf16_t)(cur.u[1] >> 16)) - ws[3];
    {
      u32x2 o; o[0] = pack2(vn[0], vn[1]); o[1] = pack2(vn[2], vn[3]);
      *(u32x2*)(Vn + r16 * 72 + wave * 16 + q4 * 4) = o;
    }
    __syncthreads();
    bf16x8 vf[2];
#pragma unroll
    for (int ks = 0; ks < 2; ++ks) vf[ks] = *(const bf16x8*)(Vn + r16 * 72 + ks * 32 + q4 * 8);
#pragma unroll
    for (int ks = 0; ks < 2; ++ks) qs = mfma16(cur.att[ks], vf[ks], qs);
#pragma unroll
    for (int e = 0; e < 4; ++e) {
      const int i = wave * 16 + q4 * 4 + e;
      if (i < nvalid) ORAW[(size_t)(rowbase + ch * 64 + i) * 512 + h * 128 + sl * 16 + r16] = qs[e];
    }
#pragma unroll
    for (int mt = 0; mt < 2; ++mt) {
      f32x4 sn = S[mt] * cur.gl;
#pragma unroll
      for (int ks = 0; ks < 2; ++ks) sn = mfma16(cur.kd[mt][ks], vf[ks], sn);
      S[mt] = sn;
      u32x2 o; o[0] = pack2(sn[0], sn[1]); o[1] = pack2(sn[2], sn[3]);
      *(u32x2*)(Sb + r16 * 136 + wave * 32 + mt * 16 + q4 * 4) = o;
    }
    __syncthreads();
    if (ch + 1 < nchunks) cur = nxt;
  }
#pragma unroll
  for (int mt = 0; mt < 2; ++mt)
#pragma unroll
    for (int e = 0; e < 4; ++e) sout[(size_t)(wave * 32 + mt * 16 + q4 * 4 + e) * 128 + sl * 16 + r16] = S[mt][e];
  __syncthreads();
}

DEV void attn_prompt_item(const P& p, int bh, int qb, unsigned char* smem) {
  const int tid = ltid(), lane = tid & 63, wave = tid >> 6;
  const int r = lane & 31, hh = lane >> 5;
  const int b = bh >> 3, hd = bh & 7;
  bf16_t* Ks = (bf16_t*)smem;
  bf16_t* Vs = Ks + 2 * 64 * 72;
  float* Bi = (float*)(Vs + 2 * 64 * 72);
  bf16_t* MIX = (bf16_t*)(p.ws + R_MIX);
  const bf16_t* KB = (const bf16_t*)(p.ws + R_KB);
  const bf16_t* VT = (const bf16_t*)(p.ws + R_VT);
  const float* CUM = (const float*)(p.ws + R_CUM);
  const int qpos = qb * 128 + wave * 32 + r;
  const size_t qrow = (size_t)b * T + qpos;
  bf16x8 qf[4];
#pragma unroll
  for (int ks = 0; ks < 4; ++ks) qf[ks] = *(const bf16x8*)(MIX + qrow * 1024 + hd * 64 + ks * 16 + hh * 8);
  f32x16 o[2];
#pragma unroll
  for (int dt = 0; dt < 2; ++dt)
#pragma unroll
    for (int q = 0; q < 16; ++q) o[dt][q] = 0.f;
  float m = -INFINITY, lsum = 0.f;
  const int nkt = qb * 2 + 2;
  const int lrow = tid >> 3, lcc = tid & 7;
  const bf16_t* Kg = KB + ((size_t)b * T + lrow) * 512 + hd * 64 + lcc * 8;
  const bf16_t* Vg = VT + ((size_t)bh * 64 + lrow) * T + lcc * 8;
  u32x4 rk[2], rv[2]; float rbias = 0.f;
#pragma unroll
  for (int i = 0; i < 2; ++i) { rk[i] = *(const u32x4*)(Kg + (size_t)(32 * i) * 512); rv[i] = *(const u32x4*)(Vg + (size_t)(32 * i) * T); }
  if (tid < 64) rbias = -CUM[((size_t)b * T + tid) * 8 + hd] * LOG2E;
  const int qlast = qb * 128 + wave * 32 + 31;
  for (int kt = 0; kt < nkt; ++kt) {
    bf16_t* ks_ = Ks + (kt & 1) * 64 * 72;
    bf16_t* vs_ = Vs + (kt & 1) * 64 * 72;
    float* bi_ = Bi + (kt & 1) * 64;
#pragma unroll
    for (int i = 0; i < 2; ++i) {
      *(u32x4*)(ks_ + (lrow + 32 * i) * 72 + lcc * 8) = rk[i];
      *(u32x4*)(vs_ + (lrow + 32 * i) * 72 + lcc * 8) = rv[i];
    }
    if (tid < 64) bi_[tid] = rbias;
    __syncthreads();
    if (kt + 1 < nkt) {
#pragma unroll
      for (int i = 0; i < 2; ++i) {
        rk[i] = *(const u32x4*)(Kg + (size_t)((kt + 1) * 64 + 32 * i) * 512);
        rv[i] = *(const u32x4*)(Vg + (size_t)(32 * i) * T + (kt + 1) * 64);
      }
      if (tid < 64) rbias = -CUM[((size_t)b * T + (kt + 1) * 64 + tid) * 8 + hd] * LOG2E;
    }
    if (kt * 64 <= qlast) {
      f32x16 s[2];
#pragma unroll
      for (int k2 = 0; k2 < 2; ++k2) {
#pragma unroll
        for (int q = 0; q < 16; ++q) s[k2][q] = 0.f;
#pragma unroll
        for (int ks = 0; ks < 4; ++ks) {
          const bf16x8 kf = *(const bf16x8*)(ks_ + (32 * k2 + r) * 72 + ks * 16 + hh * 8);
          s[k2] = mfma32(kf, qf[ks], s[k2]);
        }
      }
      const bool diag = (kt * 64 + 63 > qb * 128 + wave * 32);
      float mx = -INFINITY;
#pragma unroll
      for (int k2 = 0; k2 < 2; ++k2)
#pragma unroll
        for (int g = 0; g < 4; ++g) {
          const f32x4 bb = *(const f32x4*)(bi_ + 32 * k2 + 8 * g + 4 * hh);
#pragma unroll
          for (int e = 0; e < 4; ++e) {
            float tv = s[k2][4 * g + e] * (0.125f * LOG2E) + bb[e];
            if (diag) { const int key = kt * 64 + 32 * k2 + 8 * g + 4 * hh + e; if (key > qpos) tv = -INFINITY; }
            s[k2][4 * g + e] = tv;
            mx = fmaxf(mx, tv);
          }
        }
      mx = fmaxf(mx, __shfl_xor(mx, 32));
      const float mnew = fmaxf(m, mx);
      const float alpha = exp2f(m - mnew);
      m = mnew;
      float ps = 0.f;
      bf16x8 pb[2][2];
#pragma unroll
      for (int k2 = 0; k2 < 2; ++k2)
#pragma unroll
        for (int s2 = 0; s2 < 2; ++s2) {
#pragma unroll
          for (int j = 0; j < 8; ++j) {
            const float pv = exp2f(s[k2][8 * s2 + j] - mnew);
            ps += pv;
            pb[k2][s2][j] = (short)f2bf(pv);
          }
        }
      lsum = lsum * alpha + ps;
#pragma unroll
      for (int dt = 0; dt < 2; ++dt) {
        o[dt] = o[dt] * alpha;
#pragma unroll
        for (int k2 = 0; k2 < 2; ++k2)
#pragma unroll
          for (int s2 = 0; s2 < 2; ++s2) {
            const bf16_t* vp = vs_ + (32 * dt + r) * 72 + 32 * k2 + 16 * s2 + 4 * hh;
            const bf16x4 lo = *(const bf16x4*)vp, hi = *(const bf16x4*)(vp + 8);
            bf16x8 vf;
            vf[0] = lo[0]; vf[1] = lo[1]; vf[2] = lo[2]; vf[3] = lo[3]; vf[4] = hi[0]; vf[5] = hi[1]; vf[6] = hi[2]; vf[7] = hi[3];
            o[dt] = mfma32(vf, pb[k2][s2], o[dt]);
          }
      }
    }
  }
  lsum += __shfl_xor(lsum, 32);
  const float inv = 1.f / lsum;
#pragma unroll
  for (int dt = 0; dt < 2; ++dt)
#pragma unroll
    for (int g = 0; g < 4; ++g) {
      u32x2 ov; ov[0] = pack2(o[dt][4 * g] * inv, o[dt][4 * g + 1] * inv); ov[1] = pack2(o[dt][4 * g + 2] * inv, o[dt][4 * g + 3] * inv);
      *(u32x2*)(MIX + qrow * 1024 + hd * 64 + 32 * dt + 8 * g + 4 * hh) = ov;
    }
  __syncthreads();
}

DEV void attn_sample_item(const P& p, int item, unsigned char* smem) {
  const int tid = ltid(), lane = tid & 63, wave = tid >> 6;
  const int sb = item >> 3, hd = item & 7;
  float* cs = (float*)smem;
  float* qs = cs + 1088;
  float* ps = qs + 256;
  const float* ck = p.in[2] + (size_t)sb * 1024 * 512;
  const float* cv = p.in[3] + (size_t)sb * 1024 * 512;
  const float* clf = p.in[4] + (size_t)sb * 1024 * 8;
  const float* nk = p.out + O_FKS + (size_t)sb * 32 * 512;
  const float* nv = p.out + O_FVS + (size_t)sb * 32 * 512;
  const float* nlf = (const float*)(p.ws + R_LOGF) + (size_t)(MP + sb * 32) * 8;
  const float* QS = (const float*)(p.ws + R_QS) + (size_t)sb * 32 * 512;
  bf16_t* MIX = (bf16_t*)(p.ws + R_MIX);
  if (wave == 0) {
    float s = 0.f;
    for (int i = 0; i < 17; ++i) {
      const int j = lane * 17 + i;
      float x = 0.f;
      if (j < 1024) x = clf[(size_t)j * 8 + hd]; else if (j < 1056) x = nlf[(size_t)(j - 1024) * 8 + hd];
      s += x; cs[j] = s;
    }
    float inc = s;
#pragma unroll
    for (int o = 1; o < 64; o <<= 1) { const float tt = __shfl_up(inc, o); if (lane >= o) inc += tt; }
    const float ex = inc - s;
    for (int i = 0; i < 17; ++i) cs[lane * 17 + i] += ex;
  }
  __syncthreads();
  for (int qi = wave; qi < 32; qi += 4) {
    qs[wave * 64 + lane] = QS[(size_t)qi * 512 + hd * 64 + lane];
    __syncthreads();
    const int nkeys = 1024 + qi + 1;
    const float cq = cs[1024 + qi];
    float mx = -INFINITY;
#pragma unroll 1
    for (int n = 0; n < 17; ++n) {
      const int j = lane + 64 * n;
      float sv = -INFINITY;
      if (j < nkeys) {
        const float* kr = (j < 1024) ? (ck + (size_t)j * 512 + hd * 64) : (nk + (size_t)(j - 1024) * 512 + hd * 64);
        float d = 0.f;
#pragma unroll
        for (int c4 = 0; c4 < 16; ++c4) {
          const f32x4 kk = *(const f32x4*)(kr + c4 * 4);
          const f32x4 qq = *(const f32x4*)(qs + wave * 64 + c4 * 4);
          d += kk[0] * qq[0] + kk[1] * qq[1] + kk[2] * qq[2] + kk[3] * qq[3];
        }
        sv = d * 0.125f + cq - cs[j];
      }
      ps[wave * 1088 + j] = sv; mx = fmaxf(mx, sv);
    }
    mx = wave_max(mx);
    float sum = 0.f;
    for (int n = 0; n < 17; ++n) {
      const int j = lane + 64 * n;
      const float pv = (j < nkeys) ? __expf(ps[wave * 1088 + j] - mx) : 0.f;
      sum += pv;
      ps[wave * 1088 + j] = pv;
    }
    sum = wave_sum(sum);
    __syncthreads();
    float acc = 0.f;
#pragma unroll 4
    for (int j = 0; j < nkeys; ++j) {
      const float* vr = (j < 1024) ? (cv + (size_t)j * 512 + hd * 64) : (nv + (size_t)(j - 1024) * 512 + hd * 64);
      acc += ps[wave * 1088 + j] * vr[lane];
    }
    MIX[(size_t)(MP + sb * 32 + qi) * 1024 + hd * 64 + lane] = f2bf(acc / sum);
    __syncthreads();
  }
}

DEV void gdn_gate_phase(const P& p) {
  const int tid_ = ltid();
  const int lane = tid_ & 63, wave = tid_ >> 6;
  const float* ORAW = (const float*)(p.ws + R_GB);
  bf16_t* MIX = (bf16_t*)(p.ws + R_MIX);
  const float* ng = p.in[18];
  const f32x2 g2 = *(const f32x2*)(ng + 2 * lane);
  for (int it = blockIdx.x * 4 + wave; it < M * 4; it += gridDim.x * 4) {
    const int row = it >> 2, h = it & 3;
    const f32x2 ov = *(const f32x2*)(ORAW + (size_t)row * 512 + h * 128 + 2 * lane);
    unsigned* zp = (unsigned*)(MIX + (size_t)row * 1024 + 512 + h * 128 + 2 * lane);
    const unsigned zz = *zp;
    const float z0 = bf2f((bf16_t)(zz & 0xffff)), z1 = bf2f((bf16_t)(zz >> 16));
    const float ss = wave_sum(ov[0] * ov[0] + ov[1] * ov[1]);
    const float rs = rsqrtf(ss * (1.f / 128.f) + 1e-6f);
    *zp = pack2(ov[0] * rs * g2[0] * silu_f(z0), ov[1] * rs * g2[1] * silu_f(z1));
  }
}

template <int PASS>
DEV void s5_item(const P& p, int item, unsigned char* smem) {
  const int tid = ltid(), lane = tid & 63, wave = tid >> 6;
  const int r = lane & 31, hh = lane >> 5, r16 = lane & 15, q4 = lane >> 4;
  bf16_t* HB = (bf16_t*)smem + wave * 64 * 136;
  const float* U = (const float*)(p.ws + R_U);
  bf16_t* ZZB = (bf16_t*)(p.ws + R_ZZB);
  f32x2* E = (f32x2*)(p.ws + R_E);
  const f32x2* LAMB = (const f32x2*)(p.ws + W_LAMB);
  const f32x2* LAM256 = (const f32x2*)(p.ws + W_LAM256);
  const bf16_t* Bp = (const bf16_t*)(p.ws + W_S5B);
  const bf16_t* Cp = (const bf16_t*)(p.ws + W_S5C);
  int g, seq, span, row0, nchunk, ntok; bool samp;
  if (item < 2048) { samp = false; const int gq = item & 15; span = (item >> 4) & 63; seq = item >> 10; g = gq * 4 + wave; row0 = seq * T + span * 256; nchunk = 4; ntok = 64; }
  else { samp = true; const int it = item - 2048; const int gq = it & 15; seq = it >> 4; span = 0; g = gq * 4 + wave; row0 = MP + seq * 32; nchunk = 1; ntok = 32; }
  const f32x2 lam = LAMB[g * 64 + lane];
  float hr = 0.f, hi = 0.f;
  if (PASS == 2) {
    if (samp) { hr = p.in[7][(size_t)(seq * 64 + g) * 64 + lane]; hi = p.in[8][(size_t)(seq * 64 + g) * 64 + lane]; }
    else {
      const f32x2 l256 = LAM256[g * 64 + lane];
      for (int j = 0; j < span; ++j) {
        const f32x2 e = E[((size_t)(seq * 64 + j) * 64 + g) * 64 + lane];
        const float nr = l256[0] * hr - l256[1] * hi + e[0];
        const float ni = l256[0] * hi + l256[1] * hr + e[1];
        hr = nr; hi = ni;
      }
    }
  }
  bf16x8 bfr[4];
#pragma unroll
  for (int nt = 0; nt < 4; ++nt) bfr[nt] = *(const bf16x8*)(Bp + ((size_t)g * 128 + nt * 32 + r) * 16 + hh * 8);
  bf16x8 cfr[4];
#pragma unroll
  for (int ks = 0; ks < 4; ++ks) cfr[ks] = *(const bf16x8*)(Cp + ((size_t)g * 16 + r16) * 128 + ks * 32 + q4 * 8);
  const float dd = p.in[28][g * 16 + r16];
  for (int ch = 0; ch < nchunk; ++ch) {
    const int rowc = row0 + ch * 64;
#pragma unroll
    for (int mt = 0; mt < 2; ++mt) {
      bf16x8 uf;
      if (mt * 32 < ntok) {
        const float* up = U + (size_t)(rowc + mt * 32 + r) * D + g * 16 + hh * 8;
        const f32x4 u0 = *(const f32x4*)up, u1 = *(const f32x4*)(up + 4);
        uf[0] = (short)f2bf(u0[0]); uf[1] = (short)f2bf(u0[1]); uf[2] = (short)f2bf(u0[2]); uf[3] = (short)f2bf(u0[3]);
        uf[4] = (short)f2bf(u1[0]); uf[5] = (short)f2bf(u1[1]); uf[6] = (short)f2bf(u1[2]); uf[7] = (short)f2bf(u1[3]);
      } else {
#pragma unroll
        for (int j = 0; j < 8; ++j) uf[j] = 0;
      }
#pragma unroll
      for (int nt = 0; nt < 4; ++nt) {
        f32x16 acc;
#pragma unroll
        for (int q = 0; q < 16; ++q) acc[q] = 0.f;
        acc = mfma32(uf, bfr[nt], acc);
#pragma unroll
        for (int q = 0; q < 16; ++q) HB[(mt * 32 + (q & 3) + 8 * (q >> 2) + 4 * hh) * 136 + nt * 32 + r] = f2bf(acc[q]);
      }
    }
    __syncthreads();
    for (int t = 0; t < ntok; ++t) {
      const float br = bf2f(HB[t * 136 + lane]), bi = bf2f(HB[t * 136 + 64 + lane]);
      const float nr = lam[0] * hr - lam[1] * hi + br;
      const float ni = lam[0] * hi + lam[1] * hr + bi;
      hr = nr; hi = ni;
      if (PASS == 2) { HB[t * 136 + lane] = f2bf(hr); HB[t * 136 + 64 + lane] = f2bf(hi); }
    }
    __syncthreads();
    if (PASS == 2) {
#pragma unroll
      for (int m4 = 0; m4 < 4; ++m4) {
        if (m4 * 16 < ntok) {
          f32x4 y = {0.f, 0.f, 0.f, 0.f};
#pragma unroll
          for (int ks = 0; ks < 4; ++ks) {
            const bf16x8 hf = *(const bf16x8*)(HB + (m4 * 16 + r16) * 136 + ks * 32 + q4 * 8);
            y = mfma16(hf, cfr[ks], y);
          }
#pragma unroll
          for (int e = 0; e < 4; ++e) {
            const size_t idx = (size_t)(rowc + m4 * 16 + q4 * 4 + e) * D + g * 16 + r16;
            const float yy = y[e] + dd * U[idx];
            ZZB[idx] = f2bf(gelu_tanh(yy));
          }
        }
      }
      __syncthreads();
    }
  }
  if (PASS == 1) E[((size_t)(seq * 64 + span) * 64 + g) * 64 + lane] = (f32x2){hr, hi};
  else {
    if (samp) { p.out[O_S5RS + (size_t)(seq * 64 + g) * 64 + lane] = hr; p.out[O_S5IS + (size_t)(seq * 64 + g) * 64 + lane] = hi; }
    else if (span == 63) { p.out[O_S5RP + (size_t)(seq * 64 + g) * 64 + lane] = hr; p.out[O_S5IP + (size_t)(seq * 64 + g) * 64 + lane] = hi; }
  }
}

DEV void gsync(unsigned* bar, unsigned& epoch) {
  epoch += gridDim.x;
  asm volatile("s_waitcnt vmcnt(0) lgkmcnt(0)" ::: "memory");
  __syncthreads();
  if (threadIdx.x == 0) {
    __builtin_amdgcn_fence(__ATOMIC_RELEASE, "agent");
    __hip_atomic_fetch_add(bar, 1u, __ATOMIC_RELAXED, __HIP_MEMORY_SCOPE_AGENT);
    while (__hip_atomic_load(bar, __ATOMIC_RELAXED, __HIP_MEMORY_SCOPE_AGENT) < epoch) __builtin_amdgcn_s_sleep(1);
    __builtin_amdgcn_fence(__ATOMIC_ACQUIRE, "agent");
    asm volatile("s_waitcnt vmcnt(0) lgkmcnt(0)" ::: "memory");
  }
  __syncthreads();
}
#ifndef MINW
#define MINW 2
#endif
__global__ void __launch_bounds__(256, MINW) fwd_mega(P p) {
  extern __shared__ __attribute__((aligned(16))) unsigned char smem[];
  cg::grid_group grid = cg::this_grid();
  const int tid = threadIdx.x;
  float* X = p.out + O_Y;
  bf16_t* Xb = (bf16_t*)(p.ws + A_XB);
  bf16_t* ACT = (bf16_t*)(p.ws + R_ACT);

#ifndef NO_P0
  unsigned* bar = (unsigned*)(p.ws + W_CTR + 1024);
  unsigned epoch = 0;
  phase0(p, smem);
#endif
  grid.sync();
  gsync(bar, epoch);

#pragma unroll 1
  for (int layer = 0; layer < 2; ++layer) {
#pragma unroll 1
    for (int f = 0; f < 2; ++f) {
      if (f == 1) {
        if (layer == 0) {
#ifndef NO_EVENIN
          gemm_phase(Xb, 1024, (const bf16_t*)(p.ws + W_EVEN_IN), 1024, 29, EpiEvenIn{p}, smem);
#endif
          gsync(bar, epoch);
#ifndef NO_CUM
          if (blockIdx.x < 2) cumsum_prompt(p, blockIdx.x, smem);
#endif
#ifndef NO_PREP
          for (int it = blockIdx.x; it < NPREP; it += gridDim.x) gdn_prep_item(p, it, smem);
#endif
          gsync(bar, epoch);
          {
            unsigned* ctr = (unsigned*)(p.ws + W_CTR);
            int* sh = (int*)(smem + LDS_BYTES - 16);
            for (;;) {
              if (tid == 0) *sh = (int)atomicAdd(ctr, 1u);
              __syncthreads();
              const int it = *sh;
              __syncthreads();
              if (it >= 64 + 2048 + 64 + 256) break;
#ifndef NO_SCAN
              if (it < 64) gdn_scan_chain(p, it, smem);
#else
              if (it < 64) {}
#endif
#ifndef NO_ATTN
              else if (it < 64 + 2048) { const int a = it - 64; attn_prompt_item(p, a & 15, 127 - (a >> 4), smem); }
#endif
#ifndef NO_ATTNS
              else if (it < 64 + 2048 + 64) attn_sample_item(p, it - 64 - 2048, smem);
#endif
#ifndef NO_SCAN
              else gdn_scan_chain(p, 64 + (it - 64 - 2048 - 64), smem);
#endif
            }
          }
          gsync(bar, epoch);
          gdn_gate_phase(p);
          gsync(bar, epoch);
          gemm_phase((const bf16_t*)(p.ws + R_MIX), 1024, (const bf16_t*)(p.ws + W_EVEN_OUT), 1024, 8, EpiElem<FResid>{FResid{X, 1.0f}}, smem);
          gsync(bar, epoch);
        } else {
          gemm_phase(Xb, 1024, (const bf16_t*)(p.ws + W_ODD_IN), 1024, 8, EpiElem<FStoreF32>{FStoreF32{(float*)(p.ws + R_U)}}, smem);
          gsync(bar, epoch);
#ifndef NO_S5
          for (int it = blockIdx.x; it < 2048; it += gridDim.x) if (((it >> 4) & 63) != 63) s5_item<1>(p, it, smem);
#endif
          gsync(bar, epoch);
#ifndef NO_S5
          for (int it = blockIdx.x; it < 2048 + 128; it += gridDim.x) s5_item<2>(p, it, smem);
#endif
          gsync(bar, epoch);
          gemm_phase((const bf16_t*)(p.ws + R_ZZB), 1024, (const bf16_t*)(p.ws + W_GLU), 1024, 8,
                     EpiElem<FGlu>{FGlu{(const bf16_t*)(p.ws + R_ZZB), p.in[30], (bf16_t*)(p.ws + A_GATED)}}, smem);
          gsync(bar, epoch);
          gemm_phase((const bf16_t*)(p.ws + A_GATED), 1024, (const bf16_t*)(p.ws + W_ODD_OUT), 1024, 8, EpiElem<FResid>{FResid{X, 1.0f}}, smem);
          gsync(bar, epoch);
        }
        ln_phase(X, Xb, p.in[11] + (layer * 3 + 1) * D, p.in[12] + (layer * 3 + 1) * D, true);
        gsync(bar, epoch);
      }
      const int idx = layer * 2 + f;
      gemm_phase(Xb, 1024, (const bf16_t*)(p.ws + W_FFN_IN + idx * SZ_FFN_IN), 1024, 44, EpiSwiglu{ACT}, smem);
      gsync(bar, epoch);
      gemm_phase(ACT, DFF, (const bf16_t*)(p.ws + W_FFN_OUT + idx * SZ_FFN_OUT), DFF, 8, EpiElem<FResid>{FResid{X, 0.5f}}, smem);
      gsync(bar, epoch);
      const bool last = (layer == 1 && f == 1);
      ln_phase(X, Xb, p.in[11] + (layer * 3 + f * 2) * D, p.in[12] + (layer * 3 + f * 2) * D, !last);
      if (!last) gsync(bar, epoch);
    }
  }
}

extern "C" void kernel_launch(void* const* d_in, const int* in_sizes, int n_in, void* d_out, int out_size, void* d_ws, size_t ws_size,
                              hipStream_t stream) {
  static int grid_blocks = 0;
  if (grid_blocks == 0) {
    int dev = 0, cus = 0, per_cu = 0;
    (void)hipGetDevice(&dev);
    (void)hipDeviceGetAttribute(&cus, hipDeviceAttributeMultiprocessorCount, dev);
    if (hipFuncSetAttribute((const void*)fwd_mega, hipFuncAttributeMaxDynamicSharedMemorySize, LDS_BYTES) != hipSuccess) {
      fprintf(stderr, "hipFuncSetAttribute failed\n");
    }
    (void)hipOccupancyMaxActiveBlocksPerMultiprocessor(&per_cu, (const void*)fwd_mega, 256, LDS_BYTES);
    if (per_cu < 1) per_cu = 1;
    if (per_cu > MINW) per_cu = MINW;
    grid_blocks = cus * per_cu;
    if (ws_size < WS_NEED) fprintf(stderr, "workspace too small: %zu < %zu\n", ws_size, (size_t)WS_NEED);
  }
  P p{};
  for (int i = 0; i < 32; ++i) p.in[i] = (const float*)d_in[i];
  p.out = (float*)d_out;
  p.ws = (unsigned char*)d_ws;
  (void)hipMemsetAsync((unsigned char*)d_ws + W_CTR + 1024, 0, 256, stream);
  void* args[] = {&p};
  hipError_t e = hipLaunchCooperativeKernel((const void*)fwd_mega, dim3(grid_blocks), dim3(256), args, LDS_BYTES, stream);
  if (e != hipSuccess) fprintf(stderr, "cooperative launch failed: %s (grid %d)\n", hipGetErrorString(e), grid_blocks);
}
```

```cpp
#include <hip/hip_runtime.h>
#include <hip/hip_cooperative_groups.h>
#include <cstdio>
#include <cstdint>
namespace cg = cooperative_groups;

typedef unsigned short bf16_t;
typedef short bf16x8 __attribute__((ext_vector_type(8)));
typedef short bf16x4 __attribute__((ext_vector_type(4)));
typedef float f32x4 __attribute__((ext_vector_type(4)));
typedef float f32x2 __attribute__((ext_vector_type(2)));
typedef float f32x16 __attribute__((ext_vector_type(16)));
typedef unsigned u32x4 __attribute__((ext_vector_type(4)));
typedef unsigned u32x2 __attribute__((ext_vector_type(2)));

#define DEV __device__ __forceinline__

constexpr int D = 1024, T = 16384, MP = 32768, MS = 256, M = MP + MS, DFF = 2816;
constexpr int MT = M / 128;
constexpr float ALPHA = 1.41421356237f;
constexpr float LOG2E = 1.44269504089f;
constexpr int LDS_BYTES = 73728;
constexpr int NPREP = 2048 + 32;

constexpr size_t O_Y = 0;
constexpr size_t O_FKP = 33816576, O_FVP = 50593792, O_FLP = 67371008, O_GSP = 67633152, O_GCP = 67764224;
constexpr size_t O_S5RP = 67773440, O_S5IP = 67781632, O_FKS = 67789824, O_FVS = 67920896, O_FLS = 68051968;
constexpr size_t O_GSS = 68054016, O_GCS = 68578304, O_S5RS = 68615168, O_S5IS = 68647936;

constexpr size_t MB = 1u << 20;
constexpr size_t W_FFN_IN = 0;
constexpr size_t SZ_FFN_IN = (size_t)5632 * 1024 * 2;
constexpr size_t W_FFN_OUT = W_FFN_IN + 4 * SZ_FFN_IN;
constexpr size_t SZ_FFN_OUT = (size_t)1024 * 2816 * 2;
constexpr size_t W_EVEN_IN = W_FFN_OUT + 4 * SZ_FFN_OUT;
constexpr size_t W_EVEN_OUT = W_EVEN_IN + (size_t)3712 * 1024 * 2;
constexpr size_t W_ODD_IN = W_EVEN_OUT + 2 * MB;
constexpr size_t W_GLU = W_ODD_IN + 2 * MB;
constexpr size_t W_ODD_OUT = W_GLU + 2 * MB;
constexpr size_t W_S5B = W_ODD_OUT + 2 * MB;
constexpr size_t W_S5C = W_S5B + 262144;
constexpr size_t W_LAMB = W_S5C + 262144;
constexpr size_t W_LAM256 = W_LAMB + 32768;
constexpr size_t W_CTR = W_LAM256 + 32768;
constexpr size_t W_END = W_CTR + 4096;
static_assert(W_END < 90 * MB, "weights region");
constexpr size_t A_XB = 90 * MB;
constexpr size_t SZ_XB = (size_t)M * 1024 * 2;
constexpr size_t A_PW = A_XB;
constexpr size_t A_PQG = A_PW + (size_t)NPREP * 8192 * 2;
constexpr size_t A_PKDT = A_PQG + (size_t)NPREP * 8192 * 2;
constexpr size_t A_PUT = A_PKDT + (size_t)NPREP * 8192 * 2;
constexpr size_t A_PATT = A_PUT + (size_t)NPREP * 8192 * 2;
constexpr size_t A_PGL = A_PATT + (size_t)NPREP * 4096 * 2;
constexpr size_t A_PEND = A_PGL + 16384;
constexpr size_t A_GATED = A_XB + 70 * MB;
static_assert(A_PEND < 90 * MB + 154 * MB, "prep region");
static_assert(A_GATED + SZ_XB < 90 * MB + 154 * MB, "gated region");
constexpr size_t R0 = 244 * MB;
constexpr size_t R_ACT = R0;
constexpr size_t R_MIX = R0;
constexpr size_t R_KB = R_MIX + SZ_XB;
constexpr size_t R_VT = R_KB + (size_t)M * 512 * 2;
constexpr size_t R_GB = R_VT + (size_t)16 * 64 * 16384 * 2;
constexpr size_t R_LOGF = R_GB + (size_t)M * 1536 * 2;
constexpr size_t R_CUM = R_LOGF + (size_t)M * 8 * 4;
constexpr size_t R_GG = R_CUM + (size_t)M * 8 * 4;
constexpr size_t R_BETA = R_GG + (size_t)M * 4 * 4;
constexpr size_t R_QS = R_BETA + (size_t)M * 4 * 4;
constexpr size_t R_EVEN_END = R_QS + (size_t)256 * 512 * 4;
constexpr size_t R_U = R0;
constexpr size_t R_ZZB = R_U + (size_t)M * 1024 * 4;
constexpr size_t R_E = R_ZZB + SZ_XB;
constexpr size_t R_ODD_END = R_E + (size_t)2 * 64 * 4096 * 8;
constexpr size_t WS_NEED = 490 * MB;
static_assert(R_EVEN_END < WS_NEED && R_ODD_END < WS_NEED && R_ACT + (size_t)M * DFF * 2 < WS_NEED, "ws");

struct P {
  const float* in[32];
  float* out;
  unsigned char* ws;
};

DEV int ltid() { int t = threadIdx.x; asm volatile("" : "+v"(t)); return t; }
typedef __bf16 hbf16x2 __attribute__((ext_vector_type(2)));
DEV unsigned pack2(float a, float b) {
  f32x2 v = {a, b};
  hbf16x2 h = __builtin_convertvector(v, hbf16x2);
  return __builtin_bit_cast(unsigned, h);
}
DEV bf16_t f2bf(float f) { return (bf16_t)(pack2(f, 0.f) & 0xffffu); }
DEV float bf2f(bf16_t h) { return __uint_as_float(((unsigned)h) << 16); }
DEV float fexp2(float x) { return __builtin_amdgcn_exp2f(x); }
DEV float frcp(float x) { return __builtin_amdgcn_rcpf(x); }
DEV float silu_f(float x) { return x * frcp(1.f + fexp2(-LOG2E * x)); }
DEV float sigmoid_f(float x) { return frcp(1.f + fexp2(-LOG2E * x)); }
DEV float softplus_f(float x) { return fmaxf(x, 0.f) + log1pf(__expf(-fabsf(x))); }
DEV float gelu_tanh(float x) {
  float u = 0.7978845608028654f * (x + 0.044715f * x * x * x);
  float t = 1.f - 2.f / (1.f + __expf(2.f * u));
  return 0.5f * x * (1.f + t);
}
DEV float wave_sum(float v) {
#pragma unroll
  for (int o = 32; o >= 1; o >>= 1) v += __shfl_xor(v, o);
  return v;
}
DEV float wave_max(float v) {
#pragma unroll
  for (int o = 32; o >= 1; o >>= 1) v = fmaxf(v, __shfl_xor(v, o));
  return v;
}
DEV f32x16 mfma32(bf16x8 a, bf16x8 b, f32x16 c) { return __builtin_amdgcn_mfma_f32_32x32x16_bf16(a, b, c, 0, 0, 0); }
DEV f32x4 mfma16(bf16x8 a, bf16x8 b, f32x4 c) { return __builtin_amdgcn_mfma_f32_16x16x32_bf16(a, b, c, 0, 0, 0); }

struct MapId { DEV int operator()(int n) const { return n; } };
struct MapFfnIn {
  DEV int operator()(int n) const {
    int t = n >> 7, w = n & 127;
    int wn = w >> 6, nt = (w >> 5) & 1, c = w & 31;
    return nt * DFF + t * 64 + wn * 32 + c;
  }
};
struct MapEvenIn {
  DEV int operator()(int n) const {
    if (n < 1536) return n;
    if (n < 3072) return 1544 + (n - 1536);
    if (n < 3584) return 3088 + (n - 3072);
    if (n < 3592) return 1536 + (n - 3584);
    if (n < 3600) return 3080 + (n - 3592);
    return -1;
  }
};

template <class Map>
DEV void conv_t(const float* __restrict__ src, int Nsrc, int K, bf16_t* __restrict__ dst, int Np, Map map, unsigned char* smem) {
  float* tile = (float*)smem;
  const int tid = ltid();
  const int ntn = Np >> 6, ntk = K >> 6;
  for (int t = blockIdx.x; t < ntn * ntk; t += gridDim.x) {
    const int tn = t % ntn, tk = t / ntn;
    {
      const int c = tid & 63, r0 = tid >> 6;
      const int sc = map(tn * 64 + c);
#pragma unroll
      for (int i = 0; i < 16; ++i) {
        const int k = tk * 64 + r0 + 4 * i;
        tile[(r0 + 4 * i) * 65 + c] = (sc >= 0) ? src[(size_t)k * Nsrc + sc] : 0.f;
      }
    }
    __syncthreads();
    {
      const int kk = tid & 63, n0 = tid >> 6;
#pragma unroll
      for (int i = 0; i < 16; ++i) {
        const int n = n0 + 4 * i;
        dst[(size_t)(tn * 64 + n) * K + tk * 64 + kk] = f2bf(tile[kk * 65 + n]);
      }
    }
    __syncthreads();
  }
}

DEV void phase0(const P& p, unsigned char* smem) {
  const int tid = ltid();
  const size_t gt = (size_t)blockIdx.x * 256 + tid, gn = (size_t)gridDim.x * 256;
  {
    float* X = p.out + O_Y;
    bf16_t* Xb = (bf16_t*)(p.ws + A_XB);
    const size_t n4p = (size_t)MP * D / 4, n4 = (size_t)M * D / 4;
    for (size_t i = gt; i < n4; i += gn) {
      f32x4 v = (i < n4p) ? ((const f32x4*)p.in[0])[i] : ((const f32x4*)p.in[1])[i - n4p];
      ((f32x4*)X)[i] = v;
      u32x2 o; o[0] = pack2(v[0], v[1]); o[1] = pack2(v[2], v[3]);
      ((u32x2*)Xb)[i] = o;
    }
  }
  for (int l = 0; l < 2; ++l)
    for (int f = 0; f < 2; ++f) {
      const int idx = l * 2 + f;
      conv_t(p.in[9] + (size_t)idx * 1024 * 5632, 5632, 1024, (bf16_t*)(p.ws + W_FFN_IN + idx * SZ_FFN_IN), 5632, MapFfnIn(), smem);
      conv_t(p.in[10] + (size_t)idx * 2816 * 1024, 1024, 2816, (bf16_t*)(p.ws + W_FFN_OUT + idx * SZ_FFN_OUT), 1024, MapId(), smem);
    }
  conv_t(p.in[13], 3600, 1024, (bf16_t*)(p.ws + W_EVEN_IN), 3712, MapEvenIn(), smem);
  conv_t(p.in[19], 1024, 1024, (bf16_t*)(p.ws + W_EVEN_OUT), 1024, MapId(), smem);
  conv_t(p.in[20], 1024, 1024, (bf16_t*)(p.ws + W_ODD_IN), 1024, MapId(), smem);
  conv_t(p.in[29], 1024, 1024, (bf16_t*)(p.ws + W_GLU), 1024, MapId(), smem);
  conv_t(p.in[31], 1024, 1024, (bf16_t*)(p.ws + W_ODD_OUT), 1024, MapId(), smem);
  if (gt < 4096) {
    const int g = (int)gt >> 6, pp = (int)gt & 63;
    const float step = expf(p.in[23][g]);
    const float lr = p.in[21][gt], li = p.in[22][gt];
    const float a = lr * step, b = li * step;
    const float ea = expf(a);
    float sb, cb; sincosf(b, &sb, &cb);
    const float lbr = ea * cb, lbi = ea * sb;
    const float sh = sinf(0.5f * b);
    const float nr = expm1f(a) * cb - 2.f * sh * sh, ni = lbi;
    const float dd = lr * lr + li * li;
    const float cr = (nr * lr + ni * li) / dd, ci = (ni * lr - nr * li) / dd;
    bf16_t* Bp = (bf16_t*)(p.ws + W_S5B);
    bf16_t* Cp = (bf16_t*)(p.ws + W_S5C);
    for (int c = 0; c < 16; ++c) {
      const float br = p.in[24][gt * 16 + c], bi = p.in[25][gt * 16 + c];
      Bp[((size_t)g * 128 + pp) * 16 + c] = f2bf(cr * br - ci * bi);
      Bp[((size_t)g * 128 + 64 + pp) * 16 + c] = f2bf(cr * bi + ci * br);
      Cp[((size_t)g * 16 + c) * 128 + pp] = f2bf(p.in[26][((size_t)g * 16 + c) * 64 + pp]);
      Cp[((size_t)g * 16 + c) * 128 + 64 + pp] = f2bf(-p.in[27][((size_t)g * 16 + c) * 64 + pp]);
    }
    ((f32x2*)(p.ws + W_LAMB))[gt] = (f32x2){lbr, lbi};
    float xr = lbr, xi = lbi;
    for (int i = 0; i < 8; ++i) { const float nr2 = xr * xr - xi * xi, ni2 = 2.f * xr * xi; xr = nr2; xi = ni2; }
    ((f32x2*)(p.ws + W_LAM256))[gt] = (f32x2){xr, xi};
  }
  if (gt < 64) ((unsigned*)(p.ws + W_CTR))[gt] = 0u;
}

template <class Epi>
DEV void gemm_phase(const bf16_t* __restrict__ A, int lda, const bf16_t* __restrict__ Wt, int K, int NT, Epi epi, unsigned char* smem) {
  const int tid = ltid(), lane = tid & 63, wave = tid >> 6, wm = wave >> 1, wn = wave & 1;
  const int r = lane & 31, hh = lane >> 5;
  bf16_t* As = (bf16_t*)smem;
  bf16_t* Bs = As + 2 * 128 * 72;
  const int nk = K >> 6;
  const int total = MT * NT;
  const int lrow = tid >> 3, lcc = tid & 7;
  for (int t = blockIdx.x; t < total; t += gridDim.x) {
    const int band = t / (43 * NT), rem = t - band * 43 * NT;
    const int tn = rem / 43, tm = band * 43 + (rem - tn * 43);
    const bf16_t* Ag = A + (size_t)(tm * 128 + lrow) * lda + lcc * 8;
    const bf16_t* Bg = Wt + (size_t)(tn * 128 + lrow) * K + lcc * 8;
    f32x16 acc[2][2];
#pragma unroll
    for (int i = 0; i < 2; ++i)
#pragma unroll
      for (int j = 0; j < 2; ++j)
#pragma unroll
        for (int q = 0; q < 16; ++q) acc[i][j][q] = 0.f;
    u32x4 ra[4], rb[4];
#pragma unroll
    for (int i = 0; i < 4; ++i) {
      ra[i] = *(const u32x4*)(Ag + (size_t)(32 * i) * lda);
      rb[i] = *(const u32x4*)(Bg + (size_t)(32 * i) * K);
    }
    for (int kt = 0; kt < nk; ++kt) {
      bf16_t* as = As + (kt & 1) * 128 * 72;
      bf16_t* bs = Bs + (kt & 1) * 128 * 72;
#pragma unroll
      for (int i = 0; i < 4; ++i) {
        *(u32x4*)(as + (lrow + 32 * i) * 72 + lcc * 8) = ra[i];
        *(u32x4*)(bs + (lrow + 32 * i) * 72 + lcc * 8) = rb[i];
      }
      __syncthreads();
      if (kt + 1 < nk) {
#pragma unroll
        for (int i = 0; i < 4; ++i) {
          ra[i] = *(const u32x4*)(Ag + (size_t)(32 * i) * lda + (kt + 1) * 64);
          rb[i] = *(const u32x4*)(Bg + (size_t)(32 * i) * K + (kt + 1) * 64);
        }
      }
#pragma unroll
      for (int ks = 0; ks < 4; ++ks) {
        bf16x8 af[2], bfr[2];
#pragma unroll
        for (int i = 0; i < 2; ++i) {
          af[i] = *(const bf16x8*)(as + (wm * 64 + i * 32 + r) * 72 + ks * 16 + hh * 8);
          bfr[i] = *(const bf16x8*)(bs + (wn * 64 + i * 32 + r) * 72 + ks * 16 + hh * 8);
        }
#pragma unroll
        for (int i = 0; i < 2; ++i)
#pragma unroll
          for (int j = 0; j < 2; ++j) acc[i][j] = mfma32(af[i], bfr[j], acc[i][j]);
      }
    }
    epi(acc, tm * 128 + wm * 64, tn, wn, lane);
    __syncthreads();
  }
}

struct EpiSwiglu {
  bf16_t* act;
  DEV void operator()(const f32x16 (&acc)[2][2], int row0, int tn, int wn, int lane) const {
    const int r = lane & 31, hh = lane >> 5;
    const int col = tn * 64 + wn * 32 + r;
#pragma unroll
    for (int mt = 0; mt < 2; ++mt)
#pragma unroll
      for (int q = 0; q < 16; ++q) {
        const int row = row0 + mt * 32 + (q & 3) + 8 * (q >> 2) + 4 * hh;
        const float a = acc[mt][0][q], b = acc[mt][1][q];
        act[(size_t)row * DFF + col] = f2bf(silu_f(a) * b);
      }
  }
};
template <class F>
struct EpiElem {
  F f;
  DEV void operator()(const f32x16 (&acc)[2][2], int row0, int tn, int wn, int lane) const {
    const int r = lane & 31, hh = lane >> 5;
#pragma unroll
    for (int mt = 0; mt < 2; ++mt)
#pragma unroll
      for (int nt = 0; nt < 2; ++nt)
#pragma unroll
        for (int q = 0; q < 16; ++q) {
          const int row = row0 + mt * 32 + (q & 3) + 8 * (q >> 2) + 4 * hh;
          const int col = tn * 128 + wn * 64 + nt * 32 + r;
          f(row, col, acc[mt][nt][q]);
        }
  }
};
struct FResid {
  float* X; float scale;
  DEV void operator()(int row, int col, float v) const {
    float* px = X + (size_t)row * D + col;
    *px = ALPHA * (*px) + scale * v;
  }
};
struct FStoreF32 {
  float* U;
  DEV void operator()(int row, int col, float v) const { U[(size_t)row * D + col] = v; }
};
struct FGlu {
  const bf16_t* zz; const float* bias; bf16_t* out;
  DEV void operator()(int row, int col, float v) const {
    const size_t i = (size_t)row * D + col;
    out[i] = f2bf(bf2f(zz[i]) * sigmoid_f(v + bias[col]));
  }
};
#define EACH_TILE(FN) FN(acc[0][0], 0, 0); FN(acc[0][1], 0, 1); FN(acc[1][0], 1, 0); FN(acc[1][1], 1, 1);
struct EpiEvenIn {
  P p;
  DEV void operator()(const f32x16 (&acc)[2][2], int row0, int tn, int wn, int lane) const {
    const int r = lane & 31, hh = lane >> 5;
    const bool samp = row0 >= MP;
    const int clb = wn * 64 + r;
    if (tn < 4) {
      bf16_t* MIX = (bf16_t*)(p.ws + R_MIX);
      float* QS = (float*)(p.ws + R_QS);
      auto fn = [&](const f32x16& a, int mt, int nt) {
        const int col = tn * 128 + clb + nt * 32;
#pragma unroll
        for (int q = 0; q < 16; ++q) {
          const int row = row0 + mt * 32 + (q & 3) + 8 * (q >> 2) + 4 * hh;
          MIX[(size_t)row * 1024 + col] = f2bf(a[q]);
          if (samp) QS[(size_t)(row - MP) * 512 + col] = a[q];
        }
      };
      EACH_TILE(fn)
    } else if (tn < 8) {
      bf16_t* KB = (bf16_t*)(p.ws + R_KB);
      float* ok = samp ? (p.out + O_FKS - (size_t)MP * 512) : (p.out + O_FKP);
      auto fn = [&](const f32x16& a, int mt, int nt) {
        const int col = (tn - 4) * 128 + clb + nt * 32;
#pragma unroll
        for (int q = 0; q < 16; ++q) {
          const int row = row0 + mt * 32 + (q & 3) + 8 * (q >> 2) + 4 * hh;
          KB[(size_t)row * 512 + col] = f2bf(a[q]);
          ok[(size_t)row * 512 + col] = a[q];
        }
      };
      EACH_TILE(fn)
    } else if (tn < 12) {
      if (!samp) {
        bf16_t* VT = (bf16_t*)(p.ws + R_VT);
        auto fn = [&](const f32x16& a, int mt, int nt) {
          const int col = (tn - 8) * 128 + clb + nt * 32;
          const int hd = col >> 6, dh = col & 63;
#pragma unroll
          for (int g = 0; g < 4; ++g) {
            const int row = row0 + mt * 32 + 8 * g + 4 * hh;
            const int b = row >> 14, tt = row & (T - 1);
            u32x2 o; o[0] = pack2(a[4 * g], a[4 * g + 1]); o[1] = pack2(a[4 * g + 2], a[4 * g + 3]);
            *(u32x2*)(VT + ((size_t)(b * 8 + hd) * 64 + dh) * T + tt) = o;
#pragma unroll
            for (int e = 0; e < 4; ++e) p.out[O_FVP + (size_t)(row + e) * 512 + col] = a[4 * g + e];
          }
        };
        EACH_TILE(fn)
      } else {
        auto fn = [&](const f32x16& a, int mt, int nt) {
          const int col = (tn - 8) * 128 + clb + nt * 32;
#pragma unroll
          for (int q = 0; q < 16; ++q) {
            const int row = row0 + mt * 32 + (q & 3) + 8 * (q >> 2) + 4 * hh;
            p.out[O_FVS + (size_t)(row - MP) * 512 + col] = a[q];
          }
        };
        EACH_TILE(fn)
      }
    } else if (tn < 24) {
      bf16_t* GB = (bf16_t*)(p.ws + R_GB);
      auto fn = [&](const f32x16& a, int mt, int nt) {
        const int col = (tn - 12) * 128 + clb + nt * 32;
#pragma unroll
        for (int q = 0; q < 16; ++q) {
          const int row = row0 + mt * 32 + (q & 3) + 8 * (q >> 2) + 4 * hh;
          const float v = a[q];
          GB[(size_t)row * 1536 + col] = f2bf(v);
          if (!samp) {
            const int tt = row & (T - 1);
            if (tt >= T - 3) p.out[O_GCP + (size_t)((row >> 14) * 3 + (tt - (T - 3))) * 1536 + col] = v;
          } else {
            const int tt = (row - MP) & 31;
            if (tt >= 29) p.out[O_GCS + (size_t)(((row - MP) >> 5) * 3 + (tt - 29)) * 1536 + col] = v;
          }
        }
      };
      EACH_TILE(fn)
    } else if (tn < 28) {
      bf16_t* MIX = (bf16_t*)(p.ws + R_MIX);
      auto fn = [&](const f32x16& a, int mt, int nt) {
        const int col = (tn - 24) * 128 + clb + nt * 32;
#pragma unroll
        for (int q = 0; q < 16; ++q) {
          const int row = row0 + mt * 32 + (q & 3) + 8 * (q >> 2) + 4 * hh;
          MIX[(size_t)row * 1024 + 512 + col] = f2bf(a[q]);
        }
      };
      EACH_TILE(fn)
    } else {
      float* LOGF = (float*)(p.ws + R_LOGF);
      float* GG = (float*)(p.ws + R_GG);
      float* BETA = (float*)(p.ws + R_BETA);
      if (wn == 0 && r < 16) {
        const int cl = r;
        float* ol = samp ? (p.out + O_FLS - (size_t)MP * 8) : (p.out + O_FLP);
        const float bias = (cl < 8) ? p.in[14][cl] : ((cl < 12) ? p.in[17][cl - 8] : 0.f);
        const float ea = (cl >= 8 && cl < 12) ? __expf(p.in[16][cl - 8]) : 0.f;
        auto fn = [&](const f32x16& a, int mt, int nt) {
          if (nt == 0) {
#pragma unroll
            for (int q = 0; q < 16; ++q) {
              const int row = row0 + mt * 32 + (q & 3) + 8 * (q >> 2) + 4 * hh;
              const float v = a[q];
              if (cl < 8) {
                const float lf = -softplus_f(-(v + bias));
                LOGF[(size_t)row * 8 + cl] = lf;
                ol[(size_t)row * 8 + cl] = lf;
              } else if (cl < 12) {
                GG[(size_t)row * 4 + (cl - 8)] = -ea * softplus_f(v + bias);
              } else {
                BETA[(size_t)row * 4 + (cl - 12)] = sigmoid_f(v);
              }
            }
          }
        };
        EACH_TILE(fn)
      }
    }
  }
};

DEV void ln_phase(float* __restrict__ X, bf16_t* __restrict__ Xb, const float* __restrict__ g, const float* __restrict__ b, bool write_bf) {
  const int tid_ = ltid();
  const int lane = tid_ & 63, wave = tid_ >> 6;
  const int gw = blockIdx.x * 4 + wave, nw = gridDim.x * 4;
  f32x4 gv[4], bv[4];
#pragma unroll
  for (int i = 0; i < 4; ++i) { gv[i] = ((const f32x4*)g)[i * 64 + lane]; bv[i] = ((const f32x4*)b)[i * 64 + lane]; }
  for (int row = gw; row < M; row += nw) {
    f32x4* xr = (f32x4*)(X + (size_t)row * D);
    f32x4 v[4];
    float s = 0.f;
#pragma unroll
    for (int i = 0; i < 4; ++i) { v[i] = xr[i * 64 + lane]; s += (v[i][0] + v[i][1]) + (v[i][2] + v[i][3]); }
    const float mu = wave_sum(s) * (1.f / D);
    float q = 0.f;
#pragma unroll
    for (int i = 0; i < 4; ++i) { v[i] = v[i] - mu; q += (v[i][0] * v[i][0] + v[i][1] * v[i][1]) + (v[i][2] * v[i][2] + v[i][3] * v[i][3]); }
    const float rs = rsqrtf(wave_sum(q) * (1.f / D) + 1e-5f);
#pragma unroll
    for (int i = 0; i < 4; ++i) {
      f32x4 o = v[i] * rs * gv[i] + bv[i];
      xr[i * 64 + lane] = o;
      if (write_bf) {
        u32x2 pk; pk[0] = pack2(o[0], o[1]); pk[1] = pack2(o[2], o[3]);
        ((u32x2*)(Xb + (size_t)row * D))[i * 64 + lane] = pk;
      }
    }
  }
}

DEV void cumsum_prompt(const P& p, int b, unsigned char* smem) {
  const float* LOGF = (const float*)(p.ws + R_LOGF) + (size_t)b * T * 8;
  float* CUM = (float*)(p.ws + R_CUM) + (size_t)b * T * 8;
  float* tot = (float*)smem;
  const int tid = ltid();
  float s[8];
#pragma unroll
  for (int h = 0; h < 8; ++h) s[h] = 0.f;
  for (int i = 0; i < 64; ++i) {
    const f32x4* r = (const f32x4*)(LOGF + (size_t)(tid * 64 + i) * 8);
    f32x4 a = r[0], c = r[1];
    s[0] += a[0]; s[1] += a[1]; s[2] += a[2]; s[3] += a[3]; s[4] += c[0]; s[5] += c[1]; s[6] += c[2]; s[7] += c[3];
  }
#pragma unroll
  for (int h = 0; h < 8; ++h) tot[tid * 8 + h] = s[h];
  __syncthreads();
  if (tid < 8) {
    float run = 0.f;
    for (int i = 0; i < 256; ++i) { const float v = tot[i * 8 + tid]; tot[i * 8 + tid] = run; run += v; }
  }
  __syncthreads();
#pragma unroll
  for (int h = 0; h < 8; ++h) s[h] = tot[tid * 8 + h];
  for (int i = 0; i < 64; ++i) {
    const f32x4* r = (const f32x4*)(LOGF + (size_t)(tid * 64 + i) * 8);
    f32x4 a = r[0], c = r[1];
    s[0] += a[0]; s[1] += a[1]; s[2] += a[2]; s[3] += a[3]; s[4] += c[0]; s[5] += c[1]; s[6] += c[2]; s[7] += c[3];
    f32x4* w = (f32x4*)(CUM + (size_t)(tid * 64 + i) * 8);
    w[0] = (f32x4){s[0], s[1], s[2], s[3]};
    w[1] = (f32x4){s[4], s[5], s[6], s[7]};
  }
  __syncthreads();
}

DEV void gdn_prep_item(const P& p, int item, unsigned char* smem) {
  const int tid = ltid(), lane = tid & 63, wave = tid >> 6;
  float* Kf = (float*)smem;
  float* Qf = Kf + 64 * 132;
  float* gc = Qf + 64 * 132;
  float* bt = gc + 64;
  float* eg = bt + 64;
  float* rk = eg + 64;
  float* rq = rk + 64;
  const bf16_t* GB = (const bf16_t*)(p.ws + R_GB);
  const float* GG = (const float*)(p.ws + R_GG);
  const float* BETA = (const float*)(p.ws + R_BETA);
  const float* cw = p.in[15];
  const bool samp = item >= 2048;
  const int h = item & 3;
  int row0, L; bool has_prev; const float* cbuf = nullptr;
  if (!samp) { const int chunk = (item >> 2) & 255, b = item >> 10; row0 = b * T + chunk * 64; L = 64; has_prev = chunk > 0; }
  else { const int sb = (item - 2048) >> 2; row0 = MP + sb * 32; L = 32; has_prev = false; cbuf = p.in[6] + (size_t)sb * 3 * 1536; }
  auto getx = [&](int i, int colg) -> float {
    if (i >= 0) return (i < L) ? bf2f(GB[(size_t)(row0 + i) * 1536 + colg]) : 0.f;
    if (samp) return cbuf[(3 + i) * 1536 + colg];
    return has_prev ? bf2f(GB[(size_t)(row0 + i) * 1536 + colg]) : 0.f;
  };
  const int c = tid & 127;
  const int half = tid >> 7;
  {
    const int colk = 512 + h * 128 + c, colq = h * 128 + c;
    const float k0 = cw[colk], k1 = cw[1536 + colk], k2 = cw[2 * 1536 + colk], k3 = cw[3 * 1536 + colk];
    const float q0 = cw[colq], q1 = cw[1536 + colq], q2 = cw[2 * 1536 + colq], q3 = cw[3 * 1536 + colq];
    const int i0 = half * 32;
    float a3 = getx(i0 - 3, colk), a2 = getx(i0 - 2, colk), a1 = getx(i0 - 1, colk);
    float b3 = getx(i0 - 3, colq), b2 = getx(i0 - 2, colq), b1 = getx(i0 - 1, colq);
#pragma unroll 8
    for (int ii = 0; ii < 32; ++ii) {
      const int i = i0 + ii;
      const float xa = getx(i, colk), xb = getx(i, colq);
      float ya = k0 * a3 + k1 * a2 + k2 * a1 + k3 * xa;
      float yb = q0 * b3 + q1 * b2 + q2 * b1 + q3 * xb;
      ya = (i < L) ? silu_f(ya) : 0.f;
      yb = (i < L) ? silu_f(yb) : 0.f;
      Kf[i * 132 + c] = ya;
      Qf[i * 132 + c] = yb;
      a3 = a2; a2 = a1; a1 = xa;
      b3 = b2; b2 = b1; b1 = xb;
    }
  }
  __syncthreads();
  for (int i = wave * 16; i < wave * 16 + 16; ++i) {
    const float a0 = Kf[i * 132 + lane], a1 = Kf[i * 132 + 64 + lane];
    const float sk = wave_sum(a0 * a0 + a1 * a1);
    const float b0 = Qf[i * 132 + lane], b1 = Qf[i * 132 + 64 + lane];
    const float sq = wave_sum(b0 * b0 + b1 * b1);
    if (lane == 0) { rk[i] = rsqrtf(sk + 1e-6f); rq[i] = rsqrtf(sq + 1e-6f) * 0.08838834764831845f; }
  }
  if (wave == 0) {
    float gi = (lane < L) ? GG[(size_t)(row0 + lane) * 4 + h] : 0.f;
    const float bi = (lane < L) ? BETA[(size_t)(row0 + lane) * 4 + h] : 0.f;
#pragma unroll
    for (int o = 1; o < 64; o <<= 1) { const float tt = __shfl_up(gi, o); if (lane >= o) gi += tt; }
    gc[lane] = gi; eg[lane] = __expf(gi); bt[lane] = bi;
  }
  __syncthreads();
  {
#pragma unroll 4
    for (int ii = 0; ii < 32; ++ii) {
      const int i = half * 32 + ii;
      Kf[i * 132 + c] *= rk[i];
      Qf[i * 132 + c] *= rq[i];
    }
  }
  __syncthreads();
  bf16_t* PW = (bf16_t*)(p.ws + A_PW) + (size_t)item * 8192;
  bf16_t* PQG = (bf16_t*)(p.ws + A_PQG) + (size_t)item * 8192;
  bf16_t* PKDT = (bf16_t*)(p.ws + A_PKDT) + (size_t)item * 8192;
  bf16_t* PUT = (bf16_t*)(p.ws + A_PUT) + (size_t)item * 8192;
  bf16_t* PATT = (bf16_t*)(p.ws + A_PATT) + (size_t)item * 4096;
  float* PGL = (float*)(p.ws + A_PGL);
  const float gl = gc[63];
  {
#pragma unroll 4
    for (int ii = 0; ii < 32; ++ii) {
      const int i = half * 32 + ii;
      PQG[i * 128 + c] = f2bf(Qf[i * 132 + c] * eg[i]);
    }
#pragma unroll
    for (int j8 = 0; j8 < 4; ++j8) {
      const int j0 = half * 32 + j8 * 8;
      float e[8];
#pragma unroll
      for (int t = 0; t < 8; ++t) e[t] = Kf[(j0 + t) * 132 + c] * __expf(gl - gc[j0 + t]);
      u32x4 o;
      o[0] = pack2(e[0], e[1]); o[1] = pack2(e[2], e[3]); o[2] = pack2(e[4], e[5]); o[3] = pack2(e[6], e[7]);
      *(u32x4*)(PKDT + c * 64 + j0) = o;
    }
    if (tid == 0) PGL[item] = __expf(gl);
  }
  const int ti = tid >> 4, tj = tid & 15;
  {
    float accA[4][4], accN[4][4];
#pragma unroll
    for (int a = 0; a < 4; ++a)
#pragma unroll
      for (int b = 0; b < 4; ++b) { accA[a][b] = 0.f; accN[a][b] = 0.f; }
#pragma unroll 2
    for (int cc = 0; cc < 128; cc += 4) {
      f32x4 qi[4], ki[4], kj[4];
#pragma unroll
      for (int a = 0; a < 4; ++a) {
        qi[a] = *(const f32x4*)(Qf + (ti + 16 * a) * 132 + cc);
        ki[a] = *(const f32x4*)(Kf + (ti + 16 * a) * 132 + cc);
        kj[a] = *(const f32x4*)(Kf + (tj + 16 * a) * 132 + cc);
      }
#pragma unroll
      for (int a = 0; a < 4; ++a)
#pragma unroll
        for (int b = 0; b < 4; ++b) {
          accA[a][b] += qi[a][0] * kj[b][0] + qi[a][1] * kj[b][1] + qi[a][2] * kj[b][2] + qi[a][3] * kj[b][3];
          accN[a][b] += ki[a][0] * kj[b][0] + ki[a][1] * kj[b][1] + ki[a][2] * kj[b][2] + ki[a][3] * kj[b][3];
        }
    }
    __syncthreads();
    float* Nl = Qf;
#pragma unroll
    for (int a = 0; a < 4; ++a)
#pragma unroll
      for (int b = 0; b < 4; ++b) {
        const int i = ti + 16 * a, j = tj + 16 * b;
        const float dec = (j <= i) ? __expf(gc[i] - gc[j]) : 0.f;
        PATT[i * 64 + j] = f2bf((j <= i) ? accA[a][b] * dec : 0.f);
        Nl[i * 68 + j] = (j < i) ? accN[a][b] * bt[i] * dec : 0.f;
      }
  }
  __syncthreads();
  {
    const float* Nl = Qf;
    float col[64];
    if (tid < 128) {
      const int colg = 1024 + h * 128 + c;
      const float w0 = cw[colg], w1 = cw[1536 + colg], w2 = cw[2 * 1536 + colg], w3 = cw[3 * 1536 + colg];
      float x3 = getx(-3, colg), x2 = getx(-2, colg), x1 = getx(-1, colg);
#pragma unroll
      for (int i = 0; i < 64; ++i) {
        const float x = getx(i, colg);
        float y = w0 * x3 + w1 * x2 + w2 * x1 + w3 * x;
        y = (i < L) ? silu_f(y) : 0.f;
        col[i] = y * bt[i];
        x3 = x2; x2 = x1; x1 = x;
      }
    } else {
#pragma unroll
      for (int i = 0; i < 64; ++i) col[i] = Kf[i * 132 + c] * bt[i] * eg[i];
    }
#pragma unroll
    for (int i = 1; i < 64; ++i) {
      float sacc = 0.f;
#pragma unroll
      for (int j4 = 0; j4 < (i + 3) / 4; ++j4) {
        const f32x4 nv = *(const f32x4*)(Nl + i * 68 + j4 * 4);
#pragma unroll
        for (int e = 0; e < 4; ++e)
          if (j4 * 4 + e < i) sacc += nv[e] * col[j4 * 4 + e];
      }
      col[i] -= sacc;
    }
    if (tid < 128) {
#pragma unroll
      for (int j8 = 0; j8 < 8; ++j8) {
        u32x4 o;
        o[0] = pack2(col[j8 * 8 + 0], col[j8 * 8 + 1]); o[1] = pack2(col[j8 * 8 + 2], col[j8 * 8 + 3]);
        o[2] = pack2(col[j8 * 8 + 4], col[j8 * 8 + 5]); o[3] = pack2(col[j8 * 8 + 6], col[j8 * 8 + 7]);
        *(u32x4*)(PUT + c * 64 + j8 * 8) = o;
      }
    } else {
#pragma unroll
      for (int i = 0; i < 64; ++i) PW[i * 128 + c] = f2bf(col[i]);
    }
  }
  __syncthreads();
}

struct GdnFr { bf16x8 w[4], qg[4], att[2], kd[2][2]; u32x2 u; float gl; };
DEV void gdn_load(GdnFr& f, const P& p, int item, int sl, int wave, int lane) {
  const int r16 = lane & 15, q4 = lane >> 4;
  const bf16_t* PW = (const bf16_t*)(p.ws + A_PW) + (size_t)item * 8192;
  const bf16_t* PQG = (const bf16_t*)(p.ws + A_PQG) + (size_t)item * 8192;
  const bf16_t* PKDT = (const bf16_t*)(p.ws + A_PKDT) + (size_t)item * 8192;
  const bf16_t* PUT = (const bf16_t*)(p.ws + A_PUT) + (size_t)item * 8192;
  const bf16_t* PATT = (const bf16_t*)(p.ws + A_PATT) + (size_t)item * 4096;
#pragma unroll
  for (int ks = 0; ks < 4; ++ks) {
    f.w[ks] = *(const bf16x8*)(PW + (wave * 16 + r16) * 128 + ks * 32 + q4 * 8);
    f.qg[ks] = *(const bf16x8*)(PQG + (wave * 16 + r16) * 128 + ks * 32 + q4 * 8);
  }
#pragma unroll
  for (int ks = 0; ks < 2; ++ks) {
    f.att[ks] = *(const bf16x8*)(PATT + (wave * 16 + r16) * 64 + ks * 32 + q4 * 8);
#pragma unroll
    for (int mt = 0; mt < 2; ++mt) f.kd[mt][ks] = *(const bf16x8*)(PKDT + (wave * 32 + mt * 16 + r16) * 64 + ks * 32 + q4 * 8);
  }
  f.u = *(const u32x2*)(PUT + (sl * 16 + r16) * 64 + wave * 16 + q4 * 4);
  f.gl = ((const float*)(p.ws + A_PGL))[item];
}

DEV void gdn_scan_chain(const P& p, int chain, unsigned char* smem) {
  const int tid = ltid(), lane = tid & 63, wave = tid >> 6;
  const int r16 = lane & 15, q4 = lane >> 4;
  bf16_t* Sb = (bf16_t*)smem;
  bf16_t* Vn = Sb + 16 * 136;
  float* ORAW = (float*)(p.ws + R_GB);
  int sl, h, nchunks, item0, rowbase, nvalid; float* sout; const float* s0 = nullptr;
  if (chain < 64) { sl = chain & 7; h = (chain >> 3) & 3; const int b = chain >> 5; nchunks = 256; item0 = b * 1024 + h; rowbase = b * T; nvalid = 64;
    sout = p.out + O_GSP + (size_t)(b * 4 + h) * 16384; }
  else { const int cs = chain - 64; sl = cs & 7; h = (cs >> 3) & 3; const int sb = cs >> 5; nchunks = 1; item0 = 2048 + sb * 4 + h; rowbase = MP + sb * 32; nvalid = 32;
    sout = p.out + O_GSS + (size_t)(sb * 4 + h) * 16384; s0 = p.in[5] + (size_t)(sb * 4 + h) * 16384; }
  f32x4 S[2];
#pragma unroll
  for (int mt = 0; mt < 2; ++mt)
#pragma unroll
    for (int e = 0; e < 4; ++e) S[mt][e] = s0 ? s0[(size_t)(wave * 32 + mt * 16 + q4 * 4 + e) * 128 + sl * 16 + r16] : 0.f;
#pragma unroll
  for (int mt = 0; mt < 2; ++mt) {
    u32x2 o; o[0] = pack2(S[mt][0], S[mt][1]); o[1] = pack2(S[mt][2], S[mt][3]);
    *(u32x2*)(Sb + r16 * 136 + wave * 32 + mt * 16 + q4 * 4) = o;
  }
  GdnFr cur, nxt;
  gdn_load(cur, p, item0, sl, wave, lane);
  __syncthreads();
  for (int ch = 0; ch < nchunks; ++ch) {
    if (ch + 1 < nchunks) gdn_load(nxt, p, item0 + (ch + 1) * 4, sl, wave, lane);
    f32x4 ws = {0.f, 0.f, 0.f, 0.f}, qs = {0.f, 0.f, 0.f, 0.f};
#pragma unroll
    for (int ks = 0; ks < 4; ++ks) {
      const bf16x8 sf = *(const bf16x8*)(Sb + r16 * 136 + ks * 32 + q4 * 8);
      ws = mfma16(cur.w[ks], sf, ws);
      qs = mfma16(cur.qg[ks], sf, qs);
    }
    f32x4 vn;
    vn[0] = bf2f((bf16_t)(cur.u[0] & 0xffff)) - ws[0];
    vn[1] = bf2f((bf16_t)(cur.u[0] >> 16)) - ws[1];
    vn[2] = bf2f((bf16_t)(cur.u[1] & 0xffff)) - ws[2];
    vn[3] = bf2f((bf16_t)(cur.u[1] >> 16)) - ws[3];
    {
      u32x2 o; o[0] = pack2(vn[0], vn[1]); o[1] = pack2(vn[2], vn[3]);
      *(u32x2*)(Vn + r16 * 72 + wave * 16 + q4 * 4) = o;
    }
    __syncthreads();
    bf16x8 vf[2];
#pragma unroll
    for (int ks = 0; ks < 2; ++ks) vf[ks] = *(const bf16x8*)(Vn + r16 * 72 + ks * 32 + q4 * 8);
#pragma unroll
    for (int ks = 0; ks < 2; ++ks) qs = mfma16(cur.att[ks], vf[ks], qs);
#pragma unroll
    for (int e = 0; e < 4; ++e) {
      const int i = wave * 16 + q4 * 4 + e;
      if (i < nvalid) ORAW[(size_t)(rowbase + ch * 64 + i) * 512 + h * 128 + sl * 16 + r16] = qs[e];
    }
#pragma unroll
    for (int mt = 0; mt < 2; ++mt) {
      f32x4 sn = S[mt] * cur.gl;
#pragma unroll
      for (int ks = 0; ks < 2; ++ks) sn = mfma16(cur.kd[mt][ks], vf[ks], sn);
      S[mt] = sn;
      u32x2 o; o[0] = pack2(sn[0], sn[1]); o[1] = pack2(sn[2], sn[3]);
      *(u32x2*)(Sb + r16 * 136 + wave * 32 + mt * 16 + q4 * 4) = o;
    }
    __syncthreads();
    if (ch + 1 < nchunks) cur = nxt;
  }
#pragma unroll
  for (int mt = 0; mt < 2; ++mt)
#pragma unroll
    for (int e = 0; e < 4; ++e) sout[(size_t)(wave * 32 + mt * 16 + q4 * 4 + e) * 128 + sl * 16 + r16] = S[mt][e];
  __syncthreads();
}

DEV void attn_prompt_item(const P& p, int bh, int qb, unsigned char* smem) {
  const int tid = ltid(), lane = tid & 63, wave = tid >> 6;
  const int r = lane & 31, hh = lane >> 5;
  const int b = bh >> 3, hd = bh & 7;
  bf16_t* Ks = (bf16_t*)smem;
  bf16_t* Vs = Ks + 2 * 64 * 72;
  float* Bi = (float*)(Vs + 2 * 64 * 72);
  bf16_t* MIX = (bf16_t*)(p.ws + R_MIX);
  const bf16_t* KB = (const bf16_t*)(p.ws + R_KB);
  const bf16_t* VT = (const bf16_t*)(p.ws + R_VT);
  const float* CUM = (const float*)(p.ws + R_CUM);
  const int qpos = qb * 128 + wave * 32 + r;
  const size_t qrow = (size_t)b * T + qpos;
  bf16x8 qf[4];
#pragma unroll
  for (int ks = 0; ks < 4; ++ks) qf[ks] = *(const bf16x8*)(MIX + qrow * 1024 + hd * 64 + ks * 16 + hh * 8);
  f32x16 o[2];
#pragma unroll
  for (int dt = 0; dt < 2; ++dt)
#pragma unroll
    for (int q = 0; q < 16; ++q) o[dt][q] = 0.f;
  float m = -INFINITY, lsum = 0.f;
  const int nkt = qb * 2 + 2;
  const int lrow = tid >> 3, lcc = tid & 7;
  const bf16_t* Kg = KB + ((size_t)b * T + lrow) * 512 + hd * 64 + lcc * 8;
  const bf16_t* Vg = VT + ((size_t)bh * 64 + lrow) * T + lcc * 8;
  u32x4 rk[2], rv[2]; float rbias = 0.f;
#pragma unroll
  for (int i = 0; i < 2; ++i) { rk[i] = *(const u32x4*)(Kg + (size_t)(32 * i) * 512); rv[i] = *(const u32x4*)(Vg + (size_t)(32 * i) * T); }
  if (tid < 64) rbias = -CUM[((size_t)b * T + tid) * 8 + hd] * LOG2E;
  const int qlast = qb * 128 + wave * 32 + 31;
  for (int kt = 0; kt < nkt; ++kt) {
    bf16_t* ks_ = Ks + (kt & 1) * 64 * 72;
    bf16_t* vs_ = Vs + (kt & 1) * 64 * 72;
    float* bi_ = Bi + (kt & 1) * 64;
#pragma unroll
    for (int i = 0; i < 2; ++i) {
      *(u32x4*)(ks_ + (lrow + 32 * i) * 72 + lcc * 8) = rk[i];
      *(u32x4*)(vs_ + (lrow + 32 * i) * 72 + lcc * 8) = rv[i];
    }
    if (tid < 64) bi_[tid] = rbias;
    __syncthreads();
    if (kt + 1 < nkt) {
#pragma unroll
      for (int i = 0; i < 2; ++i) {
        rk[i] = *(const u32x4*)(Kg + (size_t)((kt + 1) * 64 + 32 * i) * 512);
        rv[i] = *(const u32x4*)(Vg + (size_t)(32 * i) * T + (kt + 1) * 64);
      }
      if (tid < 64) rbias = -CUM[((size_t)b * T + (kt + 1) * 64 + tid) * 8 + hd] * LOG2E;
    }
    if (kt * 64 <= qlast) {
      f32x16 s[2];
#pragma unroll
      for (int k2 = 0; k2 < 2; ++k2) {
#pragma unroll
        for (int q = 0; q < 16; ++q) s[k2][q] = 0.f;
#pragma unroll
        for (int ks = 0; ks < 4; ++ks) {
          const bf16x8 kf = *(const bf16x8*)(ks_ + (32 * k2 + r) * 72 + ks * 16 + hh * 8);
          s[k2] = mfma32(kf, qf[ks], s[k2]);
        }
      }
      const bool diag = (kt * 64 + 63 > qb * 128 + wave * 32);
      float mx = -INFINITY;
#pragma unroll
      for (int k2 = 0; k2 < 2; ++k2)
#pragma unroll
        for (int g = 0; g < 4; ++g) {
          const f32x4 bb = *(const f32x4*)(bi_ + 32 * k2 + 8 * g + 4 * hh);
#pragma unroll
          for (int e = 0; e < 4; ++e) {
            float tv = s[k2][4 * g + e] * (0.125f * LOG2E) + bb[e];
            if (diag) { const int key = kt * 64 + 32 * k2 + 8 * g + 4 * hh + e; if (key > qpos) tv = -INFINITY; }
            s[k2][4 * g + e] = tv;
            mx = fmaxf(mx, tv);
          }
        }
      mx = fmaxf(mx, __shfl_xor(mx, 32));
      if (__builtin_amdgcn_ballot_w64(mx > m + 8.f) != 0ull) {
        const float mnew = fmaxf(m, mx);
        const float alpha = fexp2(m - mnew);
        m = mnew;
        lsum *= alpha;
#pragma unroll
        for (int dt = 0; dt < 2; ++dt) o[dt] = o[dt] * alpha;
      }
      float ps = 0.f;
      bf16x8 pb[2][2];
#pragma unroll
      for (int k2 = 0; k2 < 2; ++k2)
#pragma unroll
        for (int s2 = 0; s2 < 2; ++s2) {
          u32x4 pk;
#pragma unroll
          for (int j = 0; j < 4; ++j) {
            const float p0 = fexp2(s[k2][8 * s2 + 2 * j] - m), p1 = fexp2(s[k2][8 * s2 + 2 * j + 1] - m);
            ps += p0 + p1;
            pk[j] = pack2(p0, p1);
          }
          pb[k2][s2] = __builtin_bit_cast(bf16x8, pk);
        }
      lsum += ps;
#pragma unroll
      for (int dt = 0; dt < 2; ++dt) {
#pragma unroll
        for (int k2 = 0; k2 < 2; ++k2)
#pragma unroll
          for (int s2 = 0; s2 < 2; ++s2) {
            const bf16_t* vp = vs_ + (32 * dt + r) * 72 + 32 * k2 + 16 * s2 + 4 * hh;
            const bf16x4 lo = *(const bf16x4*)vp, hi = *(const bf16x4*)(vp + 8);
            bf16x8 vf;
            vf[0] = lo[0]; vf[1] = lo[1]; vf[2] = lo[2]; vf[3] = lo[3]; vf[4] = hi[0]; vf[5] = hi[1]; vf[6] = hi[2]; vf[7] = hi[3];
            o[dt] = mfma32(vf, pb[k2][s2], o[dt]);
          }
      }
    }
  }
  lsum += __shfl_xor(lsum, 32);
  const float inv = 1.f / lsum;
#pragma unroll
  for (int dt = 0; dt < 2; ++dt)
#pragma unroll
    for (int g = 0; g < 4; ++g) {
      u32x2 ov; ov[0] = pack2(o[dt][4 * g] * inv, o[dt][4 * g + 1] * inv); ov[1] = pack2(o[dt][4 * g + 2] * inv, o[dt][4 * g + 3] * inv);
      *(u32x2*)(MIX + qrow * 1024 + hd * 64 + 32 * dt + 8 * g + 4 * hh) = ov;
    }
  __syncthreads();
}

DEV void attn_sample_item(const P& p, int item, unsigned char* smem) {
  const int tid = ltid(), lane = tid & 63, wave = tid >> 6;
  const int sb = item >> 3, hd = item & 7;
  float* cs = (float*)smem;
  float* qs = cs + 1088;
  float* ps = qs + 256;
  const float* ck = p.in[2] + (size_t)sb * 1024 * 512;
  const float* cv = p.in[3] + (size_t)sb * 1024 * 512;
  const float* clf = p.in[4] + (size_t)sb * 1024 * 8;
  const float* nk = p.out + O_FKS + (size_t)sb * 32 * 512;
  const float* nv = p.out + O_FVS + (size_t)sb * 32 * 512;
  const float* nlf = (const float*)(p.ws + R_LOGF) + (size_t)(MP + sb * 32) * 8;
  const float* QS = (const float*)(p.ws + R_QS) + (size_t)sb * 32 * 512;
  bf16_t* MIX = (bf16_t*)(p.ws + R_MIX);
  if (wave == 0) {
    float s = 0.f;
    for (int i = 0; i < 17; ++i) {
      const int j = lane * 17 + i;
      float x = 0.f;
      if (j < 1024) x = clf[(size_t)j * 8 + hd]; else if (j < 1056) x = nlf[(size_t)(j - 1024) * 8 + hd];
      s += x; cs[j] = s;
    }
    float inc = s;
#pragma unroll
    for (int o = 1; o < 64; o <<= 1) { const float tt = __shfl_up(inc, o); if (lane >= o) inc += tt; }
    const float ex = inc - s;
    for (int i = 0; i < 17; ++i) cs[lane * 17 + i] += ex;
  }
  __syncthreads();
  for (int qi = wave; qi < 32; qi += 4) {
    qs[wave * 64 + lane] = QS[(size_t)qi * 512 + hd * 64 + lane];
    __syncthreads();
    const int nkeys = 1024 + qi + 1;
    const float cq = cs[1024 + qi];
    float mx = -INFINITY;
#pragma unroll 1
    for (int n = 0; n < 17; ++n) {
      const int j = lane + 64 * n;
      float sv = -INFINITY;
      if (j < nkeys) {
        const float* kr = (j < 1024) ? (ck + (size_t)j * 512 + hd * 64) : (nk + (size_t)(j - 1024) * 512 + hd * 64);
        float d = 0.f;
#pragma unroll
        for (int c4 = 0; c4 < 16; ++c4) {
          const f32x4 kk = *(const f32x4*)(kr + c4 * 4);
          const f32x4 qq = *(const f32x4*)(qs + wave * 64 + c4 * 4);
          d += kk[0] * qq[0] + kk[1] * qq[1] + kk[2] * qq[2] + kk[3] * qq[3];
        }
        sv = d * 0.125f + cq - cs[j];
      }
      ps[wave * 1088 + j] = sv; mx = fmaxf(mx, sv);
    }
    mx = wave_max(mx);
    float sum = 0.f;
    for (int n = 0; n < 17; ++n) {
      const int j = lane + 64 * n;
      const float pv = (j < nkeys) ? __expf(ps[wave * 1088 + j] - mx) : 0.f;
      sum += pv;
      ps[wave * 1088 + j] = pv;
    }
    sum = wave_sum(sum);
    __syncthreads();
    float acc = 0.f;
#pragma unroll 4
    for (int j = 0; j < nkeys; ++j) {
      const float* vr = (j < 1024) ? (cv + (size_t)j * 512 + hd * 64) : (nv + (size_t)(j - 1024) * 512 + hd * 64);
      acc += ps[wave * 1088 + j] * vr[lane];
    }
    MIX[(size_t)(MP + sb * 32 + qi) * 1024 + hd * 64 + lane] = f2bf(acc / sum);
    __syncthreads();
  }
}

DEV void gdn_gate_phase(const P& p) {
  const int tid_ = ltid();
  const int lane = tid_ & 63, wave = tid_ >> 6;
  const float* ORAW = (const float*)(p.ws + R_GB);
  bf16_t* MIX = (bf16_t*)(p.ws + R_MIX);
  const float* ng = p.in[18];
  const f32x2 g2 = *(const f32x2*)(ng + 2 * lane);
  for (int it = blockIdx.x * 4 + wave; it < M * 4; it += gridDim.x * 4) {
    const int row = it >> 2, h = it & 3;
    const f32x2 ov = *(const f32x2*)(ORAW + (size_t)row * 512 + h * 128 + 2 * lane);
    unsigned* zp = (unsigned*)(MIX + (size_t)row * 1024 + 512 + h * 128 + 2 * lane);
    const unsigned zz = *zp;
    const float z0 = bf2f((bf16_t)(zz & 0xffff)), z1 = bf2f((bf16_t)(zz >> 16));
    const float ss = wave_sum(ov[0] * ov[0] + ov[1] * ov[1]);
    const float rs = rsqrtf(ss * (1.f / 128.f) + 1e-6f);
    *zp = pack2(ov[0] * rs * g2[0] * silu_f(z0), ov[1] * rs * g2[1] * silu_f(z1));
  }
}

template <int PASS>
DEV void s5_item(const P& p, int item, unsigned char* smem) {
  const int tid = ltid(), lane = tid & 63, wave = tid >> 6;
  const int r = lane & 31, hh = lane >> 5, r16 = lane & 15, q4 = lane >> 4;
  bf16_t* HB = (bf16_t*)smem + wave * 64 * 136;
  const float* U = (const float*)(p.ws + R_U);
  bf16_t* ZZB = (bf16_t*)(p.ws + R_ZZB);
  f32x2* E = (f32x2*)(p.ws + R_E);
  const f32x2* LAMB = (const f32x2*)(p.ws + W_LAMB);
  const f32x2* LAM256 = (const f32x2*)(p.ws + W_LAM256);
  const bf16_t* Bp = (const bf16_t*)(p.ws + W_S5B);
  const bf16_t* Cp = (const bf16_t*)(p.ws + W_S5C);
  int g, seq, span, row0, nchunk, ntok; bool samp;
  if (item < 2048) { samp = false; const int gq = item & 15; span = (item >> 4) & 63; seq = item >> 10; g = gq * 4 + wave; row0 = seq * T + span * 256; nchunk = 4; ntok = 64; }
  else { samp = true; const int it = item - 2048; const int gq = it & 15; seq = it >> 4; span = 0; g = gq * 4 + wave; row0 = MP + seq * 32; nchunk = 1; ntok = 32; }
  const f32x2 lam = LAMB[g * 64 + lane];
  float hr = 0.f, hi = 0.f;
  if (PASS == 2) {
    if (samp) { hr = p.in[7][(size_t)(seq * 64 + g) * 64 + lane]; hi = p.in[8][(size_t)(seq * 64 + g) * 64 + lane]; }
    else {
      const f32x2 l256 = LAM256[g * 64 + lane];
      for (int j = 0; j < span; ++j) {
        const f32x2 e = E[((size_t)(seq * 64 + j) * 64 + g) * 64 + lane];
        const float nr = l256[0] * hr - l256[1] * hi + e[0];
        const float ni = l256[0] * hi + l256[1] * hr + e[1];
        hr = nr; hi = ni;
      }
    }
  }
  bf16x8 bfr[4];
#pragma unroll
  for (int nt = 0; nt < 4; ++nt) bfr[nt] = *(const bf16x8*)(Bp + ((size_t)g * 128 + nt * 32 + r) * 16 + hh * 8);
  bf16x8 cfr[4];
#pragma unroll
  for (int ks = 0; ks < 4; ++ks) cfr[ks] = *(const bf16x8*)(Cp + ((size_t)g * 16 + r16) * 128 + ks * 32 + q4 * 8);
  const float dd = p.in[28][g * 16 + r16];
  for (int ch = 0; ch < nchunk; ++ch) {
    const int rowc = row0 + ch * 64;
#pragma unroll
    for (int mt = 0; mt < 2; ++mt) {
      bf16x8 uf;
      if (mt * 32 < ntok) {
        const float* up = U + (size_t)(rowc + mt * 32 + r) * D + g * 16 + hh * 8;
        const f32x4 u0 = *(const f32x4*)up, u1 = *(const f32x4*)(up + 4);
        uf[0] = (short)f2bf(u0[0]); uf[1] = (short)f2bf(u0[1]); uf[2] = (short)f2bf(u0[2]); uf[3] = (short)f2bf(u0[3]);
        uf[4] = (short)f2bf(u1[0]); uf[5] = (short)f2bf(u1[1]); uf[6] = (short)f2bf(u1[2]); uf[7] = (short)f2bf(u1[3]);
      } else {
#pragma unroll
        for (int j = 0; j < 8; ++j) uf[j] = 0;
      }
#pragma unroll
      for (int nt = 0; nt < 4; ++nt) {
        f32x16 acc;
#pragma unroll
        for (int q = 0; q < 16; ++q) acc[q] = 0.f;
        acc = mfma32(uf, bfr[nt], acc);
#pragma unroll
        for (int q = 0; q < 16; ++q) HB[(mt * 32 + (q & 3) + 8 * (q >> 2) + 4 * hh) * 136 + nt * 32 + r] = f2bf(acc[q]);
      }
    }
    __syncthreads();
    for (int t = 0; t < ntok; ++t) {
      const float br = bf2f(HB[t * 136 + lane]), bi = bf2f(HB[t * 136 + 64 + lane]);
      const float nr = lam[0] * hr - lam[1] * hi + br;
      const float ni = lam[0] * hi + lam[1] * hr + bi;
      hr = nr; hi = ni;
      if (PASS == 2) { HB[t * 136 + lane] = f2bf(hr); HB[t * 136 + 64 + lane] = f2bf(hi); }
    }
    __syncthreads();
    if (PASS == 2) {
#pragma unroll
      for (int m4 = 0; m4 < 4; ++m4) {
        if (m4 * 16 < ntok) {
          f32x4 y = {0.f, 0.f, 0.f, 0.f};
#pragma unroll
          for (int ks = 0; ks < 4; ++ks) {
            const bf16x8 hf = *(const bf16x8*)(HB + (m4 * 16 + r16) * 136 + ks * 32 + q4 * 8);
            y = mfma16(hf, cfr[ks], y);
          }
#pragma unroll
          for (int e = 0; e < 4; ++e) {
            const size_t idx = (size_t)(rowc + m4 * 16 + q4 * 4 + e) * D + g * 16 + r16;
            const float yy = y[e] + dd * U[idx];
            ZZB[idx] = f2bf(gelu_tanh(yy));
          }
        }
      }
      __syncthreads();
    }
  }
  if (PASS == 1) E[((size_t)(seq * 64 + span) * 64 + g) * 64 + lane] = (f32x2){hr, hi};
  else {
    if (samp) { p.out[O_S5RS + (size_t)(seq * 64 + g) * 64 + lane] = hr; p.out[O_S5IS + (size_t)(seq * 64 + g) * 64 + lane] = hi; }
    else if (span == 63) { p.out[O_S5RP + (size_t)(seq * 64 + g) * 64 + lane] = hr; p.out[O_S5IP + (size_t)(seq * 64 + g) * 64 + lane] = hi; }
  }
}

DEV void gsync(unsigned* bar, unsigned& epoch) {
  epoch += gridDim.x;
  asm volatile("s_waitcnt vmcnt(0) lgkmcnt(0)" ::: "memory");
  __syncthreads();
  if (threadIdx.x == 0) {
    __builtin_amdgcn_fence(__ATOMIC_RELEASE, "agent");
    __hip_atomic_fetch_add(bar, 1u, __ATOMIC_RELAXED, __HIP_MEMORY_SCOPE_AGENT);
    while (__hip_atomic_load(bar, __ATOMIC_RELAXED, __HIP_MEMORY_SCOPE_AGENT) < epoch) __builtin_amdgcn_s_sleep(1);
    __builtin_amdgcn_fence(__ATOMIC_ACQUIRE, "agent");
    asm volatile("s_waitcnt vmcnt(0) lgkmcnt(0)" ::: "memory");
  }
  __syncthreads();
}
#ifndef MINW
#define MINW 2
#endif
__global__ void __launch_bounds__(256, MINW) fwd_mega(P p) {
  extern __shared__ __attribute__((aligned(16))) unsigned char smem[];
  cg::grid_group grid = cg::this_grid();
  const int tid = threadIdx.x;
  float* X = p.out + O_Y;
  bf16_t* Xb = (bf16_t*)(p.ws + A_XB);
  bf16_t* ACT = (bf16_t*)(p.ws + R_ACT);

#ifndef NO_P0
  unsigned* bar = (unsigned*)(p.ws + W_CTR + 1024);
  unsigned epoch = 0;
  phase0(p, smem);
#endif
  grid.sync();
  gsync(bar, epoch);

#pragma unroll 1
  for (int layer = 0; layer < 2; ++layer) {
#pragma unroll 1
    for (int f = 0; f < 2; ++f) {
      if (f == 1) {
        if (layer == 0) {
#ifndef NO_EVENIN
          gemm_phase(Xb, 1024, (const bf16_t*)(p.ws + W_EVEN_IN), 1024, 29, EpiEvenIn{p}, smem);
#endif
          gsync(bar, epoch);
#ifndef NO_CUM
          if (blockIdx.x < 2) cumsum_prompt(p, blockIdx.x, smem);
#endif
#ifndef NO_PREP
          for (int it = blockIdx.x; it < NPREP; it += gridDim.x) gdn_prep_item(p, it, smem);
#endif
          gsync(bar, epoch);
          {
            unsigned* ctr = (unsigned*)(p.ws + W_CTR);
            int* sh = (int*)(smem + LDS_BYTES - 16);
            for (;;) {
              if (tid == 0) *sh = (int)atomicAdd(ctr, 1u);
              __syncthreads();
              const int it = *sh;
              __syncthreads();
              if (it >= 64 + 2048 + 64 + 256) break;
#ifndef NO_SCAN
              if (it < 64) gdn_scan_chain(p, it, smem);
#else
              if (it < 64) {}
#endif
#ifndef NO_ATTN
              else if (it < 64 + 2048) { const int a = it - 64; attn_prompt_item(p, a & 15, 127 - (a >> 4), smem); }
#endif
#ifndef NO_ATTNS
              else if (it < 64 + 2048 + 64) attn_sample_item(p, it - 64 - 2048, smem);
#endif
#ifndef NO_SCAN
              else gdn_scan_chain(p, 64 + (it - 64 - 2048 - 64), smem);
#endif
            }
          }
          gsync(bar, epoch);
          gdn_gate_phase(p);
          gsync(bar, epoch);
          gemm_phase((const bf16_t*)(p.ws + R_MIX), 1024, (const bf16_t*)(p.ws + W_EVEN_OUT), 1024, 8, EpiElem<FResid>{FResid{X, 1.0f}}, smem);
          gsync(bar, epoch);
        } else {
          gemm_phase(Xb, 1024, (const bf16_t*)(p.ws + W_ODD_IN), 1024, 8, EpiElem<FStoreF32>{FStoreF32{(float*)(p.ws + R_U)}}, smem);
          gsync(bar, epoch);
#ifndef NO_S5
          for (int it = blockIdx.x; it < 2048; it += gridDim.x) if (((it >> 4) & 63) != 63) s5_item<1>(p, it, smem);
#endif
          gsync(bar, epoch);
#ifndef NO_S5
          for (int it = blockIdx.x; it < 2048 + 128; it += gridDim.x) s5_item<2>(p, it, smem);
#endif
          gsync(bar, epoch);
          gemm_phase((const bf16_t*)(p.ws + R_ZZB), 1024, (const bf16_t*)(p.ws + W_GLU), 1024, 8,
                     EpiElem<FGlu>{FGlu{(const bf16_t*)(p.ws + R_ZZB), p.in[30], (bf16_t*)(p.ws + A_GATED)}}, smem);
          gsync(bar, epoch);
          gemm_phase((const bf16_t*)(p.ws + A_GATED), 1024, (const bf16_t*)(p.ws + W_ODD_OUT), 1024, 8, EpiElem<FResid>{FResid{X, 1.0f}}, smem);
          gsync(bar, epoch);
        }
        ln_phase(X, Xb, p.in[11] + (layer * 3 + 1) * D, p.in[12] + (layer * 3 + 1) * D, true);
        gsync(bar, epoch);
      }
      const int idx = layer * 2 + f;
      gemm_phase(Xb, 1024, (const bf16_t*)(p.ws + W_FFN_IN + idx * SZ_FFN_IN), 1024, 44, EpiSwiglu{ACT}, smem);
      gsync(bar, epoch);
      gemm_phase(ACT, DFF, (const bf16_t*)(p.ws + W_FFN_OUT + idx * SZ_FFN_OUT), DFF, 8, EpiElem<FResid>{FResid{X, 0.5f}}, smem);
      gsync(bar, epoch);
      const bool last = (layer == 1 && f == 1);
      ln_phase(X, Xb, p.in[11] + (layer * 3 + f * 2) * D, p.in[12] + (layer * 3 + f * 2) * D, !last);
      if (!last) gsync(bar, epoch);
    }
  }
}

extern "C" void kernel_launch(void* const* d_in, const int* in_sizes, int n_in, void* d_out, int out_size, void* d_ws, size_t ws_size,
                              hipStream_t stream) {
  static int grid_blocks = 0;
  if (grid_blocks == 0) {
    int dev = 0, cus = 0, per_cu = 0;
    (void)hipGetDevice(&dev);
    (void)hipDeviceGetAttribute(&cus, hipDeviceAttributeMultiprocessorCount, dev);
    if (hipFuncSetAttribute((const void*)fwd_mega, hipFuncAttributeMaxDynamicSharedMemorySize, LDS_BYTES) != hipSuccess) {
      fprintf(stderr, "hipFuncSetAttribute failed\n");
    }
    (void)hipOccupancyMaxActiveBlocksPerMultiprocessor(&per_cu, (const void*)fwd_mega, 256, LDS_BYTES);
    if (per_cu < 1) per_cu = 1;
    if (per_cu > MINW) per_cu = MINW;
    grid_blocks = cus * per_cu;
    if (ws_size < WS_NEED) fprintf(stderr, "workspace too small: %zu < %zu\n", ws_size, (size_t)WS_NEED);
  }
  P p{};
  for (int i = 0; i < 32; ++i) p.in[i] = (const float*)d_in[i];
  p.out = (float*)d_out;
  p.ws = (unsigned char*)d_ws;
  (void)hipMemsetAsync((unsigned char*)d_ws + W_CTR + 1024, 0, 256, stream);
  void* args[] = {&p};
  hipError_t e = hipLaunchCooperativeKernel((const void*)fwd_mega, dim3(grid_blocks), dim3(256), args, LDS_BYTES, stream);
  if (e != hipSuccess) fprintf(stderr, "cooperative launch failed: %s (grid %d)\n", hipGetErrorString(e), grid_blocks);
}
```

```cpp
#include <hip/hip_runtime.h>
#include <hip/hip_cooperative_groups.h>
#include <cstdio>
#include <cstdint>
namespace cg = cooperative_groups;

typedef unsigned short bf16_t;
typedef short bf16x8 __attribute__((ext_vector_type(8)));
typedef short bf16x4 __attribute__((ext_vector_type(4)));
typedef float f32x4 __attribute__((ext_vector_type(4)));
typedef float f32x2 __attribute__((ext_vector_type(2)));
typedef float f32x16 __attribute__((ext_vector_type(16)));
typedef unsigned u32x4 __attribute__((ext_vector_type(4)));
typedef unsigned u32x2 __attribute__((ext_vector_type(2)));

#define DEV __device__ __forceinline__

constexpr int D = 1024, T = 16384, MP = 32768, MS = 256, M = MP + MS, DFF = 2816;
constexpr int MT = M / 128;
constexpr float ALPHA = 1.41421356237f;
constexpr float LOG2E = 1.44269504089f;
constexpr int LDS_BYTES = 73728;
constexpr int NPREP = 2048 + 32;

constexpr size_t O_Y = 0;
constexpr size_t O_FKP = 33816576, O_FVP = 50593792, O_FLP = 67371008, O_GSP = 67633152, O_GCP = 67764224;
constexpr size_t O_S5RP = 67773440, O_S5IP = 67781632, O_FKS = 67789824, O_FVS = 67920896, O_FLS = 68051968;
constexpr size_t O_GSS = 68054016, O_GCS = 68578304, O_S5RS = 68615168, O_S5IS = 68647936;

constexpr size_t MB = 1u << 20;
constexpr size_t W_FFN_IN = 0;
constexpr size_t SZ_FFN_IN = (size_t)5632 * 1024 * 2;
constexpr size_t W_FFN_OUT = W_FFN_IN + 4 * SZ_FFN_IN;
constexpr size_t SZ_FFN_OUT = (size_t)1024 * 2816 * 2;
constexpr size_t W_EVEN_IN = W_FFN_OUT + 4 * SZ_FFN_OUT;
constexpr size_t W_EVEN_OUT = W_EVEN_IN + (size_t)3712 * 1024 * 2;
constexpr size_t W_ODD_IN = W_EVEN_OUT + 2 * MB;
constexpr size_t W_GLU = W_ODD_IN + 2 * MB;
constexpr size_t W_ODD_OUT = W_GLU + 2 * MB;
constexpr size_t W_S5B = W_ODD_OUT + 2 * MB;
constexpr size_t W_S5C = W_S5B + 262144;
constexpr size_t W_LAMB = W_S5C + 262144;
constexpr size_t W_LAM256 = W_LAMB + 32768;
constexpr size_t W_CTR = W_LAM256 + 32768;
constexpr size_t W_END = W_CTR + 4096;
static_assert(W_END < 90 * MB, "weights region");
constexpr size_t A_XB = 90 * MB;
constexpr size_t SZ_XB = (size_t)M * 1024 * 2;
constexpr size_t A_PW = A_XB;
constexpr size_t A_PQG = A_PW + (size_t)NPREP * 8192 * 2;
constexpr size_t A_PKDT = A_PQG + (size_t)NPREP * 8192 * 2;
constexpr size_t A_PUT = A_PKDT + (size_t)NPREP * 8192 * 2;
constexpr size_t A_PATT = A_PUT + (size_t)NPREP * 8192 * 2;
constexpr size_t A_PGL = A_PATT + (size_t)NPREP * 4096 * 2;
constexpr size_t A_PEND = A_PGL + 16384;
constexpr size_t A_GATED = A_XB + 70 * MB;
static_assert(A_PEND < 90 * MB + 154 * MB, "prep region");
static_assert(A_GATED + SZ_XB < 90 * MB + 154 * MB, "gated region");
constexpr size_t R0 = 244 * MB;
constexpr size_t R_ACT = R0;
constexpr size_t R_MIX = R0;
constexpr size_t R_KB = R_MIX + SZ_XB;
constexpr size_t R_VT = R_KB + (size_t)M * 512 * 2;
constexpr size_t R_GB = R_VT + (size_t)16 * 64 * 16384 * 2;
constexpr size_t R_LOGF = R_GB + (size_t)M * 1536 * 2;
constexpr size_t R_CUM = R_LOGF + (size_t)M * 8 * 4;
constexpr size_t R_GG = R_CUM + (size_t)M * 8 * 4;
constexpr size_t R_BETA = R_GG + (size_t)M * 4 * 4;
constexpr size_t R_QS = R_BETA + (size_t)M * 4 * 4;
constexpr size_t R_EVEN_END = R_QS + (size_t)256 * 512 * 4;
constexpr size_t R_U = R0;
constexpr size_t R_ZZB = R_U + (size_t)M * 1024 * 4;
constexpr size_t R_E = R_ZZB + SZ_XB;
constexpr size_t R_ODD_END = R_E + (size_t)2 * 64 * 4096 * 8;
constexpr size_t WS_NEED = 490 * MB;
static_assert(R_EVEN_END < WS_NEED && R_ODD_END < WS_NEED && R_ACT + (size_t)M * DFF * 2 < WS_NEED, "ws");

struct P {
  const float* in[32];
  float* out;
  unsigned char* ws;
};

DEV int ltid() { int t = threadIdx.x; asm volatile("" : "+v"(t)); return t; }
typedef __bf16 hbf16x2 __attribute__((ext_vector_type(2)));
DEV unsigned pack2(float a, float b) {
  f32x2 v = {a, b};
  hbf16x2 h = __builtin_convertvector(v, hbf16x2);
  return __builtin_bit_cast(unsigned, h);
}
DEV bf16_t f2bf(float f) { return (bf16_t)(pack2(f, 0.f) & 0xffffu); }
DEV float bf2f(bf16_t h) { return __uint_as_float(((unsigned)h) << 16); }
DEV float fexp2(float x) { return __builtin_amdgcn_exp2f(x); }
DEV float frcp(float x) { return __builtin_amdgcn_rcpf(x); }
DEV float silu_f(float x) { return x * frcp(1.f + fexp2(-LOG2E * x)); }
DEV float sigmoid_f(float x) { return frcp(1.f + fexp2(-LOG2E * x)); }
DEV float softplus_f(float x) { return fmaxf(x, 0.f) + log1pf(__expf(-fabsf(x))); }
DEV float gelu_tanh(float x) {
  float u = 0.7978845608028654f * (x + 0.044715f * x * x * x);
  float t = 1.f - 2.f / (1.f + __expf(2.f * u));
  return 0.5f * x * (1.f + t);
}
DEV float wave_sum(float v) {
#pragma unroll
  for (int o = 32; o >= 1; o >>= 1) v += __shfl_xor(v, o);
  return v;
}
DEV float wave_max(float v) {
#pragma unroll
  for (int o = 32; o >= 1; o >>= 1) v = fmaxf(v, __shfl_xor(v, o));
  return v;
}
DEV f32x16 mfma32(bf16x8 a, bf16x8 b, f32x16 c) { return __builtin_amdgcn_mfma_f32_32x32x16_bf16(a, b, c, 0, 0, 0); }
DEV f32x4 mfma16(bf16x8 a, bf16x8 b, f32x4 c) { return __builtin_amdgcn_mfma_f32_16x16x32_bf16(a, b, c, 0, 0, 0); }

struct MapId { DEV int operator()(int n) const { return n; } };
struct MapFfnIn {
  DEV int operator()(int n) const {
    int t = n >> 7, w = n & 127;
    int wn = w >> 6, nt = (w >> 5) & 1, c = w & 31;
    return nt * DFF + t * 64 + wn * 32 + c;
  }
};
struct MapEvenIn {
  DEV int operator()(int n) const {
    if (n < 1536) return n;
    if (n < 3072) return 1544 + (n - 1536);
    if (n < 3584) return 3088 + (n - 3072);
    if (n < 3592) return 1536 + (n - 3584);
    if (n < 3600) return 3080 + (n - 3592);
    return -1;
  }
};

template <class Map>
DEV void conv_t(const float* __restrict__ src, int Nsrc, int K, bf16_t* __restrict__ dst, int Np, Map map, unsigned char* smem) {
  float* tile = (float*)smem;
  const int tid = ltid();
  const int ntn = Np >> 6, ntk = K >> 6;
  for (int t = blockIdx.x; t < ntn * ntk; t += gridDim.x) {
    const int tn = t % ntn, tk = t / ntn;
    {
      const int c = tid & 63, r0 = tid >> 6;
      const int sc = map(tn * 64 + c);
#pragma unroll
      for (int i = 0; i < 16; ++i) {
        const int k = tk * 64 + r0 + 4 * i;
        tile[(r0 + 4 * i) * 65 + c] = (sc >= 0) ? src[(size_t)k * Nsrc + sc] : 0.f;
      }
    }
    __syncthreads();
    {
      const int kk = tid & 63, n0 = tid >> 6;
#pragma unroll
      for (int i = 0; i < 16; ++i) {
        const int n = n0 + 4 * i;
        dst[(size_t)(tn * 64 + n) * K + tk * 64 + kk] = f2bf(tile[kk * 65 + n]);
      }
    }
    __syncthreads();
  }
}

DEV void phase0(const P& p, unsigned char* smem) {
  const int tid = ltid();
  const size_t gt = (size_t)blockIdx.x * 256 + tid, gn = (size_t)gridDim.x * 256;
  {
    float* X = p.out + O_Y;
    bf16_t* Xb = (bf16_t*)(p.ws + A_XB);
    const size_t n4p = (size_t)MP * D / 4, n4 = (size_t)M * D / 4;
    for (size_t i = gt; i < n4; i += gn) {
      f32x4 v = (i < n4p) ? ((const f32x4*)p.in[0])[i] : ((const f32x4*)p.in[1])[i - n4p];
      ((f32x4*)X)[i] = v;
      u32x2 o; o[0] = pack2(v[0], v[1]); o[1] = pack2(v[2], v[3]);
      ((u32x2*)Xb)[i] = o;
    }
  }
  for (int l = 0; l < 2; ++l)
    for (int f = 0; f < 2; ++f) {
      const int idx = l * 2 + f;
      conv_t(p.in[9] + (size_t)idx * 1024 * 5632, 5632, 1024, (bf16_t*)(p.ws + W_FFN_IN + idx * SZ_FFN_IN), 5632, MapFfnIn(), smem);
      conv_t(p.in[10] + (size_t)idx * 2816 * 1024, 1024, 2816, (bf16_t*)(p.ws + W_FFN_OUT + idx * SZ_FFN_OUT), 1024, MapId(), smem);
    }
  conv_t(p.in[13], 3600, 1024, (bf16_t*)(p.ws + W_EVEN_IN), 3712, MapEvenIn(), smem);
  conv_t(p.in[19], 1024, 1024, (bf16_t*)(p.ws + W_EVEN_OUT), 1024, MapId(), smem);
  conv_t(p.in[20], 1024, 1024, (bf16_t*)(p.ws + W_ODD_IN), 1024, MapId(), smem);
  conv_t(p.in[29], 1024, 1024, (bf16_t*)(p.ws + W_GLU), 1024, MapId(), smem);
  conv_t(p.in[31], 1024, 1024, (bf16_t*)(p.ws + W_ODD_OUT), 1024, MapId(), smem);
  if (gt < 4096) {
    const int g = (int)gt >> 6, pp = (int)gt & 63;
    const float step = expf(p.in[23][g]);
    const float lr = p.in[21][gt], li = p.in[22][gt];
    const float a = lr * step, b = li * step;
    const float ea = expf(a);
    float sb, cb; sincosf(b, &sb, &cb);
    const float lbr = ea * cb, lbi = ea * sb;
    const float sh = sinf(0.5f * b);
    const float nr = expm1f(a) * cb - 2.f * sh * sh, ni = lbi;
    const float dd = lr * lr + li * li;
    const float cr = (nr * lr + ni * li) / dd, ci = (ni * lr - nr * li) / dd;
    bf16_t* Bp = (bf16_t*)(p.ws + W_S5B);
    bf16_t* Cp = (bf16_t*)(p.ws + W_S5C);
    for (int c = 0; c < 16; ++c) {
      const float br = p.in[24][gt * 16 + c], bi = p.in[25][gt * 16 + c];
      Bp[((size_t)g * 128 + pp) * 16 + c] = f2bf(cr * br - ci * bi);
      Bp[((size_t)g * 128 + 64 + pp) * 16 + c] = f2bf(cr * bi + ci * br);
      Cp[((size_t)g * 16 + c) * 128 + pp] = f2bf(p.in[26][((size_t)g * 16 + c) * 64 + pp]);
      Cp[((size_t)g * 16 + c) * 128 + 64 + pp] = f2bf(-p.in[27][((size_t)g * 16 + c) * 64 + pp]);
    }
    ((f32x2*)(p.ws + W_LAMB))[gt] = (f32x2){lbr, lbi};
    float xr = lbr, xi = lbi;
    for (int i = 0; i < 8; ++i) { const float nr2 = xr * xr - xi * xi, ni2 = 2.f * xr * xi; xr = nr2; xi = ni2; }
    ((f32x2*)(p.ws + W_LAM256))[gt] = (f32x2){xr, xi};
  }
  if (gt < 64) ((unsigned*)(p.ws + W_CTR))[gt] = 0u;
}

template <class Epi>
DEV void gemm_phase(const bf16_t* __restrict__ A, int lda, const bf16_t* __restrict__ Wt, int K, int NT, Epi epi, unsigned char* smem) {
  const int tid = ltid(), lane = tid & 63, wave = tid >> 6, wm = wave >> 1, wn = wave & 1;
  const int r = lane & 31, hh = lane >> 5;
  bf16_t* As = (bf16_t*)smem;
  bf16_t* Bs = As + 2 * 128 * 72;
  const int nk = K >> 6;
  const int total = MT * NT;
  const int lrow = tid >> 3, lcc = tid & 7;
  for (int t = blockIdx.x; t < total; t += gridDim.x) {
    const int band = t / (43 * NT), rem = t - band * 43 * NT;
    const int tn = rem / 43, tm = band * 43 + (rem - tn * 43);
    const bf16_t* Ag = A + (size_t)(tm * 128 + lrow) * lda + lcc * 8;
    const bf16_t* Bg = Wt + (size_t)(tn * 128 + lrow) * K + lcc * 8;
    f32x16 acc[2][2];
#pragma unroll
    for (int i = 0; i < 2; ++i)
#pragma unroll
      for (int j = 0; j < 2; ++j)
#pragma unroll
        for (int q = 0; q < 16; ++q) acc[i][j][q] = 0.f;
    u32x4 ra[4], rb[4];
#pragma unroll
    for (int i = 0; i < 4; ++i) {
      ra[i] = *(const u32x4*)(Ag + (size_t)(32 * i) * lda);
      rb[i] = *(const u32x4*)(Bg + (size_t)(32 * i) * K);
    }
    for (int kt = 0; kt < nk; ++kt) {
      bf16_t* as = As + (kt & 1) * 128 * 72;
      bf16_t* bs = Bs + (kt & 1) * 128 * 72;
#pragma unroll
      for (int i = 0; i < 4; ++i) {
        *(u32x4*)(as + (lrow + 32 * i) * 72 + lcc * 8) = ra[i];
        *(u32x4*)(bs + (lrow + 32 * i) * 72 + lcc * 8) = rb[i];
      }
      __syncthreads();
      if (kt + 1 < nk) {
#pragma unroll
        for (int i = 0; i < 4; ++i) {
          ra[i] = *(const u32x4*)(Ag + (size_t)(32 * i) * lda + (kt + 1) * 64);
          rb[i] = *(const u32x4*)(Bg + (size_t)(32 * i) * K + (kt + 1) * 64);
        }
      }
#pragma unroll
      for (int ks = 0; ks < 4; ++ks) {
        bf16x8 af[2], bfr[2];
#pragma unroll
        for (int i = 0; i < 2; ++i) {
          af[i] = *(const bf16x8*)(as + (wm * 64 + i * 32 + r) * 72 + ks * 16 + hh * 8);
          bfr[i] = *(const bf16x8*)(bs + (wn * 64 + i * 32 + r) * 72 + ks * 16 + hh * 8);
        }
#pragma unroll
        for (int i = 0; i < 2; ++i)
#pragma unroll
          for (int j = 0; j < 2; ++j) acc[i][j] = mfma32(af[i], bfr[j], acc[i][j]);
      }
    }
    epi(acc, tm * 128 + wm * 64, tn, wn, lane);
    __syncthreads();
  }
}

struct EpiSwiglu {
  bf16_t* act;
  DEV void operator()(const f32x16 (&acc)[2][2], int row0, int tn, int wn, int lane) const {
    const int r = lane & 31, hh = lane >> 5;
    const int col = tn * 64 + wn * 32 + r;
#pragma unroll
    for (int mt = 0; mt < 2; ++mt)
#pragma unroll
      for (int q = 0; q < 16; ++q) {
        const int row = row0 + mt * 32 + (q & 3) + 8 * (q >> 2) + 4 * hh;
        const float a = acc[mt][0][q], b = acc[mt][1][q];
        act[(size_t)row * DFF + col] = f2bf(silu_f(a) * b);
      }
  }
};
template <class F>
struct EpiElem {
  F f;
  DEV void operator()(const f32x16 (&acc)[2][2], int row0, int tn, int wn, int lane) const {
    const int r = lane & 31, hh = lane >> 5;
#pragma unroll
    for (int mt = 0; mt < 2; ++mt)
#pragma unroll
      for (int nt = 0; nt < 2; ++nt)
#pragma unroll
        for (int q = 0; q < 16; ++q) {
          const int row = row0 + mt * 32 + (q & 3) + 8 * (q >> 2) + 4 * hh;
          const int col = tn * 128 + wn * 64 + nt * 32 + r;
          f(row, col, acc[mt][nt][q]);
        }
  }
};
struct FResid {
  float* X; float scale;
  DEV void operator()(int row, int col, float v) const {
    float* px = X + (size_t)row * D + col;
    *px = ALPHA * (*px) + scale * v;
  }
};
struct FStoreF32 {
  float* U;
  DEV void operator()(int row, int col, float v) const { U[(size_t)row * D + col] = v; }
};
struct FGlu {
  const bf16_t* zz; const float* bias; bf16_t* out;
  DEV void operator()(int row, int col, float v) const {
    const size_t i = (size_t)row * D + col;
    out[i] = f2bf(bf2f(zz[i]) * sigmoid_f(v + bias[col]));
  }
};
#define EACH_TILE(FN) FN(acc[0][0], 0, 0); FN(acc[0][1], 0, 1); FN(acc[1][0], 1, 0); FN(acc[1][1], 1, 1);
struct EpiEvenIn {
  P p;
  DEV void operator()(const f32x16 (&acc)[2][2], int row0, int tn, int wn, int lane) const {
    const int r = lane & 31, hh = lane >> 5;
    const bool samp = row0 >= MP;
    const int clb = wn * 64 + r;
    if (tn < 4) {
      bf16_t* MIX = (bf16_t*)(p.ws + R_MIX);
      float* QS = (float*)(p.ws + R_QS);
      auto fn = [&](const f32x16& a, int mt, int nt) {
        const int col = tn * 128 + clb + nt * 32;
#pragma unroll
        for (int q = 0; q < 16; ++q) {
          const int row = row0 + mt * 32 + (q & 3) + 8 * (q >> 2) + 4 * hh;
          MIX[(size_t)row * 1024 + col] = f2bf(a[q]);
          if (samp) QS[(size_t)(row - MP) * 512 + col] = a[q];
        }
      };
      EACH_TILE(fn)
    } else if (tn < 8) {
      bf16_t* KB = (bf16_t*)(p.ws + R_KB);
      float* ok = samp ? (p.out + O_FKS - (size_t)MP * 512) : (p.out + O_FKP);
      auto fn = [&](const f32x16& a, int mt, int nt) {
        const int col = (tn - 4) * 128 + clb + nt * 32;
#pragma unroll
        for (int q = 0; q < 16; ++q) {
          const int row = row0 + mt * 32 + (q & 3) + 8 * (q >> 2) + 4 * hh;
          KB[(size_t)row * 512 + col] = f2bf(a[q]);
          ok[(size_t)row * 512 + col] = a[q];
        }
      };
      EACH_TILE(fn)
    } else if (tn < 12) {
      if (!samp) {
        bf16_t* VT = (bf16_t*)(p.ws + R_VT);
        auto fn = [&](const f32x16& a, int mt, int nt) {
          const int col = (tn - 8) * 128 + clb + nt * 32;
          const int hd = col >> 6, dh = col & 63;
#pragma unroll
          for (int g = 0; g < 4; ++g) {
            const int row = row0 + mt * 32 + 8 * g + 4 * hh;
            const int b = row >> 14, tt = row & (T - 1);
            u32x2 o; o[0] = pack2(a[4 * g], a[4 * g + 1]); o[1] = pack2(a[4 * g + 2], a[4 * g + 3]);
            *(u32x2*)(VT + ((size_t)(b * 8 + hd) * 64 + dh) * T + tt) = o;
#pragma unroll
            for (int e = 0; e < 4; ++e) p.out[O_FVP + (size_t)(row + e) * 512 + col] = a[4 * g + e];
          }
        };
        EACH_TILE(fn)
      } else {
        auto fn = [&](const f32x16& a, int mt, int nt) {
          const int col = (tn - 8) * 128 + clb + nt * 32;
#pragma unroll
          for (int q = 0; q < 16; ++q) {
            const int row = row0 + mt * 32 + (q & 3) + 8 * (q >> 2) + 4 * hh;
            p.out[O_FVS + (size_t)(row - MP) * 512 + col] = a[q];
          }
        };
        EACH_TILE(fn)
      }
    } else if (tn < 24) {
      bf16_t* GB = (bf16_t*)(p.ws + R_GB);
      auto fn = [&](const f32x16& a, int mt, int nt) {
        const int col = (tn - 12) * 128 + clb + nt * 32;
#pragma unroll
        for (int q = 0; q < 16; ++q) {
          const int row = row0 + mt * 32 + (q & 3) + 8 * (q >> 2) + 4 * hh;
          const float v = a[q];
          GB[(size_t)row * 1536 + col] = f2bf(v);
          if (!samp) {
            const int tt = row & (T - 1);
            if (tt >= T - 3) p.out[O_GCP + (size_t)((row >> 14) * 3 + (tt - (T - 3))) * 1536 + col] = v;
          } else {
            const int tt = (row - MP) & 31;
            if (tt >= 29) p.out[O_GCS + (size_t)(((row - MP) >> 5) * 3 + (tt - 29)) * 1536 + col] = v;
          }
        }
      };
      EACH_TILE(fn)
    } else if (tn < 28) {
      bf16_t* MIX = (bf16_t*)(p.ws + R_MIX);
      auto fn = [&](const f32x16& a, int mt, int nt) {
        const int col = (tn - 24) * 128 + clb + nt * 32;
#pragma unroll
        for (int q = 0; q < 16; ++q) {
          const int row = row0 + mt * 32 + (q & 3) + 8 * (q >> 2) + 4 * hh;
          MIX[(size_t)row * 1024 + 512 + col] = f2bf(a[q]);
        }
      };
      EACH_TILE(fn)
    } else {
      float* LOGF = (float*)(p.ws + R_LOGF);
      float* GG = (float*)(p.ws + R_GG);
      float* BETA = (float*)(p.ws + R_BETA);
      if (wn == 0 && r < 16) {
        const int cl = r;
        float* ol = samp ? (p.out + O_FLS - (size_t)MP * 8) : (p.out + O_FLP);
        const float bias = (cl < 8) ? p.in[14][cl] : ((cl < 12) ? p.in[17][cl - 8] : 0.f);
        const float ea = (cl >= 8 && cl < 12) ? __expf(p.in[16][cl - 8]) : 0.f;
        auto fn = [&](const f32x16& a, int mt, int nt) {
          if (nt == 0) {
#pragma unroll
            for (int q = 0; q < 16; ++q) {
              const int row = row0 + mt * 32 + (q & 3) + 8 * (q >> 2) + 4 * hh;
              const float v = a[q];
              if (cl < 8) {
                const float lf = -softplus_f(-(v + bias));
                LOGF[(size_t)row * 8 + cl] = lf;
                ol[(size_t)row * 8 + cl] = lf;
              } else if (cl < 12) {
                GG[(size_t)row * 4 + (cl - 8)] = -ea * softplus_f(v + bias);
              } else {
                BETA[(size_t)row * 4 + (cl - 12)] = sigmoid_f(v);
              }
            }
          }
        };
        EACH_TILE(fn)
      }
    }
  }
};

DEV void ln_phase(float* __restrict__ X, bf16_t* __restrict__ Xb, const float* __restrict__ g, const float* __restrict__ b, bool write_bf) {
  const int tid_ = ltid();
  const int lane = tid_ & 63, wave = tid_ >> 6;
  const int gw = blockIdx.x * 4 + wave, nw = gridDim.x * 4;
  f32x4 gv[4], bv[4];
#pragma unroll
  for (int i = 0; i < 4; ++i) { gv[i] = ((const f32x4*)g)[i * 64 + lane]; bv[i] = ((const f32x4*)b)[i * 64 + lane]; }
  for (int row = gw; row < M; row += nw) {
    f32x4* xr = (f32x4*)(X + (size_t)row * D);
    f32x4 v[4];
    float s = 0.f;
#pragma unroll
    for (int i = 0; i < 4; ++i) { v[i] = xr[i * 64 + lane]; s += (v[i][0] + v[i][1]) + (v[i][2] + v[i][3]); }
    const float mu = wave_sum(s) * (1.f / D);
    float q = 0.f;
#pragma unroll
    for (int i = 0; i < 4; ++i) { v[i] = v[i] - mu; q += (v[i][0] * v[i][0] + v[i][1] * v[i][1]) + (v[i][2] * v[i][2] + v[i][3] * v[i][3]); }
    const float rs = rsqrtf(wave_sum(q) * (1.f / D) + 1e-5f);
#pragma unroll
    for (int i = 0; i < 4; ++i) {
      f32x4 o = v[i] * rs * gv[i] + bv[i];
      xr[i * 64 + lane] = o;
      if (write_bf) {
        u32x2 pk; pk[0] = pack2(o[0], o[1]); pk[1] = pack2(o[2], o[3]);
        ((u32x2*)(Xb + (size_t)row * D))[i * 64 + lane] = pk;
      }
    }
  }
}

DEV void cumsum_prompt(const P& p, int b, unsigned char* smem) {
  const float* LOGF = (const float*)(p.ws + R_LOGF) + (size_t)b * T * 8;
  float* CUM = (float*)(p.ws + R_CUM) + (size_t)b * T * 8;
  float* tot = (float*)smem;
  const int tid = ltid();
  float s[8];
#pragma unroll
  for (int h = 0; h < 8; ++h) s[h] = 0.f;
  for (int i = 0; i < 64; ++i) {
    const f32x4* r = (const f32x4*)(LOGF + (size_t)(tid * 64 + i) * 8);
    f32x4 a = r[0], c = r[1];
    s[0] += a[0]; s[1] += a[1]; s[2] += a[2]; s[3] += a[3]; s[4] += c[0]; s[5] += c[1]; s[6] += c[2]; s[7] += c[3];
  }
#pragma unroll
  for (int h = 0; h < 8; ++h) tot[tid * 8 + h] = s[h];
  __syncthreads();
  if (tid < 8) {
    float run = 0.f;
    for (int i = 0; i < 256; ++i) { const float v = tot[i * 8 + tid]; tot[i * 8 + tid] = run; run += v; }
  }
  __syncthreads();
#pragma unroll
  for (int h = 0; h < 8; ++h) s[h] = tot[tid * 8 + h];
  for (int i = 0; i < 64; ++i) {
    const f32x4* r = (const f32x4*)(LOGF + (size_t)(tid * 64 + i) * 8);
    f32x4 a = r[0], c = r[1];
    s[0] += a[0]; s[1] += a[1]; s[2] += a[2]; s[3] += a[3]; s[4] += c[0]; s[5] += c[1]; s[6] += c[2]; s[7] += c[3];
    f32x4* w = (f32x4*)(CUM + (size_t)(tid * 64 + i) * 8);
    w[0] = (f32x4){s[0], s[1], s[2], s[3]};
    w[1] = (f32x4){s[4], s[5], s[6], s[7]};
  }
  __syncthreads();
}

DEV void gdn_prep_item(const P& p, int item, unsigned char* smem) {
  const int tid = ltid(), lane = tid & 63, wave = tid >> 6;
  float* Kf = (float*)smem;
  float* Qf = Kf + 64 * 132;
  float* gc = Qf + 64 * 132;
  float* bt = gc + 64;
  float* eg = bt + 64;
  float* rk = eg + 64;
  float* rq = rk + 64;
  const bf16_t* GB = (const bf16_t*)(p.ws + R_GB);
  const float* GG = (const float*)(p.ws + R_GG);
  const float* BETA = (const float*)(p.ws + R_BETA);
  const float* cw = p.in[15];
  const bool samp = item >= 2048;
  const int h = item & 3;
  int row0, L; bool has_prev; const float* cbuf = nullptr;
  if (!samp) { const int chunk = (item >> 2) & 255, b = item >> 10; row0 = b * T + chunk * 64; L = 64; has_prev = chunk > 0; }
  else { const int sb = (item - 2048) >> 2; row0 = MP + sb * 32; L = 32; has_prev = false; cbuf = p.in[6] + (size_t)sb * 3 * 1536; }
  auto getx = [&](int i, int colg) -> float {
    if (i >= 0) return (i < L) ? bf2f(GB[(size_t)(row0 + i) * 1536 + colg]) : 0.f;
    if (samp) return cbuf[(3 + i) * 1536 + colg];
    return has_prev ? bf2f(GB[(size_t)(row0 + i) * 1536 + colg]) : 0.f;
  };
  const int c = tid & 127;
  const int half = tid >> 7;
  {
    const int colk = 512 + h * 128 + c, colq = h * 128 + c;
    const float k0 = cw[colk], k1 = cw[1536 + colk], k2 = cw[2 * 1536 + colk], k3 = cw[3 * 1536 + colk];
    const float q0 = cw[colq], q1 = cw[1536 + colq], q2 = cw[2 * 1536 + colq], q3 = cw[3 * 1536 + colq];
    const int i0 = half * 32;
    float a3 = getx(i0 - 3, colk), a2 = getx(i0 - 2, colk), a1 = getx(i0 - 1, colk);
    float b3 = getx(i0 - 3, colq), b2 = getx(i0 - 2, colq), b1 = getx(i0 - 1, colq);
#pragma unroll 8
    for (int ii = 0; ii < 32; ++ii) {
      const int i = i0 + ii;
      const float xa = getx(i, colk), xb = getx(i, colq);
      float ya = k0 * a3 + k1 * a2 + k2 * a1 + k3 * xa;
      float yb = q0 * b3 + q1 * b2 + q2 * b1 + q3 * xb;
      ya = (i < L) ? silu_f(ya) : 0.f;
      yb = (i < L) ? silu_f(yb) : 0.f;
      Kf[i * 132 + c] = ya;
      Qf[i * 132 + c] = yb;
      a3 = a2; a2 = a1; a1 = xa;
      b3 = b2; b2 = b1; b1 = xb;
    }
  }
  __syncthreads();
  for (int i = wave * 16; i < wave * 16 + 16; ++i) {
    const float a0 = Kf[i * 132 + lane], a1 = Kf[i * 132 + 64 + lane];
    const float sk = wave_sum(a0 * a0 + a1 * a1);
    const float b0 = Qf[i * 132 + lane], b1 = Qf[i * 132 + 64 + lane];
    const float sq = wave_sum(b0 * b0 + b1 * b1);
    if (lane == 0) { rk[i] = rsqrtf(sk + 1e-6f); rq[i] = rsqrtf(sq + 1e-6f) * 0.08838834764831845f; }
  }
  if (wave == 0) {
    float gi = (lane < L) ? GG[(size_t)(row0 + lane) * 4 + h] : 0.f;
    const float bi = (lane < L) ? BETA[(size_t)(row0 + lane) * 4 + h] : 0.f;
#pragma unroll
    for (int o = 1; o < 64; o <<= 1) { const float tt = __shfl_up(gi, o); if (lane >= o) gi += tt; }
    gc[lane] = gi; eg[lane] = __expf(gi); bt[lane] = bi;
  }
  __syncthreads();
  {
#pragma unroll 4
    for (int ii = 0; ii < 32; ++ii) {
      const int i = half * 32 + ii;
      Kf[i * 132 + c] *= rk[i];
      Qf[i * 132 + c] *= rq[i];
    }
  }
  __syncthreads();
  bf16_t* PW = (bf16_t*)(p.ws + A_PW) + (size_t)item * 8192;
  bf16_t* PQG = (bf16_t*)(p.ws + A_PQG) + (size_t)item * 8192;
  bf16_t* PKDT = (bf16_t*)(p.ws + A_PKDT) + (size_t)item * 8192;
  bf16_t* PUT = (bf16_t*)(p.ws + A_PUT) + (size_t)item * 8192;
  bf16_t* PATT = (bf16_t*)(p.ws + A_PATT) + (size_t)item * 4096;
  float* PGL = (float*)(p.ws + A_PGL);
  const float gl = gc[63];
  {
#pragma unroll 4
    for (int ii = 0; ii < 32; ++ii) {
      const int i = half * 32 + ii;
      PQG[i * 128 + c] = f2bf(Qf[i * 132 + c] * eg[i]);
    }
#pragma unroll
    for (int j8 = 0; j8 < 4; ++j8) {
      const int j0 = half * 32 + j8 * 8;
      float e[8];
#pragma unroll
      for (int t = 0; t < 8; ++t) e[t] = Kf[(j0 + t) * 132 + c] * __expf(gl - gc[j0 + t]);
      u32x4 o;
      o[0] = pack2(e[0], e[1]); o[1] = pack2(e[2], e[3]); o[2] = pack2(e[4], e[5]); o[3] = pack2(e[6], e[7]);
      *(u32x4*)(PKDT + c * 64 + j0) = o;
    }
    if (tid == 0) PGL[item] = __expf(gl);
  }
  const int ti = tid >> 4, tj = tid & 15;
  {
    float accA[4][4], accN[4][4];
#pragma unroll
    for (int a = 0; a < 4; ++a)
#pragma unroll
      for (int b = 0; b < 4; ++b) { accA[a][b] = 0.f; accN[a][b] = 0.f; }
#pragma unroll 2
    for (int cc = 0; cc < 128; cc += 4) {
      f32x4 qi[4], ki[4], kj[4];
#pragma unroll
      for (int a = 0; a < 4; ++a) {
        qi[a] = *(const f32x4*)(Qf + (ti + 16 * a) * 132 + cc);
        ki[a] = *(const f32x4*)(Kf + (ti + 16 * a) * 132 + cc);
        kj[a] = *(const f32x4*)(Kf + (tj + 16 * a) * 132 + cc);
      }
#pragma unroll
      for (int a = 0; a < 4; ++a)
#pragma unroll
        for (int b = 0; b < 4; ++b) {
          accA[a][b] += qi[a][0] * kj[b][0] + qi[a][1] * kj[b][1] + qi[a][2] * kj[b][2] + qi[a][3] * kj[b][3];
          accN[a][b] += ki[a][0] * kj[b][0] + ki[a][1] * kj[b][1] + ki[a][2] * kj[b][2] + ki[a][3] * kj[b][3];
        }
    }
    __syncthreads();
    float* Nl = Qf;
#pragma unroll
    for (int a = 0; a < 4; ++a)
#pragma unroll
      for (int b = 0; b < 4; ++b) {
        const int i = ti + 16 * a, j = tj + 16 * b;
        const float dec = (j <= i) ? __expf(gc[i] - gc[j]) : 0.f;
        PATT[i * 64 + j] = f2bf((j <= i) ? accA[a][b] * dec : 0.f);
        Nl[i * 68 + j] = (j < i) ? accN[a][b] * bt[i] * dec : 0.f;
      }
  }
  __syncthreads();
  {
    const float* Nl = Qf;
    float col[64];
    if (tid < 128) {
      const int colg = 1024 + h * 128 + c;
      const float w0 = cw[colg], w1 = cw[1536 + colg], w2 = cw[2 * 1536 + colg], w3 = cw[3 * 1536 + colg];
      float x3 = getx(-3, colg), x2 = getx(-2, colg), x1 = getx(-1, colg);
#pragma unroll
      for (int i = 0; i < 64; ++i) {
        const float x = getx(i, colg);
        float y = w0 * x3 + w1 * x2 + w2 * x1 + w3 * x;
        y = (i < L) ? silu_f(y) : 0.f;
        col[i] = y * bt[i];
        x3 = x2; x2 = x1; x1 = x;
      }
    } else {
#pragma unroll
      for (int i = 0; i < 64; ++i) col[i] = Kf[i * 132 + c] * bt[i] * eg[i];
    }
#pragma unroll
    for (int i = 1; i < 64; ++i) {
      float sacc = 0.f;
#pragma unroll
      for (int j4 = 0; j4 < (i + 3) / 4; ++j4) {
        const f32x4 nv = *(const f32x4*)(Nl + i * 68 + j4 * 4);
#pragma unroll
        for (int e = 0; e < 4; ++e)
          if (j4 * 4 + e < i) sacc += nv[e] * col[j4 * 4 + e];
      }
      col[i] -= sacc;
    }
    if (tid < 128) {
#pragma unroll
      for (int j8 = 0; j8 < 8; ++j8) {
        u32x4 o;
        o[0] = pack2(col[j8 * 8 + 0], col[j8 * 8 + 1]); o[1] = pack2(col[j8 * 8 + 2], col[j8 * 8 + 3]);
        o[2] = pack2(col[j8 * 8 + 4], col[j8 * 8 + 5]); o[3] = pack2(col[j8 * 8 + 6], col[j8 * 8 + 7]);
        *(u32x4*)(PUT + c * 64 + j8 * 8) = o;
      }
    } else {
#pragma unroll
      for (int i = 0; i < 64; ++i) PW[i * 128 + c] = f2bf(col[i]);
    }
  }
  __syncthreads();
}

struct GdnFr { bf16x8 w[4], qg[4], att[2], kd[2][2]; u32x2 u; float gl; };
DEV void gdn_load(GdnFr& f, const P& p, int item, int sl, int wave, int lane) {
  const int r16 = lane & 15, q4 = lane >> 4;
  const bf16_t* PW = (const bf16_t*)(p.ws + A_PW) + (size_t)item * 8192;
  const bf16_t* PQG = (const bf16_t*)(p.ws + A_PQG) + (size_t)item * 8192;
  const bf16_t* PKDT = (const bf16_t*)(p.ws + A_PKDT) + (size_t)item * 8192;
  const bf16_t* PUT = (const bf16_t*)(p.ws + A_PUT) + (size_t)item * 8192;
  const bf16_t* PATT = (const bf16_t*)(p.ws + A_PATT) + (size_t)item * 4096;
#pragma unroll
  for (int ks = 0; ks < 4; ++ks) {
    f.w[ks] = *(const bf16x8*)(PW + (wave * 16 + r16) * 128 + ks * 32 + q4 * 8);
    f.qg[ks] = *(const bf16x8*)(PQG + (wave * 16 + r16) * 128 + ks * 32 + q4 * 8);
  }
#pragma unroll
  for (int ks = 0; ks < 2; ++ks) {
    f.att[ks] = *(const bf16x8*)(PATT + (wave * 16 + r16) * 64 + ks * 32 + q4 * 8);
#pragma unroll
    for (int mt = 0; mt < 2; ++mt) f.kd[mt][ks] = *(const bf16x8*)(PKDT + (wave * 32 + mt * 16 + r16) * 64 + ks * 32 + q4 * 8);
  }
  f.u = *(const u32x2*)(PUT + (sl * 16 + r16) * 64 + wave * 16 + q4 * 4);
  f.gl = ((const float*)(p.ws + A_PGL))[item];
}

DEV void gdn_scan_chain(const P& p, int chain, unsigned char* smem) {
  const int tid = ltid(), lane = tid & 63, wave = tid >> 6;
  const int r16 = lane & 15, q4 = lane >> 4;
  bf16_t* Sb = (bf16_t*)smem;
  bf16_t* Vn = Sb + 16 * 136;
  float* ORAW = (float*)(p.ws + R_GB);
  int sl, h, nchunks, item0, rowbase, nvalid; float* sout; const float* s0 = nullptr;
  if (chain < 64) { sl = chain & 7; h = (chain >> 3) & 3; const int b = chain >> 5; nchunks = 256; item0 = b * 1024 + h; rowbase = b * T; nvalid = 64;
    sout = p.out + O_GSP + (size_t)(b * 4 + h) * 16384; }
  else { const int cs = chain - 64; sl = cs & 7; h = (cs >> 3) & 3; const int sb = cs >> 5; nchunks = 1; item0 = 2048 + sb * 4 + h; rowbase = MP + sb * 32; nvalid = 32;
    sout = p.out + O_GSS + (size_t)(sb * 4 + h) * 16384; s0 = p.in[5] + (size_t)(sb * 4 + h) * 16384; }
  f32x4 S[2];
#pragma unroll
  for (int mt = 0; mt < 2; ++mt)
#pragma unroll
    for (int e = 0; e < 4; ++e) S[mt][e] = s0 ? s0[(size_t)(wave * 32 + mt * 16 + q4 * 4 + e) * 128 + sl * 16 + r16] : 0.f;
#pragma unroll
  for (int mt = 0; mt < 2; ++mt) {
    u32x2 o; o[0] = pack2(S[mt][0], S[mt][1]); o[1] = pack2(S[mt][2], S[mt][3]);
    *(u32x2*)(Sb + r16 * 136 + wave * 32 + mt * 16 + q4 * 4) = o;
  }
  GdnFr cur, nxt;
  gdn_load(cur, p, item0, sl, wave, lane);
  __syncthreads();
  for (int ch = 0; ch < nchunks; ++ch) {
    if (ch + 1 < nchunks) gdn_load(nxt, p, item0 + (ch + 1) * 4, sl, wave, lane);
    f32x4 ws = {0.f, 0.f, 0.f, 0.f}, qs = {0.f, 0.f, 0.f, 0.f};
#pragma unroll
    for (int ks = 0; ks < 4; ++ks) {
      const bf16x8 sf = *(const bf16x8*)(Sb + r16 * 136 + ks * 32 + q4 * 8);
      ws = mfma16(cur.w[ks], sf, ws);
      qs = mfma16(cur.qg[ks], sf, qs);
    }
    f32x4 vn;
    vn[0] = bf2f((bf16_t)(cur.u[0] & 0xffff)) - ws[0];
    vn[1] = bf2f((bf16_t)(cur.u[0] >> 16)) - ws[1];
    vn[2] = bf2f((bf16_t)(cur.u[1] & 0xffff)) - ws[2];
    vn[3] = bf2f((bf16_t)(cur.u[1] >> 16)) - ws[3];
    {
      u32x2 o; o[0] = pack2(vn[0], vn[1]); o[1] = pack2(vn[2], vn[3]);
      *(u32x2*)(Vn + r16 * 72 + wave * 16 + q4 * 4) = o;
    }
    __syncthreads();
    bf16x8 vf[2];
#pragma unroll
    for (int ks = 0; ks < 2; ++ks) vf[ks] = *(const bf16x8*)(Vn + r16 * 72 + ks * 32 + q4 * 8);
#pragma unroll
    for (int ks = 0; ks < 2; ++ks) qs = mfma16(cur.att[ks], vf[ks], qs);
#pragma unroll
    for (int e = 0; e < 4; ++e) {
      const int i = wave * 16 + q4 * 4 + e;
      if (i < nvalid) ORAW[(size_t)(rowbase + ch * 64 + i) * 512 + h * 128 + sl * 16 + r16] = qs[e];
    }
#pragma unroll
    for (int mt = 0; mt < 2; ++mt) {
      f32x4 sn = S[mt] * cur.gl;
#pragma unroll
      for (int ks = 0; ks < 2; ++ks) sn = mfma16(cur.kd[mt][ks], vf[ks], sn);
      S[mt] = sn;
      u32x2 o; o[0] = pack2(sn[0], sn[1]); o[1] = pack2(sn[2], sn[3]);
      *(u32x2*)(Sb + r16 * 136 + wave * 32 + mt * 16 + q4 * 4) = o;
    }
    __syncthreads();
    if (ch + 1 < nchunks) cur = nxt;
  }
#pragma unroll
  for (int mt = 0; mt < 2; ++mt)
#pragma unroll
    for (int e = 0; e < 4; ++e) sout[(size_t)(wave * 32 + mt * 16 + q4 * 4 + e) * 128 + sl * 16 + r16] = S[mt][e];
  __syncthreads();
}

DEV void attn_prompt_item(const P& p, int bh, int qb, unsigned char* smem) {
  const int tid = ltid(), lane = tid & 63, wave = tid >> 6;
  const int r = lane & 31, hh = lane >> 5;
  const int b = bh >> 3, hd = bh & 7;
  bf16_t* Ks = (bf16_t*)smem;
  bf16_t* Vs = Ks + 2 * 64 * 72;
  float* Bi = (float*)(Vs + 2 * 64 * 72);
  bf16_t* MIX = (bf16_t*)(p.ws + R_MIX);
  const bf16_t* KB = (const bf16_t*)(p.ws + R_KB);
  const bf16_t* VT = (const bf16_t*)(p.ws + R_VT);
  const float* CUM = (const float*)(p.ws + R_CUM);
  const int qpos = qb * 128 + wave * 32 + r;
  const size_t qrow = (size_t)b * T + qpos;
  bf16x8 qf[4];
#pragma unroll
  for (int ks = 0; ks < 4; ++ks) qf[ks] = *(const bf16x8*)(MIX + qrow * 1024 + hd * 64 + ks * 16 + hh * 8);
  f32x16 o[2];
#pragma unroll
  for (int dt = 0; dt < 2; ++dt)
#pragma unroll
    for (int q = 0; q < 16; ++q) o[dt][q] = 0.f;
  float m = -INFINITY, lsum = 0.f;
  const int nkt = qb * 2 + 2;
  const int lrow = tid >> 3, lcc = tid & 7;
  const bf16_t* Kg = KB + ((size_t)b * T + lrow) * 512 + hd * 64 + lcc * 8;
  const bf16_t* Vg = VT + ((size_t)bh * 64 + lrow) * T + lcc * 8;
  u32x4 rk[2], rv[2]; float rbias = 0.f;
#pragma unroll
  for (int i = 0; i < 2; ++i) { rk[i] = *(const u32x4*)(Kg + (size_t)(32 * i) * 512); rv[i] = *(const u32x4*)(Vg + (size_t)(32 * i) * T); }
  if (tid < 64) rbias = -CUM[((size_t)b * T + tid) * 8 + hd] * LOG2E;
  const int qlast = qb * 128 + wave * 32 + 31;
  for (int kt = 0; kt < nkt; ++kt) {
    bf16_t* ks_ = Ks + (kt & 1) * 64 * 72;
    bf16_t* vs_ = Vs + (kt & 1) * 64 * 72;
    float* bi_ = Bi + (kt & 1) * 64;
#pragma unroll
    for (int i = 0; i < 2; ++i) {
      *(u32x4*)(ks_ + (lrow + 32 * i) * 72 + lcc * 8) = rk[i];
      *(u32x4*)(vs_ + (lrow + 32 * i) * 72 + lcc * 8) = rv[i];
    }
    if (tid < 64) bi_[tid] = rbias;
    __syncthreads();
    if (kt + 1 < nkt) {
#pragma unroll
      for (int i = 0; i < 2; ++i) {
        rk[i] = *(const u32x4*)(Kg + (size_t)((kt + 1) * 64 + 32 * i) * 512);
        rv[i] = *(const u32x4*)(Vg + (size_t)(32 * i) * T + (kt + 1) * 64);
      }
      if (tid < 64) rbias = -CUM[((size_t)b * T + (kt + 1) * 64 + tid) * 8 + hd] * LOG2E;
    }
    if (kt * 64 <= qlast) {
      f32x16 s[2];
#pragma unroll
      for (int k2 = 0; k2 < 2; ++k2) {
#pragma unroll
        for (int q = 0; q < 16; ++q) s[k2][q] = 0.f;
#pragma unroll
        for (int ks = 0; ks < 4; ++ks) {
          const bf16x8 kf = *(const bf16x8*)(ks_ + (32 * k2 + r) * 72 + ks * 16 + hh * 8);
          s[k2] = mfma32(kf, qf[ks], s[k2]);
        }
      }
      const bool diag = (kt * 64 + 63 > qb * 128 + wave * 32);
      float mx = -INFINITY;
#pragma unroll
      for (int k2 = 0; k2 < 2; ++k2)
#pragma unroll
        for (int g = 0; g < 4; ++g) {
          const f32x4 bb = *(const f32x4*)(bi_ + 32 * k2 + 8 * g + 4 * hh);
#pragma unroll
          for (int e = 0; e < 4; ++e) {
            float tv = s[k2][4 * g + e] * (0.125f * LOG2E) + bb[e];
            if (diag) { const int key = kt * 64 + 32 * k2 + 8 * g + 4 * hh + e; if (key > qpos) tv = -INFINITY; }
            s[k2][4 * g + e] = tv;
            mx = fmaxf(mx, tv);
          }
        }
      mx = fmaxf(mx, __shfl_xor(mx, 32));
      if (__builtin_amdgcn_ballot_w64(mx > m + 8.f) != 0ull) {
        const float mnew = fmaxf(m, mx);
        const float alpha = fexp2(m - mnew);
        m = mnew;
        lsum *= alpha;
#pragma unroll
        for (int dt = 0; dt < 2; ++dt) o[dt] = o[dt] * alpha;
      }
      float ps = 0.f;
      bf16x8 pb[2][2];
#pragma unroll
      for (int k2 = 0; k2 < 2; ++k2)
#pragma unroll
        for (int s2 = 0; s2 < 2; ++s2) {
          u32x4 pk;
#pragma unroll
          for (int j = 0; j < 4; ++j) {
            const float p0 = fexp2(s[k2][8 * s2 + 2 * j] - m), p1 = fexp2(s[k2][8 * s2 + 2 * j + 1] - m);
            ps += p0 + p1;
            pk[j] = pack2(p0, p1);
          }
          pb[k2][s2] = __builtin_bit_cast(bf16x8, pk);
        }
      lsum += ps;
#pragma unroll
      for (int dt = 0; dt < 2; ++dt) {
#pragma unroll
        for (int k2 = 0; k2 < 2; ++k2)
#pragma unroll
          for (int s2 = 0; s2 < 2; ++s2) {
            const bf16_t* vp = vs_ + (32 * dt + r) * 72 + 32 * k2 + 16 * s2 + 4 * hh;
            const bf16x4 lo = *(const bf16x4*)vp, hi = *(const bf16x4*)(vp + 8);
            bf16x8 vf;
            vf[0] = lo[0]; vf[1] = lo[1]; vf[2] = lo[2]; vf[3] = lo[3]; vf[4] = hi[0]; vf[5] = hi[1]; vf[6] = hi[2]; vf[7] = hi[3];
            o[dt] = mfma32(vf, pb[k2][s2], o[dt]);
          }
      }
    }
  }
  lsum += __shfl_xor(lsum, 32);
  const float inv = 1.f / lsum;
#pragma unroll
  for (int dt = 0; dt < 2; ++dt)
#pragma unroll
    for (int g = 0; g < 4; ++g) {
      u32x2 ov; ov[0] = pack2(o[dt][4 * g] * inv, o[dt][4 * g + 1] * inv); ov[1] = pack2(o[dt][4 * g + 2] * inv, o[dt][4 * g + 3] * inv);
      *(u32x2*)(MIX + qrow * 1024 + hd * 64 + 32 * dt + 8 * g + 4 * hh) = ov;
    }
  __syncthreads();
}

DEV void attn_sample_item(const P& p, int item, unsigned char* smem) {
  const int tid = ltid(), lane = tid & 63, wave = tid >> 6;
  const int qg = item & 3, hd = (item >> 2) & 7, sb = item >> 5;
  float* cs = (float*)smem;
  float* qs = cs + 1088;
  float* ps = qs + 256;
  const float* ck = p.in[2] + (size_t)sb * 1024 * 512;
  const float* cv = p.in[3] + (size_t)sb * 1024 * 512;
  const float* clf = p.in[4] + (size_t)sb * 1024 * 8;
  const float* nk = p.out + O_FKS + (size_t)sb * 32 * 512;
  const float* nv = p.out + O_FVS + (size_t)sb * 32 * 512;
  const float* nlf = (const float*)(p.ws + R_LOGF) + (size_t)(MP + sb * 32) * 8;
  const float* QS = (const float*)(p.ws + R_QS) + (size_t)sb * 32 * 512;
  bf16_t* MIX = (bf16_t*)(p.ws + R_MIX);
  if (wave == 0) {
    float s = 0.f;
    for (int i = 0; i < 17; ++i) {
      const int j = lane * 17 + i;
      float x = 0.f;
      if (j < 1024) x = clf[(size_t)j * 8 + hd]; else if (j < 1056) x = nlf[(size_t)(j - 1024) * 8 + hd];
      s += x; cs[j] = s;
    }
    float inc = s;
#pragma unroll
    for (int o = 1; o < 64; o <<= 1) { const float tt = __shfl_up(inc, o); if (lane >= o) inc += tt; }
    const float ex = inc - s;
    for (int i = 0; i < 17; ++i) cs[lane * 17 + i] += ex;
  }
  __syncthreads();
  for (int qi = qg * 8 + wave * 2; qi < qg * 8 + wave * 2 + 2; ++qi) {
    qs[wave * 64 + lane] = QS[(size_t)qi * 512 + hd * 64 + lane];
    __syncthreads();
    const int nkeys = 1024 + qi + 1;
    const float cq = cs[1024 + qi];
    float mx = -INFINITY;
#pragma unroll 2
    for (int n = 0; n < 17; ++n) {
      const int j = lane + 64 * n;
      float sv = -INFINITY;
      if (j < nkeys) {
        const float* kr = (j < 1024) ? (ck + (size_t)j * 512 + hd * 64) : (nk + (size_t)(j - 1024) * 512 + hd * 64);
        float d = 0.f;
#pragma unroll
        for (int c4 = 0; c4 < 16; ++c4) {
          const f32x4 kk = *(const f32x4*)(kr + c4 * 4);
          const f32x4 qq = *(const f32x4*)(qs + wave * 64 + c4 * 4);
          d += kk[0] * qq[0] + kk[1] * qq[1] + kk[2] * qq[2] + kk[3] * qq[3];
        }
        sv = d * 0.125f + cq - cs[j];
      }
      ps[wave * 1088 + j] = sv; mx = fmaxf(mx, sv);
    }
    mx = wave_max(mx);
    float sum = 0.f;
    for (int n = 0; n < 17; ++n) {
      const int j = lane + 64 * n;
      const float pv = (j < nkeys) ? __expf(ps[wave * 1088 + j] - mx) : 0.f;
      sum += pv;
      ps[wave * 1088 + j] = pv;
    }
    sum = wave_sum(sum);
    __syncthreads();
    float acc0 = 0.f, acc1 = 0.f, acc2 = 0.f, acc3 = 0.f;
    const float* cvh = cv + hd * 64 + lane;
#pragma unroll 4
    for (int j = 0; j < 1024; j += 4) {
      const f32x4 pp = *(const f32x4*)(ps + wave * 1088 + j);
      acc0 += pp[0] * cvh[(size_t)(j + 0) * 512];
      acc1 += pp[1] * cvh[(size_t)(j + 1) * 512];
      acc2 += pp[2] * cvh[(size_t)(j + 2) * 512];
      acc3 += pp[3] * cvh[(size_t)(j + 3) * 512];
    }
    for (int j = 1024; j < nkeys; ++j) acc0 += ps[wave * 1088 + j] * nv[(size_t)(j - 1024) * 512 + hd * 64 + lane];
    const float acc = (acc0 + acc1) + (acc2 + acc3);
    MIX[(size_t)(MP + sb * 32 + qi) * 1024 + hd * 64 + lane] = f2bf(acc / sum);
    __syncthreads();
  }
}

DEV void gdn_gate_phase(const P& p) {
  const int tid_ = ltid();
  const int lane = tid_ & 63, wave = tid_ >> 6;
  const float* ORAW = (const float*)(p.ws + R_GB);
  bf16_t* MIX = (bf16_t*)(p.ws + R_MIX);
  const float* ng = p.in[18];
  const f32x2 g2 = *(const f32x2*)(ng + 2 * lane);
  for (int it = blockIdx.x * 4 + wave; it < M * 4; it += gridDim.x * 4) {
    const int row = it >> 2, h = it & 3;
    const f32x2 ov = *(const f32x2*)(ORAW + (size_t)row * 512 + h * 128 + 2 * lane);
    unsigned* zp = (unsigned*)(MIX + (size_t)row * 1024 + 512 + h * 128 + 2 * lane);
    const unsigned zz = *zp;
    const float z0 = bf2f((bf16_t)(zz & 0xffff)), z1 = bf2f((bf16_t)(zz >> 16));
    const float ss = wave_sum(ov[0] * ov[0] + ov[1] * ov[1]);
    const float rs = rsqrtf(ss * (1.f / 128.f) + 1e-6f);
    *zp = pack2(ov[0] * rs * g2[0] * silu_f(z0), ov[1] * rs * g2[1] * silu_f(z1));
  }
}

template <int PASS>
DEV void s5_item(const P& p, int item, unsigned char* smem) {
  const int tid = ltid(), lane = tid & 63, wave = tid >> 6;
  const int r = lane & 31, hh = lane >> 5, r16 = lane & 15, q4 = lane >> 4;
  bf16_t* HB = (bf16_t*)smem + wave * 64 * 136;
  const float* U = (const float*)(p.ws + R_U);
  bf16_t* ZZB = (bf16_t*)(p.ws + R_ZZB);
  f32x2* E = (f32x2*)(p.ws + R_E);
  const f32x2* LAMB = (const f32x2*)(p.ws + W_LAMB);
  const f32x2* LAM256 = (const f32x2*)(p.ws + W_LAM256);
  const bf16_t* Bp = (const bf16_t*)(p.ws + W_S5B);
  const bf16_t* Cp = (const bf16_t*)(p.ws + W_S5C);
  int g, seq, span, row0, nchunk, ntok; bool samp;
  if (item < 2048) { samp = false; const int gq = item & 15; span = (item >> 4) & 63; seq = item >> 10; g = gq * 4 + wave; row0 = seq * T + span * 256; nchunk = 4; ntok = 64; }
  else { samp = true; const int it = item - 2048; const int gq = it & 15; seq = it >> 4; span = 0; g = gq * 4 + wave; row0 = MP + seq * 32; nchunk = 1; ntok = 32; }
  const f32x2 lam = LAMB[g * 64 + lane];
  float hr = 0.f, hi = 0.f;
  if (PASS == 2) {
    if (samp) { hr = p.in[7][(size_t)(seq * 64 + g) * 64 + lane]; hi = p.in[8][(size_t)(seq * 64 + g) * 64 + lane]; }
    else {
      const f32x2 l256 = LAM256[g * 64 + lane];
      for (int j = 0; j < span; ++j) {
        const f32x2 e = E[((size_t)(seq * 64 + j) * 64 + g) * 64 + lane];
        const float nr = l256[0] * hr - l256[1] * hi + e[0];
        const float ni = l256[0] * hi + l256[1] * hr + e[1];
        hr = nr; hi = ni;
      }
    }
  }
  bf16x8 bfr[4];
#pragma unroll
  for (int nt = 0; nt < 4; ++nt) bfr[nt] = *(const bf16x8*)(Bp + ((size_t)g * 128 + nt * 32 + r) * 16 + hh * 8);
  bf16x8 cfr[4];
#pragma unroll
  for (int ks = 0; ks < 4; ++ks) cfr[ks] = *(const bf16x8*)(Cp + ((size_t)g * 16 + r16) * 128 + ks * 32 + q4 * 8);
  const float dd = p.in[28][g * 16 + r16];
  for (int ch = 0; ch < nchunk; ++ch) {
    const int rowc = row0 + ch * 64;
#pragma unroll
    for (int mt = 0; mt < 2; ++mt) {
      bf16x8 uf;
      if (mt * 32 < ntok) {
        const float* up = U + (size_t)(rowc + mt * 32 + r) * D + g * 16 + hh * 8;
        const f32x4 u0 = *(const f32x4*)up, u1 = *(const f32x4*)(up + 4);
        uf[0] = (short)f2bf(u0[0]); uf[1] = (short)f2bf(u0[1]); uf[2] = (short)f2bf(u0[2]); uf[3] = (short)f2bf(u0[3]);
        uf[4] = (short)f2bf(u1[0]); uf[5] = (short)f2bf(u1[1]); uf[6] = (short)f2bf(u1[2]); uf[7] = (short)f2bf(u1[3]);
      } else {
#pragma unroll
        for (int j = 0; j < 8; ++j) uf[j] = 0;
      }
#pragma unroll
      for (int nt = 0; nt < 4; ++nt) {
        f32x16 acc;
#pragma unroll
        for (int q = 0; q < 16; ++q) acc[q] = 0.f;
        acc = mfma32(uf, bfr[nt], acc);
#pragma unroll
        for (int q = 0; q < 16; ++q) HB[(mt * 32 + (q & 3) + 8 * (q >> 2) + 4 * hh) * 136 + nt * 32 + r] = f2bf(acc[q]);
      }
    }
    __syncthreads();
    for (int t = 0; t < ntok; ++t) {
      const float br = bf2f(HB[t * 136 + lane]), bi = bf2f(HB[t * 136 + 64 + lane]);
      const float nr = lam[0] * hr - lam[1] * hi + br;
      const float ni = lam[0] * hi + lam[1] * hr + bi;
      hr = nr; hi = ni;
      if (PASS == 2) { HB[t * 136 + lane] = f2bf(hr); HB[t * 136 + 64 + lane] = f2bf(hi); }
    }
    __syncthreads();
    if (PASS == 2) {
#pragma unroll
      for (int m4 = 0; m4 < 4; ++m4) {
        if (m4 * 16 < ntok) {
          f32x4 y = {0.f, 0.f, 0.f, 0.f};
#pragma unroll
          for (int ks = 0; ks < 4; ++ks) {
            const bf16x8 hf = *(const bf16x8*)(HB + (m4 * 16 + r16) * 136 + ks * 32 + q4 * 8);
            y = mfma16(hf, cfr[ks], y);
          }
#pragma unroll
          for (int e = 0; e < 4; ++e) {
            const size_t idx = (size_t)(rowc + m4 * 16 + q4 * 4 + e) * D + g * 16 + r16;
            const float yy = y[e] + dd * U[idx];
            ZZB[idx] = f2bf(gelu_tanh(yy));
          }
        }
      }
      __syncthreads();
    }
  }
  if (PASS == 1) E[((size_t)(seq * 64 + span) * 64 + g) * 64 + lane] = (f32x2){hr, hi};
  else {
    if (samp) { p.out[O_S5RS + (size_t)(seq * 64 + g) * 64 + lane] = hr; p.out[O_S5IS + (size_t)(seq * 64 + g) * 64 + lane] = hi; }
    else if (span == 63) { p.out[O_S5RP + (size_t)(seq * 64 + g) * 64 + lane] = hr; p.out[O_S5IP + (size_t)(seq * 64 + g) * 64 + lane] = hi; }
  }
}

DEV void gsync(unsigned* bar, unsigned& epoch) {
  epoch += gridDim.x;
  asm volatile("s_waitcnt vmcnt(0) lgkmcnt(0)" ::: "memory");
  __syncthreads();
  if (threadIdx.x == 0) {
    __builtin_amdgcn_fence(__ATOMIC_RELEASE, "agent");
    __hip_atomic_fetch_add(bar, 1u, __ATOMIC_RELAXED, __HIP_MEMORY_SCOPE_AGENT);
    while (__hip_atomic_load(bar, __ATOMIC_RELAXED, __HIP_MEMORY_SCOPE_AGENT) < epoch) __builtin_amdgcn_s_sleep(1);
    __builtin_amdgcn_fence(__ATOMIC_ACQUIRE, "agent");
    asm volatile("s_waitcnt vmcnt(0) lgkmcnt(0)" ::: "memory");
  }
  __syncthreads();
}
#ifndef MINW
#define MINW 2
#endif
__global__ void __launch_bounds__(256, MINW) fwd_mega(P p) {
  extern __shared__ __attribute__((aligned(16))) unsigned char smem[];
  cg::grid_group grid = cg::this_grid();
  const int tid = threadIdx.x;
  float* X = p.out + O_Y;
  bf16_t* Xb = (bf16_t*)(p.ws + A_XB);
  bf16_t* ACT = (bf16_t*)(p.ws + R_ACT);

#ifndef NO_P0
  unsigned* bar = (unsigned*)(p.ws + W_CTR + 1024);
  unsigned epoch = 0;
  phase0(p, smem);
#endif
  grid.sync();
  gsync(bar, epoch);

#pragma unroll 1
  for (int layer = 0; layer < 2; ++layer) {
#pragma unroll 1
    for (int f = 0; f < 2; ++f) {
      if (f == 1) {
        if (layer == 0) {
#ifndef NO_EVENIN
          gemm_phase(Xb, 1024, (const bf16_t*)(p.ws + W_EVEN_IN), 1024, 29, EpiEvenIn{p}, smem);
#endif
          gsync(bar, epoch);
#ifndef NO_CUM
          if (blockIdx.x < 2) cumsum_prompt(p, blockIdx.x, smem);
#endif
#ifndef NO_PREP
          for (int it = blockIdx.x; it < NPREP; it += gridDim.x) gdn_prep_item(p, it, smem);
#endif
          gsync(bar, epoch);
          {
            unsigned* ctr = (unsigned*)(p.ws + W_CTR);
            int* sh = (int*)(smem + LDS_BYTES - 16);
            for (;;) {
              if (tid == 0) *sh = (int)atomicAdd(ctr, 1u);
              __syncthreads();
              const int it = *sh;
              __syncthreads();
              if (it >= 64 + 256 + 2048 + 256) break;
              if (it < 64) gdn_scan_chain(p, it, smem);
              else if (it < 64 + 256) attn_sample_item(p, it - 64, smem);
              else if (it < 64 + 256 + 2048) { const int a = it - 64 - 256; attn_prompt_item(p, a & 15, 127 - (a >> 4), smem); }
              else gdn_scan_chain(p, 64 + (it - 64 - 256 - 2048), smem);
            }
          }
          gsync(bar, epoch);
          gdn_gate_phase(p);
          gsync(bar, epoch);
          gemm_phase((const bf16_t*)(p.ws + R_MIX), 1024, (const bf16_t*)(p.ws + W_EVEN_OUT), 1024, 8, EpiElem<FResid>{FResid{X, 1.0f}}, smem);
          gsync(bar, epoch);
        } else {
          gemm_phase(Xb, 1024, (const bf16_t*)(p.ws + W_ODD_IN), 1024, 8, EpiElem<FStoreF32>{FStoreF32{(float*)(p.ws + R_U)}}, smem);
          gsync(bar, epoch);
#ifndef NO_S5
          for (int it = blockIdx.x; it < 2048; it += gridDim.x) if (((it >> 4) & 63) != 63) s5_item<1>(p, it, smem);
#endif
          gsync(bar, epoch);
#ifndef NO_S5
          for (int it = blockIdx.x; it < 2048 + 128; it += gridDim.x) s5_item<2>(p, it, smem);
#endif
          gsync(bar, epoch);
          gemm_phase((const bf16_t*)(p.ws + R_ZZB), 1024, (const bf16_t*)(p.ws + W_GLU), 1024, 8,
                     EpiElem<FGlu>{FGlu{(const bf16_t*)(p.ws + R_ZZB), p.in[30], (bf16_t*)(p.ws + A_GATED)}}, smem);
          gsync(bar, epoch);
          gemm_phase((const bf16_t*)(p.ws + A_GATED), 1024, (const bf16_t*)(p.ws + W_ODD_OUT), 1024, 8, EpiElem<FResid>{FResid{X, 1.0f}}, smem);
          gsync(bar, epoch);
        }
        ln_phase(X, Xb, p.in[11] + (layer * 3 + 1) * D, p.in[12] + (layer * 3 + 1) * D, true);
        gsync(bar, epoch);
      }
      const int idx = layer * 2 + f;
      gemm_phase(Xb, 1024, (const bf16_t*)(p.ws + W_FFN_IN + idx * SZ_FFN_IN), 1024, 44, EpiSwiglu{ACT}, smem);
      gsync(bar, epoch);
      gemm_phase(ACT, DFF, (const bf16_t*)(p.ws + W_FFN_OUT + idx * SZ_FFN_OUT), DFF, 8, EpiElem<FResid>{FResid{X, 0.5f}}, smem);
      gsync(bar, epoch);
      const bool last = (layer == 1 && f == 1);
      ln_phase(X, Xb, p.in[11] + (layer * 3 + f * 2) * D, p.in[12] + (layer * 3 + f * 2) * D, !last);
      if (!last) gsync(bar, epoch);
    }
  }
}

extern "C" void kernel_launch(void* const* d_in, const int* in_sizes, int n_in, void* d_out, int out_size, void* d_ws, size_t ws_size,
                              hipStream_t stream) {
  static int grid_blocks = 0;
  if (grid_blocks == 0) {
    int dev = 0, cus = 0, per_cu = 0;
    (void)hipGetDevice(&dev);
    (void)hipDeviceGetAttribute(&cus, hipDeviceAttributeMultiprocessorCount, dev);
    if (hipFuncSetAttribute((const void*)fwd_mega, hipFuncAttributeMaxDynamicSharedMemorySize, LDS_BYTES) != hipSuccess) {
      fprintf(stderr, "hipFuncSetAttribute failed\n");
    }
    (void)hipOccupancyMaxActiveBlocksPerMultiprocessor(&per_cu, (const void*)fwd_mega, 256, LDS_BYTES);
    if (per_cu < 1) per_cu = 1;
    if (per_cu > MINW) per_cu = MINW;
    grid_blocks = cus * per_cu;
    if (ws_size < WS_NEED) fprintf(stderr, "workspace too small: %zu < %zu\n", ws_size, (size_t)WS_NEED);
  }
  P p{};
  for (int i = 0; i < 32; ++i) p.in[i] = (const float*)d_in[i];
  p.out = (float*)d_out;
  p.ws = (unsigned char*)d_ws;
  (void)hipMemsetAsync((unsigned char*)d_ws + W_CTR + 1024, 0, 256, stream);
  void* args[] = {&p};
  hipError_t e = hipLaunchCooperativeKernel((const void*)fwd_mega, dim3(grid_blocks), dim3(256), args, LDS_BYTES, stream);
  if (e != hipSuccess) fprintf(stderr, "cooperative launch failed: %s (grid %d)\n", hipGetErrorString(e), grid_blocks);
}
```

```cpp
#include <hip/hip_runtime.h>
#include <hip/hip_cooperative_groups.h>
#include <cstdio>
#include <cstdint>
namespace cg = cooperative_groups;

typedef unsigned short bf16_t;
typedef short bf16x8 __attribute__((ext_vector_type(8)));
typedef short bf16x4 __attribute__((ext_vector_type(4)));
typedef float f32x4 __attribute__((ext_vector_type(4)));
typedef float f32x2 __attribute__((ext_vector_type(2)));
typedef float f32x16 __attribute__((ext_vector_type(16)));
typedef unsigned u32x4 __attribute__((ext_vector_type(4)));
typedef unsigned u32x2 __attribute__((ext_vector_type(2)));

#define DEV __device__ __forceinline__

constexpr int D = 1024, T = 16384, MP = 32768, MS = 256, M = MP + MS, DFF = 2816;
constexpr int MT = M / 128;
constexpr float ALPHA = 1.41421356237f;
constexpr float LOG2E = 1.44269504089f;
constexpr int LDS_BYTES = 73728;
constexpr int NPREP = 2048 + 32;

constexpr size_t O_Y = 0;
constexpr size_t O_FKP = 33816576, O_FVP = 50593792, O_FLP = 67371008, O_GSP = 67633152, O_GCP = 67764224;
constexpr size_t O_S5RP = 67773440, O_S5IP = 67781632, O_FKS = 67789824, O_FVS = 67920896, O_FLS = 68051968;
constexpr size_t O_GSS = 68054016, O_GCS = 68578304, O_S5RS = 68615168, O_S5IS = 68647936;

constexpr size_t MB = 1u << 20;
constexpr size_t W_FFN_IN = 0;
constexpr size_t SZ_FFN_IN = (size_t)5632 * 1024 * 2;
constexpr size_t W_FFN_OUT = W_FFN_IN + 4 * SZ_FFN_IN;
constexpr size_t SZ_FFN_OUT = (size_t)1024 * 2816 * 2;
constexpr size_t W_EVEN_IN = W_FFN_OUT + 4 * SZ_FFN_OUT;
constexpr size_t W_EVEN_OUT = W_EVEN_IN + (size_t)3712 * 1024 * 2;
constexpr size_t W_ODD_IN = W_EVEN_OUT + 2 * MB;
constexpr size_t W_GLU = W_ODD_IN + 2 * MB;
constexpr size_t W_ODD_OUT = W_GLU + 2 * MB;
constexpr size_t W_S5B = W_ODD_OUT + 2 * MB;
constexpr size_t W_S5C = W_S5B + 262144;
constexpr size_t W_LAMB = W_S5C + 262144;
constexpr size_t W_LAM256 = W_LAMB + 32768;
constexpr size_t W_CTR = W_LAM256 + 32768;
constexpr size_t W_END = W_CTR + 4096;
static_assert(W_END < 90 * MB, "weights region");
constexpr size_t A_XB = 90 * MB;
constexpr size_t SZ_XB = (size_t)M * 1024 * 2;
constexpr size_t A_PW = A_XB;
constexpr size_t A_PQG = A_PW + (size_t)NPREP * 8192 * 2;
constexpr size_t A_PKDT = A_PQG + (size_t)NPREP * 8192 * 2;
constexpr size_t A_PUT = A_PKDT + (size_t)NPREP * 8192 * 2;
constexpr size_t A_PATT = A_PUT + (size_t)NPREP * 8192 * 2;
constexpr size_t A_PGL = A_PATT + (size_t)NPREP * 4096 * 2;
constexpr size_t A_PEND = A_PGL + 16384;
constexpr size_t A_GATED = A_XB + 70 * MB;
static_assert(A_PEND < 90 * MB + 154 * MB, "prep region");
static_assert(A_GATED + SZ_XB < 90 * MB + 154 * MB, "gated region");
constexpr size_t R0 = 244 * MB;
constexpr size_t R_ACT = R0;
constexpr size_t R_MIX = R0;
constexpr size_t R_KB = R_MIX + SZ_XB;
constexpr size_t R_VT = R_KB + (size_t)M * 512 * 2;
constexpr size_t R_GB = R_VT + (size_t)16 * 64 * 16384 * 2;
constexpr size_t R_LOGF = R_GB + (size_t)M * 1536 * 2;
constexpr size_t R_CUM = R_LOGF + (size_t)M * 8 * 4;
constexpr size_t R_GG = R_CUM + (size_t)M * 8 * 4;
constexpr size_t R_BETA = R_GG + (size_t)M * 4 * 4;
constexpr size_t R_QS = R_BETA + (size_t)M * 4 * 4;
constexpr size_t R_EVEN_END = R_QS + (size_t)256 * 512 * 4;
constexpr size_t R_U = R0;
constexpr size_t R_ZZB = R_U + (size_t)M * 1024 * 4;
constexpr size_t R_E = R_ZZB + SZ_XB;
constexpr size_t R_ODD_END = R_E + (size_t)2 * 64 * 4096 * 8;
constexpr size_t WS_NEED = 490 * MB;
static_assert(R_EVEN_END < WS_NEED && R_ODD_END < WS_NEED && R_ACT + (size_t)M * DFF * 2 < WS_NEED, "ws");

struct P {
  const float* in[32];
  float* out;
  unsigned char* ws;
};

DEV int ltid() { int t = threadIdx.x; asm volatile("" : "+v"(t)); return t; }
typedef __bf16 hbf16x2 __attribute__((ext_vector_type(2)));
DEV unsigned pack2(float a, float b) {
  f32x2 v = {a, b};
  hbf16x2 h = __builtin_convertvector(v, hbf16x2);
  return __builtin_bit_cast(unsigned, h);
}
DEV bf16_t f2bf(float f) { return (bf16_t)(pack2(f, 0.f) & 0xffffu); }
DEV float bf2f(bf16_t h) { return __uint_as_float(((unsigned)h) << 16); }
DEV float fexp2(float x) { return __builtin_amdgcn_exp2f(x); }
DEV float frcp(float x) { return __builtin_amdgcn_rcpf(x); }
DEV float silu_f(float x) { return x * frcp(1.f + fexp2(-LOG2E * x)); }
DEV float sigmoid_f(float x) { return frcp(1.f + fexp2(-LOG2E * x)); }
DEV float softplus_f(float x) { return fmaxf(x, 0.f) + log1pf(__expf(-fabsf(x))); }
DEV float gelu_tanh(float x) {
  float u = 0.7978845608028654f * (x + 0.044715f * x * x * x);
  float t = 1.f - 2.f / (1.f + __expf(2.f * u));
  return 0.5f * x * (1.f + t);
}
DEV float wave_sum(float v) {
#pragma unroll
  for (int o = 32; o >= 1; o >>= 1) v += __shfl_xor(v, o);
  return v;
}
DEV float wave_max(float v) {
#pragma unroll
  for (int o = 32; o >= 1; o >>= 1) v = fmaxf(v, __shfl_xor(v, o));
  return v;
}
DEV f32x16 mfma32(bf16x8 a, bf16x8 b, f32x16 c) { return __builtin_amdgcn_mfma_f32_32x32x16_bf16(a, b, c, 0, 0, 0); }
DEV f32x4 mfma16(bf16x8 a, bf16x8 b, f32x4 c) { return __builtin_amdgcn_mfma_f32_16x16x32_bf16(a, b, c, 0, 0, 0); }

struct MapId { DEV int operator()(int n) const { return n; } };
struct MapFfnIn {
  DEV int operator()(int n) const {
    int t = n >> 7, w = n & 127;
    int wn = w >> 6, nt = (w >> 5) & 1, c = w & 31;
    return nt * DFF + t * 64 + wn * 32 + c;
  }
};
struct MapEvenIn {
  DEV int operator()(int n) const {
    if (n < 1536) return n;
    if (n < 3072) return 1544 + (n - 1536);
    if (n < 3584) return 3088 + (n - 3072);
    if (n < 3592) return 1536 + (n - 3584);
    if (n < 3600) return 3080 + (n - 3592);
    return -1;
  }
};

template <class Map>
DEV void conv_t(const float* __restrict__ src, int Nsrc, int K, bf16_t* __restrict__ dst, int Np, Map map, unsigned char* smem) {
  float* tile = (float*)smem;
  const int tid = ltid();
  const int ntn = Np >> 6, ntk = K >> 6;
  for (int t = blockIdx.x; t < ntn * ntk; t += gridDim.x) {
    const int tn = t % ntn, tk = t / ntn;
    {
      const int c = tid & 63, r0 = tid >> 6;
      const int sc = map(tn * 64 + c);
#pragma unroll
      for (int i = 0; i < 16; ++i) {
        const int k = tk * 64 + r0 + 4 * i;
        tile[(r0 + 4 * i) * 65 + c] = (sc >= 0) ? src[(size_t)k * Nsrc + sc] : 0.f;
      }
    }
    __syncthreads();
    {
      const int kk = tid & 63, n0 = tid >> 6;
#pragma unroll
      for (int i = 0; i < 16; ++i) {
        const int n = n0 + 4 * i;
        dst[(size_t)(tn * 64 + n) * K + tk * 64 + kk] = f2bf(tile[kk * 65 + n]);
      }
    }
    __syncthreads();
  }
}

DEV void phase0(const P& p, unsigned char* smem) {
  const int tid = ltid();
  const size_t gt = (size_t)blockIdx.x * 256 + tid, gn = (size_t)gridDim.x * 256;
  {
    float* X = p.out + O_Y;
    bf16_t* Xb = (bf16_t*)(p.ws + A_XB);
    const size_t n4p = (size_t)MP * D / 4, n4 = (size_t)M * D / 4;
    for (size_t i = gt; i < n4; i += gn) {
      f32x4 v = (i < n4p) ? ((const f32x4*)p.in[0])[i] : ((const f32x4*)p.in[1])[i - n4p];
      ((f32x4*)X)[i] = v;
      u32x2 o; o[0] = pack2(v[0], v[1]); o[1] = pack2(v[2], v[3]);
      ((u32x2*)Xb)[i] = o;
    }
  }
  for (int l = 0; l < 2; ++l)
    for (int f = 0; f < 2; ++f) {
      const int idx = l * 2 + f;
      conv_t(p.in[9] + (size_t)idx * 1024 * 5632, 5632, 1024, (bf16_t*)(p.ws + W_FFN_IN + idx * SZ_FFN_IN), 5632, MapFfnIn(), smem);
      conv_t(p.in[10] + (size_t)idx * 2816 * 1024, 1024, 2816, (bf16_t*)(p.ws + W_FFN_OUT + idx * SZ_FFN_OUT), 1024, MapId(), smem);
    }
  conv_t(p.in[13], 3600, 1024, (bf16_t*)(p.ws + W_EVEN_IN), 3712, MapEvenIn(), smem);
  conv_t(p.in[19], 1024, 1024, (bf16_t*)(p.ws + W_EVEN_OUT), 1024, MapId(), smem);
  conv_t(p.in[20], 1024, 1024, (bf16_t*)(p.ws + W_ODD_IN), 1024, MapId(), smem);
  conv_t(p.in[29], 1024, 1024, (bf16_t*)(p.ws + W_GLU), 1024, MapId(), smem);
  conv_t(p.in[31], 1024, 1024, (bf16_t*)(p.ws + W_ODD_OUT), 1024, MapId(), smem);
  if (gt < 4096) {
    const int g = (int)gt >> 6, pp = (int)gt & 63;
    const float step = expf(p.in[23][g]);
    const float lr = p.in[21][gt], li = p.in[22][gt];
    const float a = lr * step, b = li * step;
    const float ea = expf(a);
    float sb, cb; sincosf(b, &sb, &cb);
    const float lbr = ea * cb, lbi = ea * sb;
    const float sh = sinf(0.5f * b);
    const float nr = expm1f(a) * cb - 2.f * sh * sh, ni = lbi;
    const float dd = lr * lr + li * li;
    const float cr = (nr * lr + ni * li) / dd, ci = (ni * lr - nr * li) / dd;
    bf16_t* Bp = (bf16_t*)(p.ws + W_S5B);
    bf16_t* Cp = (bf16_t*)(p.ws + W_S5C);
    for (int c = 0; c < 16; ++c) {
      const float br = p.in[24][gt * 16 + c], bi = p.in[25][gt * 16 + c];
      Bp[((size_t)g * 128 + pp) * 16 + c] = f2bf(cr * br - ci * bi);
      Bp[((size_t)g * 128 + 64 + pp) * 16 + c] = f2bf(cr * bi + ci * br);
      Cp[((size_t)g * 16 + c) * 128 + pp] = f2bf(p.in[26][((size_t)g * 16 + c) * 64 + pp]);
      Cp[((size_t)g * 16 + c) * 128 + 64 + pp] = f2bf(-p.in[27][((size_t)g * 16 + c) * 64 + pp]);
    }
    ((f32x2*)(p.ws + W_LAMB))[gt] = (f32x2){lbr, lbi};
    float xr = lbr, xi = lbi;
    for (int i = 0; i < 8; ++i) { const float nr2 = xr * xr - xi * xi, ni2 = 2.f * xr * xi; xr = nr2; xi = ni2; }
    ((f32x2*)(p.ws + W_LAM256))[gt] = (f32x2){xr, xi};
  }
  if (gt < 64) ((unsigned*)(p.ws + W_CTR))[gt] = 0u;
}

template <class Epi>
DEV void gemm_phase(const bf16_t* __restrict__ A, int lda, const bf16_t* __restrict__ Wt, int K, int NT, Epi epi, unsigned char* smem) {
  const int tid = ltid(), lane = tid & 63, wave = tid >> 6, wm = wave >> 1, wn = wave & 1;
  const int r = lane & 31, hh = lane >> 5;
  bf16_t* As = (bf16_t*)smem;
  bf16_t* Bs = As + 2 * 128 * 72;
  const int nk = K >> 6;
  const int lrow = tid >> 3, lcc = tid & 7;
  const int xcd = blockIdx.x & 7, jx = blockIdx.x >> 3, nb = gridDim.x >> 3;
  const int U = (64 + nb - 1) / nb;
  const int n8 = NT >> 3, remc = NT & 7, has4 = (remc >= 4) ? 1 : 0, rem1 = remc - 4 * has4;
  const int NP = n8 * 32 + has4 * 16 + rem1 * 4;
  const int nPI = (xcd < NP) ? ((NP - xcd + 7) >> 3) * U : 0;
  const int nS = (blockIdx.x < 2 * NT) ? (2 * NT - blockIdx.x + gridDim.x - 1) / gridDim.x : 0;
  for (int w = 0; w < nPI + nS; ++w) {
    int tm, tn;
    if (w < nPI) {
      const int q = xcd + 8 * (w / U), jj = jx + nb * (w % U);
      if (jj >= 64) continue;
      if (q < n8 * 32) { const int c = q >> 5, lp = q & 31; tm = lp * 8 + (jj & 7); tn = c * 8 + (jj >> 3); }
      else {
        const int q2 = q - n8 * 32;
        if (has4 && q2 < 16) { tm = q2 * 16 + (jj & 15); tn = n8 * 8 + (jj >> 4); }
        else { const int q3 = q2 - has4 * 16; tm = (q3 & 3) * 64 + jj; tn = n8 * 8 + has4 * 4 + (q3 >> 2); }
      }
    } else {
      const int sidx = blockIdx.x + (w - nPI) * gridDim.x;
      tm = 256 + (sidx & 1); tn = sidx >> 1;
    }
    const bf16_t* Ag = A + (size_t)(tm * 128 + lrow) * lda + lcc * 8;
    const bf16_t* Bg = Wt + (size_t)(tn * 128 + lrow) * K + lcc * 8;
    f32x16 acc[2][2];
#pragma unroll
    for (int i = 0; i < 2; ++i)
#pragma unroll
      for (int j = 0; j < 2; ++j)
#pragma unroll
        for (int q = 0; q < 16; ++q) acc[i][j][q] = 0.f;
    u32x4 ra0[4], rb0[4], ra1[4], rb1[4];
#define G_LOAD(RA, RB, KT)                                                                   \
    _Pragma("unroll") for (int i = 0; i < 4; ++i) {                                         \
      RA[i] = *(const u32x4*)(Ag + (size_t)(32 * i) * lda + (KT) * 64);                      \
      RB[i] = *(const u32x4*)(Bg + (size_t)(32 * i) * K + (KT) * 64); }
#define G_WRITE(RA, RB, BUF)                                                                 \
    _Pragma("unroll") for (int i = 0; i < 4; ++i) {                                         \
      *(u32x4*)(As + (BUF) * 128 * 72 + (lrow + 32 * i) * 72 + lcc * 8) = RA[i];             \
      *(u32x4*)(Bs + (BUF) * 128 * 72 + (lrow + 32 * i) * 72 + lcc * 8) = RB[i]; }
#define G_COMPUTE(BUF)                                                                       \
    _Pragma("unroll") for (int ks = 0; ks < 4; ++ks) {                                      \
      bf16x8 af[2], bfr[2];                                                                  \
      _Pragma("unroll") for (int i = 0; i < 2; ++i) {                                       \
        af[i] = *(const bf16x8*)(As + (BUF) * 128 * 72 + (wm * 64 + i * 32 + r) * 72 + ks * 16 + hh * 8);  \
        bfr[i] = *(const bf16x8*)(Bs + (BUF) * 128 * 72 + (wn * 64 + i * 32 + r) * 72 + ks * 16 + hh * 8); } \
      _Pragma("unroll") for (int i = 0; i < 2; ++i)                                         \
        _Pragma("unroll") for (int j = 0; j < 2; ++j) acc[i][j] = mfma32(af[i], bfr[j], acc[i][j]); }
    G_LOAD(ra0, rb0, 0)
    G_WRITE(ra0, rb0, 0)
    G_LOAD(ra0, rb0, 1)
    G_LOAD(ra1, rb1, 2)
    __syncthreads();
    for (int kt = 0; kt < nk; kt += 2) {
      G_WRITE(ra0, rb0, 1)
      if (kt + 3 < nk) { G_LOAD(ra0, rb0, kt + 3) }
      __builtin_amdgcn_sched_barrier(0);
      G_COMPUTE(0)
      __syncthreads();
      if (kt + 2 < nk) { G_WRITE(ra1, rb1, 0) }
      if (kt + 4 < nk) { G_LOAD(ra1, rb1, kt + 4) }
      __builtin_amdgcn_sched_barrier(0);
      G_COMPUTE(1)
      __syncthreads();
    }
#undef G_LOAD
#undef G_WRITE
#undef G_COMPUTE
    epi(acc, tm * 128 + wm * 64, tn, wn, lane);
    __syncthreads();
  }
}

struct EpiSwiglu {
  bf16_t* act;
  DEV void operator()(const f32x16 (&acc)[2][2], int row0, int tn, int wn, int lane) const {
    const int r = lane & 31, hh = lane >> 5;
    const int col = tn * 64 + wn * 32 + r;
#pragma unroll
    for (int mt = 0; mt < 2; ++mt)
#pragma unroll
      for (int q = 0; q < 16; ++q) {
        const int row = row0 + mt * 32 + (q & 3) + 8 * (q >> 2) + 4 * hh;
        const float a = acc[mt][0][q], b = acc[mt][1][q];
        act[(size_t)row * DFF + col] = f2bf(silu_f(a) * b);
      }
  }
};
template <class F>
struct EpiElem {
  F f;
  DEV void operator()(const f32x16 (&acc)[2][2], int row0, int tn, int wn, int lane) const {
    const int r = lane & 31, hh = lane >> 5;
#pragma unroll
    for (int mt = 0; mt < 2; ++mt)
#pragma unroll
      for (int nt = 0; nt < 2; ++nt)
#pragma unroll
        for (int q = 0; q < 16; ++q) {
          const int row = row0 + mt * 32 + (q & 3) + 8 * (q >> 2) + 4 * hh;
          const int col = tn * 128 + wn * 64 + nt * 32 + r;
          f(row, col, acc[mt][nt][q]);
        }
  }
};
struct FResid {
  float* X; float scale;
  DEV void operator()(int row, int col, float v) const {
    float* px = X + (size_t)row * D + col;
    *px = ALPHA * (*px) + scale * v;
  }
};
struct FStoreF32 {
  float* U;
  DEV void operator()(int row, int col, float v) const { U[(size_t)row * D + col] = v; }
};
struct FGlu {
  const bf16_t* zz; const float* bias; bf16_t* out;
  DEV void operator()(int row, int col, float v) const {
    const size_t i = (size_t)row * D + col;
    out[i] = f2bf(bf2f(zz[i]) * sigmoid_f(v + bias[col]));
  }
};
#define EACH_TILE(FN) FN(acc[0][0], 0, 0); FN(acc[0][1], 0, 1); FN(acc[1][0], 1, 0); FN(acc[1][1], 1, 1);
struct EpiEvenIn {
  P p;
  DEV void operator()(const f32x16 (&acc)[2][2], int row0, int tn, int wn, int lane) const {
    const int r = lane & 31, hh = lane >> 5;
    const bool samp = row0 >= MP;
    const int clb = wn * 64 + r;
    if (tn < 4) {
      bf16_t* MIX = (bf16_t*)(p.ws + R_MIX);
      float* QS = (float*)(p.ws + R_QS);
      auto fn = [&](const f32x16& a, int mt, int nt) {
        const int col = tn * 128 + clb + nt * 32;
#pragma unroll
        for (int q = 0; q < 16; ++q) {
          const int row = row0 + mt * 32 + (q & 3) + 8 * (q >> 2) + 4 * hh;
          MIX[(size_t)row * 1024 + col] = f2bf(a[q]);
          if (samp) QS[(size_t)(row - MP) * 512 + col] = a[q];
        }
      };
      EACH_TILE(fn)
    } else if (tn < 8) {
      bf16_t* KB = (bf16_t*)(p.ws + R_KB);
      float* ok = samp ? (p.out + O_FKS - (size_t)MP * 512) : (p.out + O_FKP);
      auto fn = [&](const f32x16& a, int mt, int nt) {
        const int col = (tn - 4) * 128 + clb + nt * 32;
#pragma unroll
        for (int q = 0; q < 16; ++q) {
          const int row = row0 + mt * 32 + (q & 3) + 8 * (q >> 2) + 4 * hh;
          KB[(size_t)row * 512 + col] = f2bf(a[q]);
          ok[(size_t)row * 512 + col] = a[q];
        }
      };
      EACH_TILE(fn)
    } else if (tn < 12) {
      if (!samp) {
        bf16_t* VT = (bf16_t*)(p.ws + R_VT);
        auto fn = [&](const f32x16& a, int mt, int nt) {
          const int col = (tn - 8) * 128 + clb + nt * 32;
          const int hd = col >> 6, dh = col & 63;
#pragma unroll
          for (int g = 0; g < 4; ++g) {
            const int row = row0 + mt * 32 + 8 * g + 4 * hh;
            const int b = row >> 14, tt = row & (T - 1);
            u32x2 o; o[0] = pack2(a[4 * g], a[4 * g + 1]); o[1] = pack2(a[4 * g + 2], a[4 * g + 3]);
            *(u32x2*)(VT + ((size_t)(b * 8 + hd) * 64 + dh) * T + tt) = o;
#pragma unroll
            for (int e = 0; e < 4; ++e) p.out[O_FVP + (size_t)(row + e) * 512 + col] = a[4 * g + e];
          }
        };
        EACH_TILE(fn)
      } else {
        auto fn = [&](const f32x16& a, int mt, int nt) {
          const int col = (tn - 8) * 128 + clb + nt * 32;
#pragma unroll
          for (int q = 0; q < 16; ++q) {
            const int row = row0 + mt * 32 + (q & 3) + 8 * (q >> 2) + 4 * hh;
            p.out[O_FVS + (size_t)(row - MP) * 512 + col] = a[q];
          }
        };
        EACH_TILE(fn)
      }
    } else if (tn < 24) {
      bf16_t* GB = (bf16_t*)(p.ws + R_GB);
      auto fn = [&](const f32x16& a, int mt, int nt) {
        const int col = (tn - 12) * 128 + clb + nt * 32;
#pragma unroll
        for (int q = 0; q < 16; ++q) {
          const int row = row0 + mt * 32 + (q & 3) + 8 * (q >> 2) + 4 * hh;
          const float v = a[q];
          GB[(size_t)row * 1536 + col] = f2bf(v);
          if (!samp) {
            const int tt = row & (T - 1);
            if (tt >= T - 3) p.out[O_GCP + (size_t)((row >> 14) * 3 + (tt - (T - 3))) * 1536 + col] = v;
          } else {
            const int tt = (row - MP) & 31;
            if (tt >= 29) p.out[O_GCS + (size_t)(((row - MP) >> 5) * 3 + (tt - 29)) * 1536 + col] = v;
          }
        }
      };
      EACH_TILE(fn)
    } else if (tn < 28) {
      bf16_t* MIX = (bf16_t*)(p.ws + R_MIX);
      auto fn = [&](const f32x16& a, int mt, int nt) {
        const int col = (tn - 24) * 128 + clb + nt * 32;
#pragma unroll
        for (int q = 0; q < 16; ++q) {
          const int row = row0 + mt * 32 + (q & 3) + 8 * (q >> 2) + 4 * hh;
          MIX[(size_t)row * 1024 + 512 + col] = f2bf(a[q]);
        }
      };
      EACH_TILE(fn)
    } else {
      float* LOGF = (float*)(p.ws + R_LOGF);
      float* GG = (float*)(p.ws + R_GG);
      float* BETA = (float*)(p.ws + R_BETA);
      if (wn == 0 && r < 16) {
        const int cl = r;
        float* ol = samp ? (p.out + O_FLS - (size_t)MP * 8) : (p.out + O_FLP);
        const float bias = (cl < 8) ? p.in[14][cl] : ((cl < 12) ? p.in[17][cl - 8] : 0.f);
        const float ea = (cl >= 8 && cl < 12) ? __expf(p.in[16][cl - 8]) : 0.f;
        auto fn = [&](const f32x16& a, int mt, int nt) {
          if (nt == 0) {
#pragma unroll
            for (int q = 0; q < 16; ++q) {
              const int row = row0 + mt * 32 + (q & 3) + 8 * (q >> 2) + 4 * hh;
              const float v = a[q];
              if (cl < 8) {
                const float lf = -softplus_f(-(v + bias));
                LOGF[(size_t)row * 8 + cl] = lf;
                ol[(size_t)row * 8 + cl] = lf;
              } else if (cl < 12) {
                GG[(size_t)row * 4 + (cl - 8)] = -ea * softplus_f(v + bias);
              } else {
                BETA[(size_t)row * 4 + (cl - 12)] = sigmoid_f(v);
              }
            }
          }
        };
        EACH_TILE(fn)
      }
    }
  }
};

DEV void ln_phase(float* __restrict__ X, bf16_t* __restrict__ Xb, const float* __restrict__ g, const float* __restrict__ b, bool write_bf) {
  const int tid_ = ltid();
  const int lane = tid_ & 63, wave = tid_ >> 6;
  const int gw = blockIdx.x * 4 + wave, nw = gridDim.x * 4;
  f32x4 gv[4], bv[4];
#pragma unroll
  for (int i = 0; i < 4; ++i) { gv[i] = ((const f32x4*)g)[i * 64 + lane]; bv[i] = ((const f32x4*)b)[i * 64 + lane]; }
  for (int row = gw; row < M; row += nw) {
    f32x4* xr = (f32x4*)(X + (size_t)row * D);
    f32x4 v[4];
    float s = 0.f;
#pragma unroll
    for (int i = 0; i < 4; ++i) { v[i] = xr[i * 64 + lane]; s += (v[i][0] + v[i][1]) + (v[i][2] + v[i][3]); }
    const float mu = wave_sum(s) * (1.f / D);
    float q = 0.f;
#pragma unroll
    for (int i = 0; i < 4; ++i) { v[i] = v[i] - mu; q += (v[i][0] * v[i][0] + v[i][1] * v[i][1]) + (v[i][2] * v[i][2] + v[i][3] * v[i][3]); }
    const float rs = rsqrtf(wave_sum(q) * (1.f / D) + 1e-5f);
#pragma unroll
    for (int i = 0; i < 4; ++i) {
      f32x4 o = v[i] * rs * gv[i] + bv[i];
      xr[i * 64 + lane] = o;
      if (write_bf) {
        u32x2 pk; pk[0] = pack2(o[0], o[1]); pk[1] = pack2(o[2], o[3]);
        ((u32x2*)(Xb + (size_t)row * D))[i * 64 + lane] = pk;
      }
    }
  }
}

DEV void cumsum_prompt(const P& p, int b, unsigned char* smem) {
  const float* LOGF = (const float*)(p.ws + R_LOGF) + (size_t)b * T * 8;
  float* CUM = (float*)(p.ws + R_CUM) + (size_t)b * T * 8;
  float* tot = (float*)smem;
  const int tid = ltid();
  float s[8];
#pragma unroll
  for (int h = 0; h < 8; ++h) s[h] = 0.f;
  for (int i = 0; i < 64; ++i) {
    const f32x4* r = (const f32x4*)(LOGF + (size_t)(tid * 64 + i) * 8);
    f32x4 a = r[0], c = r[1];
    s[0] += a[0]; s[1] += a[1]; s[2] += a[2]; s[3] += a[3]; s[4] += c[0]; s[5] += c[1]; s[6] += c[2]; s[7] += c[3];
  }
#pragma unroll
  for (int h = 0; h < 8; ++h) tot[tid * 8 + h] = s[h];
  __syncthreads();
  if (tid < 8) {
    float run = 0.f;
    for (int i = 0; i < 256; ++i) { const float v = tot[i * 8 + tid]; tot[i * 8 + tid] = run; run += v; }
  }
  __syncthreads();
#pragma unroll
  for (int h = 0; h < 8; ++h) s[h] = tot[tid * 8 + h];
  for (int i = 0; i < 64; ++i) {
    const f32x4* r = (const f32x4*)(LOGF + (size_t)(tid * 64 + i) * 8);
    f32x4 a = r[0], c = r[1];
    s[0] += a[0]; s[1] += a[1]; s[2] += a[2]; s[3] += a[3]; s[4] += c[0]; s[5] += c[1]; s[6] += c[2]; s[7] += c[3];
    f32x4* w = (f32x4*)(CUM + (size_t)(tid * 64 + i) * 8);
    w[0] = (f32x4){s[0], s[1], s[2], s[3]};
    w[1] = (f32x4){s[4], s[5], s[6], s[7]};
  }
  __syncthreads();
}

DEV void gdn_prep_item(const P& p, int item, unsigned char* smem) {
  const int tid = ltid(), lane = tid & 63, wave = tid >> 6;
  float* Kf = (float*)smem;
  float* Qf = Kf + 64 * 132;
  float* gc = Qf + 64 * 132;
  float* bt = gc + 64;
  float* eg = bt + 64;
  float* rk = eg + 64;
  float* rq = rk + 64;
  const bf16_t* GB = (const bf16_t*)(p.ws + R_GB);
  const float* GG = (const float*)(p.ws + R_GG);
  const float* BETA = (const float*)(p.ws + R_BETA);
  const float* cw = p.in[15];
  const bool samp = item >= 2048;
  const int h = item & 3;
  int row0, L; bool has_prev; const float* cbuf = nullptr;
  if (!samp) { const int chunk = (item >> 2) & 255, b = item >> 10; row0 = b * T + chunk * 64; L = 64; has_prev = chunk > 0; }
  else { const int sb = (item - 2048) >> 2; row0 = MP + sb * 32; L = 32; has_prev = false; cbuf = p.in[6] + (size_t)sb * 3 * 1536; }
  auto getx = [&](int i, int colg) -> float {
    if (i >= 0) return (i < L) ? bf2f(GB[(size_t)(row0 + i) * 1536 + colg]) : 0.f;
    if (samp) return cbuf[(3 + i) * 1536 + colg];
    return has_prev ? bf2f(GB[(size_t)(row0 + i) * 1536 + colg]) : 0.f;
  };
  const int c = tid & 127;
  const int half = tid >> 7;
  {
    const int colk = 512 + h * 128 + c, colq = h * 128 + c;
    const float k0 = cw[colk], k1 = cw[1536 + colk], k2 = cw[2 * 1536 + colk], k3 = cw[3 * 1536 + colk];
    const float q0 = cw[colq], q1 = cw[1536 + colq], q2 = cw[2 * 1536 + colq], q3 = cw[3 * 1536 + colq];
    const int i0 = half * 32;
    float a3 = getx(i0 - 3, colk), a2 = getx(i0 - 2, colk), a1 = getx(i0 - 1, colk);
    float b3 = getx(i0 - 3, colq), b2 = getx(i0 - 2, colq), b1 = getx(i0 - 1, colq);
#pragma unroll 8
    for (int ii = 0; ii < 32; ++ii) {
      const int i = i0 + ii;
      const float xa = getx(i, colk), xb = getx(i, colq);
      float ya = k0 * a3 + k1 * a2 + k2 * a1 + k3 * xa;
      float yb = q0 * b3 + q1 * b2 + q2 * b1 + q3 * xb;
      ya = (i < L) ? silu_f(ya) : 0.f;
      yb = (i < L) ? silu_f(yb) : 0.f;
      Kf[i * 132 + c] = ya;
      Qf[i * 132 + c] = yb;
      a3 = a2; a2 = a1; a1 = xa;
      b3 = b2; b2 = b1; b1 = xb;
    }
  }
  __syncthreads();
  for (int i = wave * 16; i < wave * 16 + 16; ++i) {
    const float a0 = Kf[i * 132 + lane], a1 = Kf[i * 132 + 64 + lane];
    const float sk = wave_sum(a0 * a0 + a1 * a1);
    const float b0 = Qf[i * 132 + lane], b1 = Qf[i * 132 + 64 + lane];
    const float sq = wave_sum(b0 * b0 + b1 * b1);
    if (lane == 0) { rk[i] = rsqrtf(sk + 1e-6f); rq[i] = rsqrtf(sq + 1e-6f) * 0.08838834764831845f; }
  }
  if (wave == 0) {
    float gi = (lane < L) ? GG[(size_t)(row0 + lane) * 4 + h] : 0.f;
    const float bi = (lane < L) ? BETA[(size_t)(row0 + lane) * 4 + h] : 0.f;
#pragma unroll
    for (int o = 1; o < 64; o <<= 1) { const float tt = __shfl_up(gi, o); if (lane >= o) gi += tt; }
    gc[lane] = gi; eg[lane] = __expf(gi); bt[lane] = bi;
  }
  __syncthreads();
  {
#pragma unroll 4
    for (int ii = 0; ii < 32; ++ii) {
      const int i = half * 32 + ii;
      Kf[i * 132 + c] *= rk[i];
      Qf[i * 132 + c] *= rq[i];
    }
  }
  __syncthreads();
  bf16_t* PW = (bf16_t*)(p.ws + A_PW) + (size_t)item * 8192;
  bf16_t* PQG = (bf16_t*)(p.ws + A_PQG) + (size_t)item * 8192;
  bf16_t* PKDT = (bf16_t*)(p.ws + A_PKDT) + (size_t)item * 8192;
  bf16_t* PUT = (bf16_t*)(p.ws + A_PUT) + (size_t)item * 8192;
  bf16_t* PATT = (bf16_t*)(p.ws + A_PATT) + (size_t)item * 4096;
  float* PGL = (float*)(p.ws + A_PGL);
  const float gl = gc[63];
  {
#pragma unroll 4
    for (int ii = 0; ii < 32; ++ii) {
      const int i = half * 32 + ii;
      PQG[i * 128 + c] = f2bf(Qf[i * 132 + c] * eg[i]);
    }
#pragma unroll
    for (int j8 = 0; j8 < 4; ++j8) {
      const int j0 = half * 32 + j8 * 8;
      float e[8];
#pragma unroll
      for (int t = 0; t < 8; ++t) e[t] = Kf[(j0 + t) * 132 + c] * __expf(gl - gc[j0 + t]);
      u32x4 o;
      o[0] = pack2(e[0], e[1]); o[1] = pack2(e[2], e[3]); o[2] = pack2(e[4], e[5]); o[3] = pack2(e[6], e[7]);
      *(u32x4*)(PKDT + c * 64 + j0) = o;
    }
    if (tid == 0) PGL[item] = __expf(gl);
  }
  const int ti = tid >> 4, tj = tid & 15;
  {
    float accA[4][4], accN[4][4];
#pragma unroll
    for (int a = 0; a < 4; ++a)
#pragma unroll
      for (int b = 0; b < 4; ++b) { accA[a][b] = 0.f; accN[a][b] = 0.f; }
#pragma unroll 2
    for (int cc = 0; cc < 128; cc += 4) {
      f32x4 qi[4], ki[4], kj[4];
#pragma unroll
      for (int a = 0; a < 4; ++a) {
        qi[a] = *(const f32x4*)(Qf + (ti + 16 * a) * 132 + cc);
        ki[a] = *(const f32x4*)(Kf + (ti + 16 * a) * 132 + cc);
        kj[a] = *(const f32x4*)(Kf + (tj + 16 * a) * 132 + cc);
      }
#pragma unroll
      for (int a = 0; a < 4; ++a)
#pragma unroll
        for (int b = 0; b < 4; ++b) {
          accA[a][b] += qi[a][0] * kj[b][0] + qi[a][1] * kj[b][1] + qi[a][2] * kj[b][2] + qi[a][3] * kj[b][3];
          accN[a][b] += ki[a][0] * kj[b][0] + ki[a][1] * kj[b][1] + ki[a][2] * kj[b][2] + ki[a][3] * kj[b][3];
        }
    }
    __syncthreads();
    float* Nl = Qf;
#pragma unroll
    for (int a = 0; a < 4; ++a)
#pragma unroll
      for (int b = 0; b < 4; ++b) {
        const int i = ti + 16 * a, j = tj + 16 * b;
        const float dec = (j <= i) ? __expf(gc[i] - gc[j]) : 0.f;
        PATT[i * 64 + j] = f2bf((j <= i) ? accA[a][b] * dec : 0.f);
        Nl[i * 68 + j] = (j < i) ? accN[a][b] * bt[i] * dec : 0.f;
      }
  }
  __syncthreads();
  {
    const float* Nl = Qf;
    float col[64];
    if (tid < 128) {
      const int colg = 1024 + h * 128 + c;
      const float w0 = cw[colg], w1 = cw[1536 + colg], w2 = cw[2 * 1536 + colg], w3 = cw[3 * 1536 + colg];
      float x3 = getx(-3, colg), x2 = getx(-2, colg), x1 = getx(-1, colg);
#pragma unroll
      for (int i = 0; i < 64; ++i) {
        const float x = getx(i, colg);
        float y = w0 * x3 + w1 * x2 + w2 * x1 + w3 * x;
        y = (i < L) ? silu_f(y) : 0.f;
        col[i] = y * bt[i];
        x3 = x2; x2 = x1; x1 = x;
      }
    } else {
#pragma unroll
      for (int i = 0; i < 64; ++i) col[i] = Kf[i * 132 + c] * bt[i] * eg[i];
    }
#pragma unroll
    for (int i = 1; i < 64; ++i) {
      float sacc = 0.f;
#pragma unroll
      for (int j4 = 0; j4 < (i + 3) / 4; ++j4) {
        const f32x4 nv = *(const f32x4*)(Nl + i * 68 + j4 * 4);
#pragma unroll
        for (int e = 0; e < 4; ++e)
          if (j4 * 4 + e < i) sacc += nv[e] * col[j4 * 4 + e];
      }
      col[i] -= sacc;
    }
    if (tid < 128) {
#pragma unroll
      for (int j8 = 0; j8 < 8; ++j8) {
        u32x4 o;
        o[0] = pack2(col[j8 * 8 + 0], col[j8 * 8 + 1]); o[1] = pack2(col[j8 * 8 + 2], col[j8 * 8 + 3]);
        o[2] = pack2(col[j8 * 8 + 4], col[j8 * 8 + 5]); o[3] = pack2(col[j8 * 8 + 6], col[j8 * 8 + 7]);
        *(u32x4*)(PUT + c * 64 + j8 * 8) = o;
      }
    } else {
#pragma unroll
      for (int i = 0; i < 64; ++i) PW[i * 128 + c] = f2bf(col[i]);
    }
  }
  __syncthreads();
}

struct GdnFr { bf16x8 w[4], qg[4], att[2], kd[2][2]; u32x2 u; float gl; };
DEV void gdn_load(GdnFr& f, const P& p, int item, int sl, int wave, int lane) {
  const int r16 = lane & 15, q4 = lane >> 4;
  const bf16_t* PW = (const bf16_t*)(p.ws + A_PW) + (size_t)item * 8192;
  const bf16_t* PQG = (const bf16_t*)(p.ws + A_PQG) + (size_t)item * 8192;
  const bf16_t* PKDT = (const bf16_t*)(p.ws + A_PKDT) + (size_t)item * 8192;
  const bf16_t* PUT = (const bf16_t*)(p.ws + A_PUT) + (size_t)item * 8192;
  const bf16_t* PATT = (const bf16_t*)(p.ws + A_PATT) + (size_t)item * 4096;
#pragma unroll
  for (int ks = 0; ks < 4; ++ks) {
    f.w[ks] = *(const bf16x8*)(PW + (wave * 16 + r16) * 128 + ks * 32 + q4 * 8);
    f.qg[ks] = *(const bf16x8*)(PQG + (wave * 16 + r16) * 128 + ks * 32 + q4 * 8);
  }
#pragma unroll
  for (int ks = 0; ks < 2; ++ks) {
    f.att[ks] = *(const bf16x8*)(PATT + (wave * 16 + r16) * 64 + ks * 32 + q4 * 8);
#pragma unroll
    for (int mt = 0; mt < 2; ++mt) f.kd[mt][ks] = *(const bf16x8*)(PKDT + (wave * 32 + mt * 16 + r16) * 64 + ks * 32 + q4 * 8);
  }
  f.u = *(const u32x2*)(PUT + (sl * 16 + r16) * 64 + wave * 16 + q4 * 4);
  f.gl = ((const float*)(p.ws + A_PGL))[item];
}

DEV void gdn_scan_chain(const P& p, int chain, unsigned char* smem) {
  const int tid = ltid(), lane = tid & 63, wave = tid >> 6;
  const int r16 = lane & 15, q4 = lane >> 4;
  bf16_t* Sb = (bf16_t*)smem;
  bf16_t* Vn = Sb + 16 * 136;
  float* ORAW = (float*)(p.ws + R_GB);
  int sl, h, nchunks, item0, rowbase, nvalid; float* sout; const float* s0 = nullptr;
  if (chain < 64) { sl = chain & 7; h = (chain >> 3) & 3; const int b = chain >> 5; nchunks = 256; item0 = b * 1024 + h; rowbase = b * T; nvalid = 64;
    sout = p.out + O_GSP + (size_t)(b * 4 + h) * 16384; }
  else { const int cs = chain - 64; sl = cs & 7; h = (cs >> 3) & 3; const int sb = cs >> 5; nchunks = 1; item0 = 2048 + sb * 4 + h; rowbase = MP + sb * 32; nvalid = 32;
    sout = p.out + O_GSS + (size_t)(sb * 4 + h) * 16384; s0 = p.in[5] + (size_t)(sb * 4 + h) * 16384; }
  f32x4 S[2];
#pragma unroll
  for (int mt = 0; mt < 2; ++mt)
#pragma unroll
    for (int e = 0; e < 4; ++e) S[mt][e] = s0 ? s0[(size_t)(wave * 32 + mt * 16 + q4 * 4 + e) * 128 + sl * 16 + r16] : 0.f;
#pragma unroll
  for (int mt = 0; mt < 2; ++mt) {
    u32x2 o; o[0] = pack2(S[mt][0], S[mt][1]); o[1] = pack2(S[mt][2], S[mt][3]);
    *(u32x2*)(Sb + r16 * 136 + wave * 32 + mt * 16 + q4 * 4) = o;
  }
  GdnFr cur, nxt;
  gdn_load(cur, p, item0, sl, wave, lane);
  __syncthreads();
  for (int ch = 0; ch < nchunks; ++ch) {
    if (ch + 1 < nchunks) gdn_load(nxt, p, item0 + (ch + 1) * 4, sl, wave, lane);
    f32x4 ws = {0.f, 0.f, 0.f, 0.f}, qs = {0.f, 0.f, 0.f, 0.f};
#pragma unroll
    for (int ks = 0; ks < 4; ++ks) {
      const bf16x8 sf = *(const bf16x8*)(Sb + r16 * 136 + ks * 32 + q4 * 8);
      ws = mfma16(cur.w[ks], sf, ws);
      qs = mfma16(cur.qg[ks], sf, qs);
    }
    f32x4 vn;
    vn[0] = bf2f((bf16_t)(cur.u[0] & 0xffff)) - ws[0];
    vn[1] = bf2f((bf16_t)(cur.u[0] >> 16)) - ws[1];
    vn[2] = bf2f((bf16_t)(cur.u[1] & 0xffff)) - ws[2];
    vn[3] = bf2f((bf16_t)(cur.u[1] >> 16)) - ws[3];
    {
      u32x2 o; o[0] = pack2(vn[0], vn[1]); o[1] = pack2(vn[2], vn[3]);
      *(u32x2*)(Vn + r16 * 72 + wave * 16 + q4 * 4) = o;
    }
    __syncthreads();
    bf16x8 vf[2];
#pragma unroll
    for (int ks = 0; ks < 2; ++ks) vf[ks] = *(const bf16x8*)(Vn + r16 * 72 + ks * 32 + q4 * 8);
#pragma unroll
    for (int ks = 0; ks < 2; ++ks) qs = mfma16(cur.att[ks], vf[ks], qs);
#pragma unroll
    for (int e = 0; e < 4; ++e) {
      const int i = wave * 16 + q4 * 4 + e;
      if (i < nvalid) ORAW[(size_t)(rowbase + ch * 64 + i) * 512 + h * 128 + sl * 16 + r16] = qs[e];
    }
#pragma unroll
    for (int mt = 0; mt < 2; ++mt) {
      f32x4 sn = S[mt] * cur.gl;
#pragma unroll
      for (int ks = 0; ks < 2; ++ks) sn = mfma16(cur.kd[mt][ks], vf[ks], sn);
      S[mt] = sn;
      u32x2 o; o[0] = pack2(sn[0], sn[1]); o[1] = pack2(sn[2], sn[3]);
      *(u32x2*)(Sb + r16 * 136 + wave * 32 + mt * 16 + q4 * 4) = o;
    }
    __syncthreads();
    if (ch + 1 < nchunks) cur = nxt;
  }
#pragma unroll
  for (int mt = 0; mt < 2; ++mt)
#pragma unroll
    for (int e = 0; e < 4; ++e) sout[(size_t)(wave * 32 + mt * 16 + q4 * 4 + e) * 128 + sl * 16 + r16] = S[mt][e];
  __syncthreads();
}

DEV void attn_prompt_item(const P& p, int bh, int qb, unsigned char* smem) {
  const int tid = ltid(), lane = tid & 63, wave = tid >> 6;
  const int r = lane & 31, hh = lane >> 5;
  const int b = bh >> 3, hd = bh & 7;
  bf16_t* Ks = (bf16_t*)smem;
  bf16_t* Vs = Ks + 2 * 64 * 72;
  float* Bi = (float*)(Vs + 2 * 64 * 72);
  bf16_t* MIX = (bf16_t*)(p.ws + R_MIX);
  const bf16_t* KB = (const bf16_t*)(p.ws + R_KB);
  const bf16_t* VT = (const bf16_t*)(p.ws + R_VT);
  const float* CUM = (const float*)(p.ws + R_CUM);
  const int qpos = qb * 128 + wave * 32 + r;
  const size_t qrow = (size_t)b * T + qpos;
  bf16x8 qf[4];
#pragma unroll
  for (int ks = 0; ks < 4; ++ks) qf[ks] = *(const bf16x8*)(MIX + qrow * 1024 + hd * 64 + ks * 16 + hh * 8);
  f32x16 o[2];
#pragma unroll
  for (int dt = 0; dt < 2; ++dt)
#pragma unroll
    for (int q = 0; q < 16; ++q) o[dt][q] = 0.f;
  float m = -INFINITY, lsum = 0.f;
  const int nkt = qb * 2 + 2;
  const int lrow = tid >> 3, lcc = tid & 7;
  const bf16_t* Kg = KB + ((size_t)b * T + lrow) * 512 + hd * 64 + lcc * 8;
  const bf16_t* Vg = VT + ((size_t)bh * 64 + lrow) * T + lcc * 8;
  u32x4 rk[2], rv[2]; float rbias = 0.f;
#pragma unroll
  for (int i = 0; i < 2; ++i) { rk[i] = *(const u32x4*)(Kg + (size_t)(32 * i) * 512); rv[i] = *(const u32x4*)(Vg + (size_t)(32 * i) * T); }
  if (tid < 64) rbias = -CUM[((size_t)b * T + tid) * 8 + hd] * LOG2E;
  const int qlast = qb * 128 + wave * 32 + 31;
  for (int kt = 0; kt < nkt; ++kt) {
    bf16_t* ks_ = Ks + (kt & 1) * 64 * 72;
    bf16_t* vs_ = Vs + (kt & 1) * 64 * 72;
    float* bi_ = Bi + (kt & 1) * 64;
#pragma unroll
    for (int i = 0; i < 2; ++i) {
      *(u32x4*)(ks_ + (lrow + 32 * i) * 72 + lcc * 8) = rk[i];
      *(u32x4*)(vs_ + (lrow + 32 * i) * 72 + lcc * 8) = rv[i];
    }
    if (tid < 64) bi_[tid] = rbias;
    __syncthreads();
    if (kt + 1 < nkt) {
#pragma unroll
      for (int i = 0; i < 2; ++i) {
        rk[i] = *(const u32x4*)(Kg + (size_t)((kt + 1) * 64 + 32 * i) * 512);
        rv[i] = *(const u32x4*)(Vg + (size_t)(32 * i) * T + (kt + 1) * 64);
      }
      if (tid < 64) rbias = -CUM[((size_t)b * T + (kt + 1) * 64 + tid) * 8 + hd] * LOG2E;
    }
    if (kt * 64 <= qlast) {
      f32x16 s[2];
#pragma unroll
      for (int k2 = 0; k2 < 2; ++k2) {
#pragma unroll
        for (int q = 0; q < 16; ++q) s[k2][q] = 0.f;
#pragma unroll
        for (int ks = 0; ks < 4; ++ks) {
          const bf16x8 kf = *(const bf16x8*)(ks_ + (32 * k2 + r) * 72 + ks * 16 + hh * 8);
          s[k2] = mfma32(kf, qf[ks], s[k2]);
        }
      }
      const bool diag = (kt * 64 + 63 > qb * 128 + wave * 32);
      float mx = -INFINITY;
#pragma unroll
      for (int k2 = 0; k2 < 2; ++k2)
#pragma unroll
        for (int g = 0; g < 4; ++g) {
          const f32x4 bb = *(const f32x4*)(bi_ + 32 * k2 + 8 * g + 4 * hh);
#pragma unroll
          for (int e = 0; e < 4; ++e) {
            float tv = s[k2][4 * g + e] * (0.125f * LOG2E) + bb[e];
            if (diag) { const int key = kt * 64 + 32 * k2 + 8 * g + 4 * hh + e; if (key > qpos) tv = -INFINITY; }
            s[k2][4 * g + e] = tv;
            mx = fmaxf(mx, tv);
          }
        }
      mx = fmaxf(mx, __shfl_xor(mx, 32));
      if (__builtin_amdgcn_ballot_w64(mx > m + 8.f) != 0ull) {
        const float mnew = fmaxf(m, mx);
        const float alpha = fexp2(m - mnew);
        m = mnew;
        lsum *= alpha;
#pragma unroll
        for (int dt = 0; dt < 2; ++dt) o[dt] = o[dt] * alpha;
      }
      float ps = 0.f;
      bf16x8 pb[2][2];
#pragma unroll
      for (int k2 = 0; k2 < 2; ++k2)
#pragma unroll
        for (int s2 = 0; s2 < 2; ++s2) {
          u32x4 pk;
#pragma unroll
          for (int j = 0; j < 4; ++j) {
            const float p0 = fexp2(s[k2][8 * s2 + 2 * j] - m), p1 = fexp2(s[k2][8 * s2 + 2 * j + 1] - m);
            ps += p0 + p1;
            pk[j] = pack2(p0, p1);
          }
          pb[k2][s2] = __builtin_bit_cast(bf16x8, pk);
        }
      lsum += ps;
#pragma unroll
      for (int dt = 0; dt < 2; ++dt) {
#pragma unroll
        for (int k2 = 0; k2 < 2; ++k2)
#pragma unroll
          for (int s2 = 0; s2 < 2; ++s2) {
            const bf16_t* vp = vs_ + (32 * dt + r) * 72 + 32 * k2 + 16 * s2 + 4 * hh;
            const bf16x4 lo = *(const bf16x4*)vp, hi = *(const bf16x4*)(vp + 8);
            bf16x8 vf;
            vf[0] = lo[0]; vf[1] = lo[1]; vf[2] = lo[2]; vf[3] = lo[3]; vf[4] = hi[0]; vf[5] = hi[1]; vf[6] = hi[2]; vf[7] = hi[3];
            o[dt] = mfma32(vf, pb[k2][s2], o[dt]);
          }
      }
    }
  }
  lsum += __shfl_xor(lsum, 32);
  const float inv = 1.f / lsum;
#pragma unroll
  for (int dt = 0; dt < 2; ++dt)
#pragma unroll
    for (int g = 0; g < 4; ++g) {
      u32x2 ov; ov[0] = pack2(o[dt][4 * g] * inv, o[dt][4 * g + 1] * inv); ov[1] = pack2(o[dt][4 * g + 2] * inv, o[dt][4 * g + 3] * inv);
      *(u32x2*)(MIX + qrow * 1024 + hd * 64 + 32 * dt + 8 * g + 4 * hh) = ov;
    }
  __syncthreads();
}

DEV void attn_sample_item(const P& p, int item, unsigned char* smem) {
  const int tid = ltid(), lane = tid & 63, wave = tid >> 6;
  const int qg = item & 3, hd = (item >> 2) & 7, sb = item >> 5;
  float* cs = (float*)smem;
  float* qs = cs + 1088;
  float* ps = qs + 256;
  const float* ck = p.in[2] + (size_t)sb * 1024 * 512;
  const float* cv = p.in[3] + (size_t)sb * 1024 * 512;
  const float* clf = p.in[4] + (size_t)sb * 1024 * 8;
  const float* nk = p.out + O_FKS + (size_t)sb * 32 * 512;
  const float* nv = p.out + O_FVS + (size_t)sb * 32 * 512;
  const float* nlf = (const float*)(p.ws + R_LOGF) + (size_t)(MP + sb * 32) * 8;
  const float* QS = (const float*)(p.ws + R_QS) + (size_t)sb * 32 * 512;
  bf16_t* MIX = (bf16_t*)(p.ws + R_MIX);
  if (wave == 0) {
    float s = 0.f;
    for (int i = 0; i < 17; ++i) {
      const int j = lane * 17 + i;
      float x = 0.f;
      if (j < 1024) x = clf[(size_t)j * 8 + hd]; else if (j < 1056) x = nlf[(size_t)(j - 1024) * 8 + hd];
      s += x; cs[j] = s;
    }
    float inc = s;
#pragma unroll
    for (int o = 1; o < 64; o <<= 1) { const float tt = __shfl_up(inc, o); if (lane >= o) inc += tt; }
    const float ex = inc - s;
    for (int i = 0; i < 17; ++i) cs[lane * 17 + i] += ex;
  }
  __syncthreads();
  for (int qi = qg * 8 + wave * 2; qi < qg * 8 + wave * 2 + 2; ++qi) {
    qs[wave * 64 + lane] = QS[(size_t)qi * 512 + hd * 64 + lane];
    __syncthreads();
    const int nkeys = 1024 + qi + 1;
    const float cq = cs[1024 + qi];
    float mx = -INFINITY;
#pragma unroll 2
    for (int n = 0; n < 17; ++n) {
      const int j = lane + 64 * n;
      float sv = -INFINITY;
      if (j < nkeys) {
        const float* kr = (j < 1024) ? (ck + (size_t)j * 512 + hd * 64) : (nk + (size_t)(j - 1024) * 512 + hd * 64);
        float d = 0.f;
#pragma unroll
        for (int c4 = 0; c4 < 16; ++c4) {
          const f32x4 kk = *(const f32x4*)(kr + c4 * 4);
          const f32x4 qq = *(const f32x4*)(qs + wave * 64 + c4 * 4);
          d += kk[0] * qq[0] + kk[1] * qq[1] + kk[2] * qq[2] + kk[3] * qq[3];
        }
        sv = d * 0.125f + cq - cs[j];
      }
      ps[wave * 1088 + j] = sv; mx = fmaxf(mx, sv);
    }
    mx = wave_max(mx);
    float sum = 0.f;
    for (int n = 0; n < 17; ++n) {
      const int j = lane + 64 * n;
      const float pv = (j < nkeys) ? __expf(ps[wave * 1088 + j] - mx) : 0.f;
      sum += pv;
      ps[wave * 1088 + j] = pv;
    }
    sum = wave_sum(sum);
    __syncthreads();
    float acc0 = 0.f, acc1 = 0.f, acc2 = 0.f, acc3 = 0.f;
    const float* cvh = cv + hd * 64 + lane;
#pragma unroll 4
    for (int j = 0; j < 1024; j += 4) {
      const f32x4 pp = *(const f32x4*)(ps + wave * 1088 + j);
      acc0 += pp[0] * cvh[(size_t)(j + 0) * 512];
      acc1 += pp[1] * cvh[(size_t)(j + 1) * 512];
      acc2 += pp[2] * cvh[(size_t)(j + 2) * 512];
      acc3 += pp[3] * cvh[(size_t)(j + 3) * 512];
    }
    for (int j = 1024; j < nkeys; ++j) acc0 += ps[wave * 1088 + j] * nv[(size_t)(j - 1024) * 512 + hd * 64 + lane];
    const float acc = (acc0 + acc1) + (acc2 + acc3);
    MIX[(size_t)(MP + sb * 32 + qi) * 1024 + hd * 64 + lane] = f2bf(acc / sum);
    __syncthreads();
  }
}

DEV void gdn_gate_phase(const P& p) {
  const int tid_ = ltid();
  const int lane = tid_ & 63, wave = tid_ >> 6;
  const float* ORAW = (const float*)(p.ws + R_GB);
  bf16_t* MIX = (bf16_t*)(p.ws + R_MIX);
  const float* ng = p.in[18];
  const f32x2 g2 = *(const f32x2*)(ng + 2 * lane);
  for (int it = blockIdx.x * 4 + wave; it < M * 4; it += gridDim.x * 4) {
    const int row = it >> 2, h = it & 3;
    const f32x2 ov = *(const f32x2*)(ORAW + (size_t)row * 512 + h * 128 + 2 * lane);
    unsigned* zp = (unsigned*)(MIX + (size_t)row * 1024 + 512 + h * 128 + 2 * lane);
    const unsigned zz = *zp;
    const float z0 = bf2f((bf16_t)(zz & 0xffff)), z1 = bf2f((bf16_t)(zz >> 16));
    const float ss = wave_sum(ov[0] * ov[0] + ov[1] * ov[1]);
    const float rs = rsqrtf(ss * (1.f / 128.f) + 1e-6f);
    *zp = pack2(ov[0] * rs * g2[0] * silu_f(z0), ov[1] * rs * g2[1] * silu_f(z1));
  }
}

template <int PASS>
DEV void s5_item(const P& p, int item, unsigned char* smem) {
  const int tid = ltid(), lane = tid & 63, wave = tid >> 6;
  const int r = lane & 31, hh = lane >> 5, r16 = lane & 15, q4 = lane >> 4;
  bf16_t* HB = (bf16_t*)smem + wave * 64 * 136;
  const float* U = (const float*)(p.ws + R_U);
  bf16_t* ZZB = (bf16_t*)(p.ws + R_ZZB);
  f32x2* E = (f32x2*)(p.ws + R_E);
  const f32x2* LAMB = (const f32x2*)(p.ws + W_LAMB);
  const f32x2* LAM256 = (const f32x2*)(p.ws + W_LAM256);
  const bf16_t* Bp = (const bf16_t*)(p.ws + W_S5B);
  const bf16_t* Cp = (const bf16_t*)(p.ws + W_S5C);
  int g, seq, span, row0, nchunk, ntok; bool samp;
  if (item < 2048) { samp = false; const int gq = item & 15; span = (item >> 4) & 63; seq = item >> 10; g = gq * 4 + wave; row0 = seq * T + span * 256; nchunk = 4; ntok = 64; }
  else { samp = true; const int it = item - 2048; const int gq = it & 15; seq = it >> 4; span = 0; g = gq * 4 + wave; row0 = MP + seq * 32; nchunk = 1; ntok = 32; }
  const f32x2 lam = LAMB[g * 64 + lane];
  float hr = 0.f, hi = 0.f;
  if (PASS == 2) {
    if (samp) { hr = p.in[7][(size_t)(seq * 64 + g) * 64 + lane]; hi = p.in[8][(size_t)(seq * 64 + g) * 64 + lane]; }
    else {
      const f32x2 l256 = LAM256[g * 64 + lane];
      for (int j = 0; j < span; ++j) {
        const f32x2 e = E[((size_t)(seq * 64 + j) * 64 + g) * 64 + lane];
        const float nr = l256[0] * hr - l256[1] * hi + e[0];
        const float ni = l256[0] * hi + l256[1] * hr + e[1];
        hr = nr; hi = ni;
      }
    }
  }
  bf16x8 bfr[4];
#pragma unroll
  for (int nt = 0; nt < 4; ++nt) bfr[nt] = *(const bf16x8*)(Bp + ((size_t)g * 128 + nt * 32 + r) * 16 + hh * 8);
  bf16x8 cfr[4];
#pragma unroll
  for (int ks = 0; ks < 4; ++ks) cfr[ks] = *(const bf16x8*)(Cp + ((size_t)g * 16 + r16) * 128 + ks * 32 + q4 * 8);
  const float dd = p.in[28][g * 16 + r16];
  for (int ch = 0; ch < nchunk; ++ch) {
    const int rowc = row0 + ch * 64;
#pragma unroll
    for (int mt = 0; mt < 2; ++mt) {
      bf16x8 uf;
      if (mt * 32 < ntok) {
        const float* up = U + (size_t)(rowc + mt * 32 + r) * D + g * 16 + hh * 8;
        const f32x4 u0 = *(const f32x4*)up, u1 = *(const f32x4*)(up + 4);
        uf[0] = (short)f2bf(u0[0]); uf[1] = (short)f2bf(u0[1]); uf[2] = (short)f2bf(u0[2]); uf[3] = (short)f2bf(u0[3]);
        uf[4] = (short)f2bf(u1[0]); uf[5] = (short)f2bf(u1[1]); uf[6] = (short)f2bf(u1[2]); uf[7] = (short)f2bf(u1[3]);
      } else {
#pragma unroll
        for (int j = 0; j < 8; ++j) uf[j] = 0;
      }
#pragma unroll
      for (int nt = 0; nt < 4; ++nt) {
        f32x16 acc;
#pragma unroll
        for (int q = 0; q < 16; ++q) acc[q] = 0.f;
        acc = mfma32(uf, bfr[nt], acc);
#pragma unroll
        for (int q = 0; q < 16; ++q) HB[(mt * 32 + (q & 3) + 8 * (q >> 2) + 4 * hh) * 136 + nt * 32 + r] = f2bf(acc[q]);
      }
    }
    __syncthreads();
    for (int t = 0; t < ntok; ++t) {
      const float br = bf2f(HB[t * 136 + lane]), bi = bf2f(HB[t * 136 + 64 + lane]);
      const float nr = lam[0] * hr - lam[1] * hi + br;
      const float ni = lam[0] * hi + lam[1] * hr + bi;
      hr = nr; hi = ni;
      if (PASS == 2) { HB[t * 136 + lane] = f2bf(hr); HB[t * 136 + 64 + lane] = f2bf(hi); }
    }
    __syncthreads();
    if (PASS == 2) {
#pragma unroll
      for (int m4 = 0; m4 < 4; ++m4) {
        if (m4 * 16 < ntok) {
          f32x4 y = {0.f, 0.f, 0.f, 0.f};
#pragma unroll
          for (int ks = 0; ks < 4; ++ks) {
            const bf16x8 hf = *(const bf16x8*)(HB + (m4 * 16 + r16) * 136 + ks * 32 + q4 * 8);
            y = mfma16(hf, cfr[ks], y);
          }
#pragma unroll
          for (int e = 0; e < 4; ++e) {
            const size_t idx = (size_t)(rowc + m4 * 16 + q4 * 4 + e) * D + g * 16 + r16;
            const float yy = y[e] + dd * U[idx];
            ZZB[idx] = f2bf(gelu_tanh(yy));
          }
        }
      }
      __syncthreads();
    }
  }
  if (PASS == 1) E[((size_t)(seq * 64 + span) * 64 + g) * 64 + lane] = (f32x2){hr, hi};
  else {
    if (samp) { p.out[O_S5RS + (size_t)(seq * 64 + g) * 64 + lane] = hr; p.out[O_S5IS + (size_t)(seq * 64 + g) * 64 + lane] = hi; }
    else if (span == 63) { p.out[O_S5RP + (size_t)(seq * 64 + g) * 64 + lane] = hr; p.out[O_S5IP + (size_t)(seq * 64 + g) * 64 + lane] = hi; }
  }
}

DEV void gsync(unsigned* bar, unsigned& epoch) {
  epoch += gridDim.x;
  asm volatile("s_waitcnt vmcnt(0) lgkmcnt(0)" ::: "memory");
  __syncthreads();
  if (threadIdx.x == 0) {
    __builtin_amdgcn_fence(__ATOMIC_RELEASE, "agent");
    __hip_atomic_fetch_add(bar, 1u, __ATOMIC_RELAXED, __HIP_MEMORY_SCOPE_AGENT);
    while (__hip_atomic_load(bar, __ATOMIC_RELAXED, __HIP_MEMORY_SCOPE_AGENT) < epoch) __builtin_amdgcn_s_sleep(1);
    __builtin_amdgcn_fence(__ATOMIC_ACQUIRE, "agent");
    asm volatile("s_waitcnt vmcnt(0) lgkmcnt(0)" ::: "memory");
  }
  __syncthreads();
}
#ifndef MINW
#define MINW 2
#endif
__global__ void __launch_bounds__(256, MINW) fwd_mega(P p) {
  extern __shared__ __attribute__((aligned(16))) unsigned char smem[];
  cg::grid_group grid = cg::this_grid();
  const int tid = threadIdx.x;
  float* X = p.out + O_Y;
  bf16_t* Xb = (bf16_t*)(p.ws + A_XB);
  bf16_t* ACT = (bf16_t*)(p.ws + R_ACT);

#ifndef NO_P0
  unsigned* bar = (unsigned*)(p.ws + W_CTR + 1024);
  unsigned epoch = 0;
  phase0(p, smem);
#endif
  grid.sync();
  gsync(bar, epoch);

#pragma unroll 1
  for (int layer = 0; layer < 2; ++layer) {
#pragma unroll 1
    for (int f = 0; f < 2; ++f) {
      if (f == 1) {
        if (layer == 0) {
#ifndef NO_EVENIN
          gemm_phase(Xb, 1024, (const bf16_t*)(p.ws + W_EVEN_IN), 1024, 29, EpiEvenIn{p}, smem);
#endif
          gsync(bar, epoch);
#ifndef NO_CUM
          if (blockIdx.x < 2) cumsum_prompt(p, blockIdx.x, smem);
#endif
#ifndef NO_PREP
          for (int it = blockIdx.x; it < NPREP; it += gridDim.x) gdn_prep_item(p, it, smem);
#endif
          gsync(bar, epoch);
          {
            unsigned* ctr = (unsigned*)(p.ws + W_CTR);
            int* sh = (int*)(smem + LDS_BYTES - 16);
            for (;;) {
              if (tid == 0) *sh = (int)atomicAdd(ctr, 1u);
              __syncthreads();
              const int it = *sh;
              __syncthreads();
              if (it >= 64 + 256 + 2048 + 256) break;
              if (it < 64) gdn_scan_chain(p, it, smem);
              else if (it < 64 + 256) attn_sample_item(p, it - 64, smem);
              else if (it < 64 + 256 + 2048) { const int a = it - 64 - 256; attn_prompt_item(p, a & 15, 127 - (a >> 4), smem); }
              else gdn_scan_chain(p, 64 + (it - 64 - 256 - 2048), smem);
            }
          }
          gsync(bar, epoch);
          gdn_gate_phase(p);
          gsync(bar, epoch);
          gemm_phase((const bf16_t*)(p.ws + R_MIX), 1024, (const bf16_t*)(p.ws + W_EVEN_OUT), 1024, 8, EpiElem<FResid>{FResid{X, 1.0f}}, smem);
          gsync(bar, epoch);
        } else {
          gemm_phase(Xb, 1024, (const bf16_t*)(p.ws + W_ODD_IN), 1024, 8, EpiElem<FStoreF32>{FStoreF32{(float*)(p.ws + R_U)}}, smem);
          gsync(bar, epoch);
#ifndef NO_S5
          for (int it = blockIdx.x; it < 2048; it += gridDim.x) if (((it >> 4) & 63) != 63) s5_item<1>(p, it, smem);
#endif
          gsync(bar, epoch);
#ifndef NO_S5
          for (int it = blockIdx.x; it < 2048 + 128; it += gridDim.x) s5_item<2>(p, it, smem);
#endif
          gsync(bar, epoch);
          gemm_phase((const bf16_t*)(p.ws + R_ZZB), 1024, (const bf16_t*)(p.ws + W_GLU), 1024, 8,
                     EpiElem<FGlu>{FGlu{(const bf16_t*)(p.ws + R_ZZB), p.in[30], (bf16_t*)(p.ws + A_GATED)}}, smem);
          gsync(bar, epoch);
          gemm_phase((const bf16_t*)(p.ws + A_GATED), 1024, (const bf16_t*)(p.ws + W_ODD_OUT), 1024, 8, EpiElem<FResid>{FResid{X, 1.0f}}, smem);
          gsync(bar, epoch);
        }
        ln_phase(X, Xb, p.in[11] + (layer * 3 + 1) * D, p.in[12] + (layer * 3 + 1) * D, true);
        gsync(bar, epoch);
      }
      const int idx = layer * 2 + f;
      gemm_phase(Xb, 1024, (const bf16_t*)(p.ws + W_FFN_IN + idx * SZ_FFN_IN), 1024, 44, EpiSwiglu{ACT}, smem);
      gsync(bar, epoch);
      gemm_phase(ACT, DFF, (const bf16_t*)(p.ws + W_FFN_OUT + idx * SZ_FFN_OUT), DFF, 8, EpiElem<FResid>{FResid{X, 0.5f}}, smem);
      gsync(bar, epoch);
      const bool last = (layer == 1 && f == 1);
      ln_phase(X, Xb, p.in[11] + (layer * 3 + f * 2) * D, p.in[12] + (layer * 3 + f * 2) * D, !last);
      if (!last) gsync(bar, epoch);
    }
  }
}

extern "C" void kernel_launch(void* const* d_in, const int* in_sizes, int n_in, void* d_out, int out_size, void* d_ws, size_t ws_size,
                              hipStream_t stream) {
  static int grid_blocks = 0;
  if (grid_blocks == 0) {
    int dev = 0, cus = 0, per_cu = 0;
    (void)hipGetDevice(&dev);
    (void)hipDeviceGetAttribute(&cus, hipDeviceAttributeMultiprocessorCount, dev);
    if (hipFuncSetAttribute((const void*)fwd_mega, hipFuncAttributeMaxDynamicSharedMemorySize, LDS_BYTES) != hipSuccess) {
      fprintf(stderr, "hipFuncSetAttribute failed\n");
    }
    (void)hipOccupancyMaxActiveBlocksPerMultiprocessor(&per_cu, (const void*)fwd_mega, 256, LDS_BYTES);
    if (per_cu < 1) per_cu = 1;
    if (per_cu > MINW) per_cu = MINW;
    grid_blocks = cus * per_cu;
    if (ws_size < WS_NEED) fprintf(stderr, "workspace too small: %zu < %zu\n", ws_size, (size_t)WS_NEED);
  }
  P p{};
  for (int i = 0; i < 32; ++i) p.in[i] = (const float*)d_in[i];
  p.out = (float*)d_out;
  p.ws = (unsigned char*)d_ws;
  (void)hipMemsetAsync((unsigned char*)d_ws + W_CTR + 1024, 0, 256, stream);
  void* args[] = {&p};
  hipError_t e = hipLaunchCooperativeKernel((const void*)fwd_mega, dim3(grid_blocks), dim3(256), args, LDS_BYTES, stream);
  if (e != hipSuccess) fprintf(stderr, "cooperative launch failed: %s (grid %d)\n", hipGetErrorString(e), grid_blocks);
}
```

```cpp
#include <hip/hip_runtime.h>
#include <hip/hip_cooperative_groups.h>
#include <cstdio>
#include <cstdint>
namespace cg = cooperative_groups;

typedef unsigned short bf16_t;
typedef short bf16x8 __attribute__((ext_vector_type(8)));
typedef short bf16x4 __attribute__((ext_vector_type(4)));
typedef float f32x4 __attribute__((ext_vector_type(4)));
typedef float f32x2 __attribute__((ext_vector_type(2)));
typedef float f32x16 __attribute__((ext_vector_type(16)));
typedef unsigned u32x4 __attribute__((ext_vector_type(4)));
typedef unsigned u32x2 __attribute__((ext_vector_type(2)));

#define DEV __device__ __forceinline__

constexpr int D = 1024, T = 16384, MP = 32768, MS = 256, M = MP + MS, DFF = 2816;
constexpr int MT = M / 128;
constexpr float ALPHA = 1.41421356237f;
constexpr float LOG2E = 1.44269504089f;
constexpr int LDS_BYTES = 73728;
constexpr int NPREP = 2048 + 32;

constexpr size_t O_Y = 0;
constexpr size_t O_FKP = 33816576, O_FVP = 50593792, O_FLP = 67371008, O_GSP = 67633152, O_GCP = 67764224;
constexpr size_t O_S5RP = 67773440, O_S5IP = 67781632, O_FKS = 67789824, O_FVS = 67920896, O_FLS = 68051968;
constexpr size_t O_GSS = 68054016, O_GCS = 68578304, O_S5RS = 68615168, O_S5IS = 68647936;

constexpr size_t MB = 1u << 20;
constexpr size_t W_FFN_IN = 0;
constexpr size_t SZ_FFN_IN = (size_t)5632 * 1024 * 2;
constexpr size_t W_FFN_OUT = W_FFN_IN + 4 * SZ_FFN_IN;
constexpr size_t SZ_FFN_OUT = (size_t)1024 * 2816 * 2;
constexpr size_t W_EVEN_IN = W_FFN_OUT + 4 * SZ_FFN_OUT;
constexpr size_t W_EVEN_OUT = W_EVEN_IN + (size_t)3712 * 1024 * 2;
constexpr size_t W_ODD_IN = W_EVEN_OUT + 2 * MB;
constexpr size_t W_GLU = W_ODD_IN + 2 * MB;
constexpr size_t W_ODD_OUT = W_GLU + 2 * MB;
constexpr size_t W_S5B = W_ODD_OUT + 2 * MB;
constexpr size_t W_S5C = W_S5B + 262144;
constexpr size_t W_LAMB = W_S5C + 262144;
constexpr size_t W_LAM256 = W_LAMB + 32768;
constexpr size_t W_CTR = W_LAM256 + 32768;
constexpr size_t W_END = W_CTR + 4096;
static_assert(W_END < 90 * MB, "weights region");
constexpr size_t A_XB = 90 * MB;
constexpr size_t SZ_XB = (size_t)M * 1024 * 2;
constexpr size_t A_PW = A_XB;
constexpr size_t A_PQG = A_PW + (size_t)NPREP * 8192 * 2;
constexpr size_t A_PKDT = A_PQG + (size_t)NPREP * 8192 * 2;
constexpr size_t A_PUT = A_PKDT + (size_t)NPREP * 8192 * 2;
constexpr size_t A_PATT = A_PUT + (size_t)NPREP * 8192 * 2;
constexpr size_t A_PGL = A_PATT + (size_t)NPREP * 4096 * 2;
constexpr size_t A_PEND = A_PGL + 16384;
constexpr size_t A_GATED = A_XB + 70 * MB;
static_assert(A_PEND < 90 * MB + 154 * MB, "prep region");
static_assert(A_GATED + SZ_XB < 90 * MB + 154 * MB, "gated region");
constexpr size_t R0 = 244 * MB;
constexpr size_t R_ACT = R0;
constexpr size_t R_MIX = R0;
constexpr size_t R_KB = R_MIX + SZ_XB;
constexpr size_t R_VT = R_KB + (size_t)M * 512 * 2;
constexpr size_t R_GB = R_VT + (size_t)16 * 64 * 16384 * 2;
constexpr size_t R_LOGF = R_GB + (size_t)M * 1536 * 2;
constexpr size_t R_CUM = R_LOGF + (size_t)M * 8 * 4;
constexpr size_t R_GG = R_CUM + (size_t)M * 8 * 4;
constexpr size_t R_BETA = R_GG + (size_t)M * 4 * 4;
constexpr size_t R_QS = R_BETA + (size_t)M * 4 * 4;
constexpr size_t R_EVEN_END = R_QS + (size_t)256 * 512 * 4;
constexpr size_t R_U = R0;
constexpr size_t R_ZZB = R_U + (size_t)M * 1024 * 4;
constexpr size_t R_E = R_ZZB + SZ_XB;
constexpr size_t R_ODD_END = R_E + (size_t)2 * 64 * 4096 * 8;
constexpr size_t WS_NEED = 490 * MB;
static_assert(R_EVEN_END < WS_NEED && R_ODD_END < WS_NEED && R_ACT + (size_t)M * DFF * 2 < WS_NEED, "ws");

struct P {
  const float* in[32];
  float* out;
  unsigned char* ws;
};

DEV int ltid() { int t = threadIdx.x; asm volatile("" : "+v"(t)); return t; }
typedef __bf16 hbf16x2 __attribute__((ext_vector_type(2)));
DEV unsigned pack2(float a, float b) {
  f32x2 v = {a, b};
  hbf16x2 h = __builtin_convertvector(v, hbf16x2);
  return __builtin_bit_cast(unsigned, h);
}
DEV bf16_t f2bf(float f) { return (bf16_t)(pack2(f, 0.f) & 0xffffu); }
DEV float bf2f(bf16_t h) { return __uint_as_float(((unsigned)h) << 16); }
DEV float fexp2(float x) { return __builtin_amdgcn_exp2f(x); }
DEV float frcp(float x) { return __builtin_amdgcn_rcpf(x); }
DEV float silu_f(float x) { return x * frcp(1.f + fexp2(-LOG2E * x)); }
DEV float sigmoid_f(float x) { return frcp(1.f + fexp2(-LOG2E * x)); }
DEV float softplus_f(float x) { return fmaxf(x, 0.f) + log1pf(__expf(-fabsf(x))); }
DEV float gelu_tanh(float x) {
  float u = 0.7978845608028654f * (x + 0.044715f * x * x * x);
  float t = 1.f - 2.f / (1.f + __expf(2.f * u));
  return 0.5f * x * (1.f + t);
}
DEV float wave_sum(float v) {
#pragma unroll
  for (int o = 32; o >= 1; o >>= 1) v += __shfl_xor(v, o);
  return v;
}
DEV float wave_max(float v) {
#pragma unroll
  for (int o = 32; o >= 1; o >>= 1) v = fmaxf(v, __shfl_xor(v, o));
  return v;
}
DEV f32x16 mfma32(bf16x8 a, bf16x8 b, f32x16 c) { return __builtin_amdgcn_mfma_f32_32x32x16_bf16(a, b, c, 0, 0, 0); }
DEV f32x4 mfma16(bf16x8 a, bf16x8 b, f32x4 c) { return __builtin_amdgcn_mfma_f32_16x16x32_bf16(a, b, c, 0, 0, 0); }

struct MapId { DEV int operator()(int n) const { return n; } };
struct MapFfnIn {
  DEV int operator()(int n) const {
    int t = n >> 7, w = n & 127;
    int wn = w >> 6, nt = (w >> 5) & 1, c = w & 31;
    return nt * DFF + t * 64 + wn * 32 + c;
  }
};
struct MapEvenIn {
  DEV int operator()(int n) const {
    if (n < 1536) return n;
    if (n < 3072) return 1544 + (n - 1536);
    if (n < 3584) return 3088 + (n - 3072);
    if (n < 3592) return 1536 + (n - 3584);
    if (n < 3600) return 3080 + (n - 3592);
    return -1;
  }
};

template <class Map>
DEV void conv_t(const float* __restrict__ src, int Nsrc, int K, bf16_t* __restrict__ dst, int Np, Map map, unsigned char* smem) {
  float* tile = (float*)smem;
  const int tid = ltid();
  const int ntn = Np >> 6, ntk = K >> 6;
  for (int t = blockIdx.x; t < ntn * ntk; t += gridDim.x) {
    const int tn = t % ntn, tk = t / ntn;
    {
      const int c = tid & 63, r0 = tid >> 6;
      const int sc = map(tn * 64 + c);
#pragma unroll
      for (int i = 0; i < 16; ++i) {
        const int k = tk * 64 + r0 + 4 * i;
        tile[(r0 + 4 * i) * 65 + c] = (sc >= 0) ? src[(size_t)k * Nsrc + sc] : 0.f;
      }
    }
    __syncthreads();
    {
      const int kk = tid & 63, n0 = tid >> 6;
#pragma unroll
      for (int i = 0; i < 16; ++i) {
        const int n = n0 + 4 * i;
        dst[(size_t)(tn * 64 + n) * K + tk * 64 + kk] = f2bf(tile[kk * 65 + n]);
      }
    }
    __syncthreads();
  }
}

DEV void phase0(const P& p, unsigned char* smem) {
  const int tid = ltid();
  const size_t gt = (size_t)blockIdx.x * 256 + tid, gn = (size_t)gridDim.x * 256;
  {
    float* X = p.out + O_Y;
    bf16_t* Xb = (bf16_t*)(p.ws + A_XB);
    const size_t n4p = (size_t)MP * D / 4, n4 = (size_t)M * D / 4;
    for (size_t i = gt; i < n4; i += gn) {
      f32x4 v = (i < n4p) ? ((const f32x4*)p.in[0])[i] : ((const f32x4*)p.in[1])[i - n4p];
      ((f32x4*)X)[i] = v;
      u32x2 o; o[0] = pack2(v[0], v[1]); o[1] = pack2(v[2], v[3]);
      ((u32x2*)Xb)[i] = o;
    }
  }
  for (int l = 0; l < 2; ++l)
    for (int f = 0; f < 2; ++f) {
      const int idx = l * 2 + f;
      conv_t(p.in[9] + (size_t)idx * 1024 * 5632, 5632, 1024, (bf16_t*)(p.ws + W_FFN_IN + idx * SZ_FFN_IN), 5632, MapFfnIn(), smem);
      conv_t(p.in[10] + (size_t)idx * 2816 * 1024, 1024, 2816, (bf16_t*)(p.ws + W_FFN_OUT + idx * SZ_FFN_OUT), 1024, MapId(), smem);
    }
  conv_t(p.in[13], 3600, 1024, (bf16_t*)(p.ws + W_EVEN_IN), 3712, MapEvenIn(), smem);
  conv_t(p.in[19], 1024, 1024, (bf16_t*)(p.ws + W_EVEN_OUT), 1024, MapId(), smem);
  conv_t(p.in[20], 1024, 1024, (bf16_t*)(p.ws + W_ODD_IN), 1024, MapId(), smem);
  conv_t(p.in[29], 1024, 1024, (bf16_t*)(p.ws + W_GLU), 1024, MapId(), smem);
  conv_t(p.in[31], 1024, 1024, (bf16_t*)(p.ws + W_ODD_OUT), 1024, MapId(), smem);
  if (gt < 4096) {
    const int g = (int)gt >> 6, pp = (int)gt & 63;
    const float step = expf(p.in[23][g]);
    const float lr = p.in[21][gt], li = p.in[22][gt];
    const float a = lr * step, b = li * step;
    const float ea = expf(a);
    float sb, cb; sincosf(b, &sb, &cb);
    const float lbr = ea * cb, lbi = ea * sb;
    const float sh = sinf(0.5f * b);
    const float nr = expm1f(a) * cb - 2.f * sh * sh, ni = lbi;
    const float dd = lr * lr + li * li;
    const float cr = (nr * lr + ni * li) / dd, ci = (ni * lr - nr * li) / dd;
    bf16_t* Bp = (bf16_t*)(p.ws + W_S5B);
    bf16_t* Cp = (bf16_t*)(p.ws + W_S5C);
    for (int c = 0; c < 16; ++c) {
      const float br = p.in[24][gt * 16 + c], bi = p.in[25][gt * 16 + c];
      Bp[((size_t)g * 128 + pp) * 16 + c] = f2bf(cr * br - ci * bi);
      Bp[((size_t)g * 128 + 64 + pp) * 16 + c] = f2bf(cr * bi + ci * br);
      Cp[((size_t)g * 16 + c) * 128 + pp] = f2bf(p.in[26][((size_t)g * 16 + c) * 64 + pp]);
      Cp[((size_t)g * 16 + c) * 128 + 64 + pp] = f2bf(-p.in[27][((size_t)g * 16 + c) * 64 + pp]);
    }
    ((f32x2*)(p.ws + W_LAMB))[gt] = (f32x2){lbr, lbi};
    float xr = lbr, xi = lbi;
    for (int i = 0; i < 8; ++i) { const float nr2 = xr * xr - xi * xi, ni2 = 2.f * xr * xi; xr = nr2; xi = ni2; }
    ((f32x2*)(p.ws + W_LAM256))[gt] = (f32x2){xr, xi};
  }
  if (gt < 64) ((unsigned*)(p.ws + W_CTR))[gt] = 0u;
}

template <class Epi>
DEV void gemm_phase(const bf16_t* __restrict__ A, int lda, const bf16_t* __restrict__ Wt, int K, int NT, Epi epi, unsigned char* smem) {
  const int tid = ltid(), lane = tid & 63, wave = tid >> 6, wm = wave >> 1, wn = wave & 1;
  const int r = lane & 31, hh = lane >> 5;
  bf16_t* As = (bf16_t*)smem;
  bf16_t* Bs = As + 2 * 128 * 72;
  const int nk = K >> 6;
  const int lrow = tid >> 3, lcc = tid & 7;
  const int xcd = blockIdx.x & 7, jx = blockIdx.x >> 3, nb = gridDim.x >> 3;
  const int U = (64 + nb - 1) / nb;
  const int n8 = NT >> 3, remc = NT & 7, has4 = (remc >= 4) ? 1 : 0, rem1 = remc - 4 * has4;
  const int NP = n8 * 32 + has4 * 16 + rem1 * 4;
  const int nPI = (xcd < NP) ? ((NP - xcd + 7) >> 3) * U : 0;
  const int nS = (blockIdx.x < 2 * NT) ? (2 * NT - blockIdx.x + gridDim.x - 1) / gridDim.x : 0;
  for (int w = 0; w < nPI + nS; ++w) {
    int tm, tn;
    if (w < nPI) {
      const int q = xcd + 8 * (w / U), jj = jx + nb * (w % U);
      if (jj >= 64) continue;
      if (q < n8 * 32) { const int c = q >> 5, lp = q & 31; tm = lp * 8 + (jj & 7); tn = c * 8 + (jj >> 3); }
      else {
        const int q2 = q - n8 * 32;
        if (has4 && q2 < 16) { tm = q2 * 16 + (jj & 15); tn = n8 * 8 + (jj >> 4); }
        else { const int q3 = q2 - has4 * 16; tm = (q3 & 3) * 64 + jj; tn = n8 * 8 + has4 * 4 + (q3 >> 2); }
      }
    } else {
      const int sidx = blockIdx.x + (w - nPI) * gridDim.x;
      tm = 256 + (sidx & 1); tn = sidx >> 1;
    }
    const bf16_t* Ag = A + (size_t)(tm * 128 + lrow) * lda + lcc * 8;
    const bf16_t* Bg = Wt + (size_t)(tn * 128 + lrow) * K + lcc * 8;
    f32x16 acc[2][2];
#pragma unroll
    for (int i = 0; i < 2; ++i)
#pragma unroll
      for (int j = 0; j < 2; ++j)
#pragma unroll
        for (int q = 0; q < 16; ++q) acc[i][j][q] = 0.f;
    u32x4 ra0[4], rb0[4], ra1[4], rb1[4];
#define G_LOAD(RA, RB, KT)                                                                   \
    _Pragma("unroll") for (int i = 0; i < 4; ++i) {                                         \
      RA[i] = *(const u32x4*)(Ag + (size_t)(32 * i) * lda + (KT) * 64);                      \
      RB[i] = *(const u32x4*)(Bg + (size_t)(32 * i) * K + (KT) * 64); }
#define G_WRITE(RA, RB, BUF)                                                                 \
    _Pragma("unroll") for (int i = 0; i < 4; ++i) {                                         \
      *(u32x4*)(As + (BUF) * 128 * 72 + (lrow + 32 * i) * 72 + lcc * 8) = RA[i];             \
      *(u32x4*)(Bs + (BUF) * 128 * 72 + (lrow + 32 * i) * 72 + lcc * 8) = RB[i]; }
#define G_COMPUTE(BUF)                                                                       \
    _Pragma("unroll") for (int ks = 0; ks < 4; ++ks) {                                      \
      bf16x8 af[2], bfr[2];                                                                  \
      _Pragma("unroll") for (int i = 0; i < 2; ++i) {                                       \
        af[i] = *(const bf16x8*)(As + (BUF) * 128 * 72 + (wm * 64 + i * 32 + r) * 72 + ks * 16 + hh * 8);  \
        bfr[i] = *(const bf16x8*)(Bs + (BUF) * 128 * 72 + (wn * 64 + i * 32 + r) * 72 + ks * 16 + hh * 8); } \
      _Pragma("unroll") for (int i = 0; i < 2; ++i)                                         \
        _Pragma("unroll") for (int j = 0; j < 2; ++j) acc[i][j] = mfma32(af[i], bfr[j], acc[i][j]); }
    G_LOAD(ra0, rb0, 0)
    G_WRITE(ra0, rb0, 0)
    G_LOAD(ra0, rb0, 1)
    G_LOAD(ra1, rb1, 2)
    __syncthreads();
    for (int kt = 0; kt < nk; kt += 2) {
      G_WRITE(ra0, rb0, 1)
      if (kt + 3 < nk) { G_LOAD(ra0, rb0, kt + 3) }
      __builtin_amdgcn_sched_barrier(0);
      G_COMPUTE(0)
      __syncthreads();
      if (kt + 2 < nk) { G_WRITE(ra1, rb1, 0) }
      if (kt + 4 < nk) { G_LOAD(ra1, rb1, kt + 4) }
      __builtin_amdgcn_sched_barrier(0);
      G_COMPUTE(1)
      __syncthreads();
    }
#undef G_LOAD
#undef G_WRITE
#undef G_COMPUTE
    epi(acc, tm * 128 + wm * 64, tn, wn, lane);
    __syncthreads();
  }
}

struct EpiSwiglu {
  bf16_t* act;
  DEV void operator()(const f32x16 (&acc)[2][2], int row0, int tn, int wn, int lane) const {
    const int r = lane & 31, hh = lane >> 5;
    const int col = tn * 64 + wn * 32 + r;
#pragma unroll
    for (int mt = 0; mt < 2; ++mt)
#pragma unroll
      for (int q = 0; q < 16; ++q) {
        const int row = row0 + mt * 32 + (q & 3) + 8 * (q >> 2) + 4 * hh;
        const float a = acc[mt][0][q], b = acc[mt][1][q];
        act[(size_t)row * DFF + col] = f2bf(silu_f(a) * b);
      }
  }
};
template <class F>
struct EpiElem {
  F f;
  DEV void operator()(const f32x16 (&acc)[2][2], int row0, int tn, int wn, int lane) const {
    const int r = lane & 31, hh = lane >> 5;
#pragma unroll
    for (int mt = 0; mt < 2; ++mt)
#pragma unroll
      for (int nt = 0; nt < 2; ++nt)
#pragma unroll
        for (int q = 0; q < 16; ++q) {
          const int row = row0 + mt * 32 + (q & 3) + 8 * (q >> 2) + 4 * hh;
          const int col = tn * 128 + wn * 64 + nt * 32 + r;
          f(row, col, acc[mt][nt][q]);
        }
  }
};
struct FResidX {
  float* X; float scale;
  DEV void operator()(int row, int col, float v) const {
    float* px = X + (size_t)row * D + col;
    *px = ALPHA * (*px) + scale * v;
  }
};
struct FResid {
  float* X; const bf16_t* Xb; float scale;
  DEV void operator()(int row, int col, float v) const {
    const size_t i = (size_t)row * D + col;
    X[i] = ALPHA * bf2f(Xb[i]) + scale * v;
  }
};
struct FStoreF32 {
  float* U;
  DEV void operator()(int row, int col, float v) const { U[(size_t)row * D + col] = v; }
};
struct FGlu {
  const bf16_t* zz; const float* bias; bf16_t* out;
  DEV void operator()(int row, int col, float v) const {
    const size_t i = (size_t)row * D + col;
    out[i] = f2bf(bf2f(zz[i]) * sigmoid_f(v + bias[col]));
  }
};
#define EACH_TILE(FN) FN(acc[0][0], 0, 0); FN(acc[0][1], 0, 1); FN(acc[1][0], 1, 0); FN(acc[1][1], 1, 1);
struct EpiEvenIn {
  P p;
  DEV void operator()(const f32x16 (&acc)[2][2], int row0, int tn, int wn, int lane) const {
    const int r = lane & 31, hh = lane >> 5;
    const bool samp = row0 >= MP;
    const int clb = wn * 64 + r;
    if (tn < 4) {
      bf16_t* MIX = (bf16_t*)(p.ws + R_MIX);
      float* QS = (float*)(p.ws + R_QS);
      auto fn = [&](const f32x16& a, int mt, int nt) {
        const int col = tn * 128 + clb + nt * 32;
#pragma unroll
        for (int q = 0; q < 16; ++q) {
          const int row = row0 + mt * 32 + (q & 3) + 8 * (q >> 2) + 4 * hh;
          MIX[(size_t)row * 1024 + col] = f2bf(a[q]);
          if (samp) QS[(size_t)(row - MP) * 512 + col] = a[q];
        }
      };
      EACH_TILE(fn)
    } else if (tn < 8) {
      bf16_t* KB = (bf16_t*)(p.ws + R_KB);
      float* ok = samp ? (p.out + O_FKS - (size_t)MP * 512) : (p.out + O_FKP);
      auto fn = [&](const f32x16& a, int mt, int nt) {
        const int col = (tn - 4) * 128 + clb + nt * 32;
#pragma unroll
        for (int q = 0; q < 16; ++q) {
          const int row = row0 + mt * 32 + (q & 3) + 8 * (q >> 2) + 4 * hh;
          KB[(size_t)row * 512 + col] = f2bf(a[q]);
          ok[(size_t)row * 512 + col] = a[q];
        }
      };
      EACH_TILE(fn)
    } else if (tn < 12) {
      if (!samp) {
        bf16_t* VT = (bf16_t*)(p.ws + R_VT);
        auto fn = [&](const f32x16& a, int mt, int nt) {
          const int col = (tn - 8) * 128 + clb + nt * 32;
          const int hd = col >> 6, dh = col & 63;
#pragma unroll
          for (int g = 0; g < 4; ++g) {
            const int row = row0 + mt * 32 + 8 * g + 4 * hh;
            const int b = row >> 14, tt = row & (T - 1);
            u32x2 o; o[0] = pack2(a[4 * g], a[4 * g + 1]); o[1] = pack2(a[4 * g + 2], a[4 * g + 3]);
            *(u32x2*)(VT + ((size_t)(b * 8 + hd) * 64 + dh) * T + tt) = o;
#pragma unroll
            for (int e = 0; e < 4; ++e) p.out[O_FVP + (size_t)(row + e) * 512 + col] = a[4 * g + e];
          }
        };
        EACH_TILE(fn)
      } else {
        auto fn = [&](const f32x16& a, int mt, int nt) {
          const int col = (tn - 8) * 128 + clb + nt * 32;
#pragma unroll
          for (int q = 0; q < 16; ++q) {
            const int row = row0 + mt * 32 + (q & 3) + 8 * (q >> 2) + 4 * hh;
            p.out[O_FVS + (size_t)(row - MP) * 512 + col] = a[q];
          }
        };
        EACH_TILE(fn)
      }
    } else if (tn < 24) {
      bf16_t* GB = (bf16_t*)(p.ws + R_GB);
      auto fn = [&](const f32x16& a, int mt, int nt) {
        const int col = (tn - 12) * 128 + clb + nt * 32;
#pragma unroll
        for (int q = 0; q < 16; ++q) {
          const int row = row0 + mt * 32 + (q & 3) + 8 * (q >> 2) + 4 * hh;
          const float v = a[q];
          GB[(size_t)row * 1536 + col] = f2bf(v);
          if (!samp) {
            const int tt = row & (T - 1);
            if (tt >= T - 3) p.out[O_GCP + (size_t)((row >> 14) * 3 + (tt - (T - 3))) * 1536 + col] = v;
          } else {
            const int tt = (row - MP) & 31;
            if (tt >= 29) p.out[O_GCS + (size_t)(((row - MP) >> 5) * 3 + (tt - 29)) * 1536 + col] = v;
          }
        }
      };
      EACH_TILE(fn)
    } else if (tn < 28) {
      bf16_t* MIX = (bf16_t*)(p.ws + R_MIX);
      auto fn = [&](const f32x16& a, int mt, int nt) {
        const int col = (tn - 24) * 128 + clb + nt * 32;
#pragma unroll
        for (int q = 0; q < 16; ++q) {
          const int row = row0 + mt * 32 + (q & 3) + 8 * (q >> 2) + 4 * hh;
          MIX[(size_t)row * 1024 + 512 + col] = f2bf(a[q]);
        }
      };
      EACH_TILE(fn)
    } else {
      float* LOGF = (float*)(p.ws + R_LOGF);
      float* GG = (float*)(p.ws + R_GG);
      float* BETA = (float*)(p.ws + R_BETA);
      if (wn == 0 && r < 16) {
        const int cl = r;
        float* ol = samp ? (p.out + O_FLS - (size_t)MP * 8) : (p.out + O_FLP);
        const float bias = (cl < 8) ? p.in[14][cl] : ((cl < 12) ? p.in[17][cl - 8] : 0.f);
        const float ea = (cl >= 8 && cl < 12) ? __expf(p.in[16][cl - 8]) : 0.f;
        auto fn = [&](const f32x16& a, int mt, int nt) {
          if (nt == 0) {
#pragma unroll
            for (int q = 0; q < 16; ++q) {
              const int row = row0 + mt * 32 + (q & 3) + 8 * (q >> 2) + 4 * hh;
              const float v = a[q];
              if (cl < 8) {
                const float lf = -softplus_f(-(v + bias));
                LOGF[(size_t)row * 8 + cl] = lf;
                ol[(size_t)row * 8 + cl] = lf;
              } else if (cl < 12) {
                GG[(size_t)row * 4 + (cl - 8)] = -ea * softplus_f(v + bias);
              } else {
                BETA[(size_t)row * 4 + (cl - 12)] = sigmoid_f(v);
              }
            }
          }
        };
        EACH_TILE(fn)
      }
    }
  }
};

DEV void ln_phase(float* __restrict__ X, bf16_t* __restrict__ Xb, const float* __restrict__ g, const float* __restrict__ b, bool write_bf, bool write_x) {
  const int tid_ = ltid();
  const int lane = tid_ & 63, wave = tid_ >> 6;
  const int gw = blockIdx.x * 4 + wave, nw = gridDim.x * 4;
  f32x4 gv[4], bv[4];
#pragma unroll
  for (int i = 0; i < 4; ++i) { gv[i] = ((const f32x4*)g)[i * 64 + lane]; bv[i] = ((const f32x4*)b)[i * 64 + lane]; }
  for (int row = gw; row < M; row += nw) {
    f32x4* xr = (f32x4*)(X + (size_t)row * D);
    f32x4 v[4];
    float s = 0.f;
#pragma unroll
    for (int i = 0; i < 4; ++i) { v[i] = xr[i * 64 + lane]; s += (v[i][0] + v[i][1]) + (v[i][2] + v[i][3]); }
    const float mu = wave_sum(s) * (1.f / D);
    float q = 0.f;
#pragma unroll
    for (int i = 0; i < 4; ++i) { v[i] = v[i] - mu; q += (v[i][0] * v[i][0] + v[i][1] * v[i][1]) + (v[i][2] * v[i][2] + v[i][3] * v[i][3]); }
    const float rs = rsqrtf(wave_sum(q) * (1.f / D) + 1e-5f);
#pragma unroll
    for (int i = 0; i < 4; ++i) {
      f32x4 o = v[i] * rs * gv[i] + bv[i];
      if (write_x) xr[i * 64 + lane] = o;
      if (write_bf) {
        u32x2 pk; pk[0] = pack2(o[0], o[1]); pk[1] = pack2(o[2], o[3]);
        ((u32x2*)(Xb + (size_t)row * D))[i * 64 + lane] = pk;
      }
    }
  }
}

DEV void cumsum_prompt(const P& p, int b, unsigned char* smem) {
  const float* LOGF = (const float*)(p.ws + R_LOGF) + (size_t)b * T * 8;
  float* CUM = (float*)(p.ws + R_CUM) + (size_t)b * T * 8;
  float* tot = (float*)smem;
  const int tid = ltid();
  float s[8];
#pragma unroll
  for (int h = 0; h < 8; ++h) s[h] = 0.f;
  for (int i = 0; i < 64; ++i) {
    const f32x4* r = (const f32x4*)(LOGF + (size_t)(tid * 64 + i) * 8);
    f32x4 a = r[0], c = r[1];
    s[0] += a[0]; s[1] += a[1]; s[2] += a[2]; s[3] += a[3]; s[4] += c[0]; s[5] += c[1]; s[6] += c[2]; s[7] += c[3];
  }
#pragma unroll
  for (int h = 0; h < 8; ++h) tot[tid * 8 + h] = s[h];
  __syncthreads();
  if (tid < 8) {
    float run = 0.f;
    for (int i = 0; i < 256; ++i) { const float v = tot[i * 8 + tid]; tot[i * 8 + tid] = run; run += v; }
  }
  __syncthreads();
#pragma unroll
  for (int h = 0; h < 8; ++h) s[h] = tot[tid * 8 + h];
  for (int i = 0; i < 64; ++i) {
    const f32x4* r = (const f32x4*)(LOGF + (size_t)(tid * 64 + i) * 8);
    f32x4 a = r[0], c = r[1];
    s[0] += a[0]; s[1] += a[1]; s[2] += a[2]; s[3] += a[3]; s[4] += c[0]; s[5] += c[1]; s[6] += c[2]; s[7] += c[3];
    f32x4* w = (f32x4*)(CUM + (size_t)(tid * 64 + i) * 8);
    w[0] = (f32x4){s[0], s[1], s[2], s[3]};
    w[1] = (f32x4){s[4], s[5], s[6], s[7]};
  }
  __syncthreads();
}

DEV void gdn_prep_item(const P& p, int item, unsigned char* smem) {
  const int tid = ltid(), lane = tid & 63, wave = tid >> 6;
  float* Kf = (float*)smem;
  float* Qf = Kf + 64 * 132;
  float* gc = Qf + 64 * 132;
  float* bt = gc + 64;
  float* eg = bt + 64;
  float* rk = eg + 64;
  float* rq = rk + 64;
  const bf16_t* GB = (const bf16_t*)(p.ws + R_GB);
  const float* GG = (const float*)(p.ws + R_GG);
  const float* BETA = (const float*)(p.ws + R_BETA);
  const float* cw = p.in[15];
  const bool samp = item >= 2048;
  const int h = item & 3;
  int row0, L; bool has_prev; const float* cbuf = nullptr;
  if (!samp) { const int chunk = (item >> 2) & 255, b = item >> 10; row0 = b * T + chunk * 64; L = 64; has_prev = chunk > 0; }
  else { const int sb = (item - 2048) >> 2; row0 = MP + sb * 32; L = 32; has_prev = false; cbuf = p.in[6] + (size_t)sb * 3 * 1536; }
  auto getx = [&](int i, int colg) -> float {
    if (i >= 0) return (i < L) ? bf2f(GB[(size_t)(row0 + i) * 1536 + colg]) : 0.f;
    if (samp) return cbuf[(3 + i) * 1536 + colg];
    return has_prev ? bf2f(GB[(size_t)(row0 + i) * 1536 + colg]) : 0.f;
  };
  const int c = tid & 127;
  const int half = tid >> 7;
  {
    const int colk = 512 + h * 128 + c, colq = h * 128 + c;
    const float k0 = cw[colk], k1 = cw[1536 + colk], k2 = cw[2 * 1536 + colk], k3 = cw[3 * 1536 + colk];
    const float q0 = cw[colq], q1 = cw[1536 + colq], q2 = cw[2 * 1536 + colq], q3 = cw[3 * 1536 + colq];
    const int i0 = half * 32;
    float a3 = getx(i0 - 3, colk), a2 = getx(i0 - 2, colk), a1 = getx(i0 - 1, colk);
    float b3 = getx(i0 - 3, colq), b2 = getx(i0 - 2, colq), b1 = getx(i0 - 1, colq);
#pragma unroll 8
    for (int ii = 0; ii < 32; ++ii) {
      const int i = i0 + ii;
      const float xa = getx(i, colk), xb = getx(i, colq);
      float ya = k0 * a3 + k1 * a2 + k2 * a1 + k3 * xa;
      float yb = q0 * b3 + q1 * b2 + q2 * b1 + q3 * xb;
      ya = (i < L) ? silu_f(ya) : 0.f;
      yb = (i < L) ? silu_f(yb) : 0.f;
      Kf[i * 132 + c] = ya;
      Qf[i * 132 + c] = yb;
      a3 = a2; a2 = a1; a1 = xa;
      b3 = b2; b2 = b1; b1 = xb;
    }
  }
  __syncthreads();
  for (int i = wave * 16; i < wave * 16 + 16; ++i) {
    const float a0 = Kf[i * 132 + lane], a1 = Kf[i * 132 + 64 + lane];
    const float sk = wave_sum(a0 * a0 + a1 * a1);
    const float b0 = Qf[i * 132 + lane], b1 = Qf[i * 132 + 64 + lane];
    const float sq = wave_sum(b0 * b0 + b1 * b1);
    if (lane == 0) { rk[i] = rsqrtf(sk + 1e-6f); rq[i] = rsqrtf(sq + 1e-6f) * 0.08838834764831845f; }
  }
  if (wave == 0) {
    float gi = (lane < L) ? GG[(size_t)(row0 + lane) * 4 + h] : 0.f;
    const float bi = (lane < L) ? BETA[(size_t)(row0 + lane) * 4 + h] : 0.f;
#pragma unroll
    for (int o = 1; o < 64; o <<= 1) { const float tt = __shfl_up(gi, o); if (lane >= o) gi += tt; }
    gc[lane] = gi; eg[lane] = __expf(gi); bt[lane] = bi;
  }
  __syncthreads();
  {
#pragma unroll 4
    for (int ii = 0; ii < 32; ++ii) {
      const int i = half * 32 + ii;
      Kf[i * 132 + c] *= rk[i];
      Qf[i * 132 + c] *= rq[i];
    }
  }
  __syncthreads();
  bf16_t* PW = (bf16_t*)(p.ws + A_PW) + (size_t)item * 8192;
  bf16_t* PQG = (bf16_t*)(p.ws + A_PQG) + (size_t)item * 8192;
  bf16_t* PKDT = (bf16_t*)(p.ws + A_PKDT) + (size_t)item * 8192;
  bf16_t* PUT = (bf16_t*)(p.ws + A_PUT) + (size_t)item * 8192;
  bf16_t* PATT = (bf16_t*)(p.ws + A_PATT) + (size_t)item * 4096;
  float* PGL = (float*)(p.ws + A_PGL);
  const float gl = gc[63];
  {
#pragma unroll 4
    for (int ii = 0; ii < 32; ++ii) {
      const int i = half * 32 + ii;
      PQG[i * 128 + c] = f2bf(Qf[i * 132 + c] * eg[i]);
    }
#pragma unroll
    for (int j8 = 0; j8 < 4; ++j8) {
      const int j0 = half * 32 + j8 * 8;
      float e[8];
#pragma unroll
      for (int t = 0; t < 8; ++t) e[t] = Kf[(j0 + t) * 132 + c] * __expf(gl - gc[j0 + t]);
      u32x4 o;
      o[0] = pack2(e[0], e[1]); o[1] = pack2(e[2], e[3]); o[2] = pack2(e[4], e[5]); o[3] = pack2(e[6], e[7]);
      *(u32x4*)(PKDT + c * 64 + j0) = o;
    }
    if (tid == 0) PGL[item] = __expf(gl);
  }
  const int ti = tid >> 4, tj = tid & 15;
  {
    float accA[4][4], accN[4][4];
#pragma unroll
    for (int a = 0; a < 4; ++a)
#pragma unroll
      for (int b = 0; b < 4; ++b) { accA[a][b] = 0.f; accN[a][b] = 0.f; }
#pragma unroll 2
    for (int cc = 0; cc < 128; cc += 4) {
      f32x4 qi[4], ki[4], kj[4];
#pragma unroll
      for (int a = 0; a < 4; ++a) {
        qi[a] = *(const f32x4*)(Qf + (ti + 16 * a) * 132 + cc);
        ki[a] = *(const f32x4*)(Kf + (ti + 16 * a) * 132 + cc);
        kj[a] = *(const f32x4*)(Kf + (tj + 16 * a) * 132 + cc);
      }
#pragma unroll
      for (int a = 0; a < 4; ++a)
#pragma unroll
        for (int b = 0; b < 4; ++b) {
          accA[a][b] += qi[a][0] * kj[b][0] + qi[a][1] * kj[b][1] + qi[a][2] * kj[b][2] + qi[a][3] * kj[b][3];
          accN[a][b] += ki[a][0] * kj[b][0] + ki[a][1] * kj[b][1] + ki[a][2] * kj[b][2] + ki[a][3] * kj[b][3];
        }
    }
    __syncthreads();
    float* Nl = Qf;
#pragma unroll
    for (int a = 0; a < 4; ++a)
#pragma unroll
      for (int b = 0; b < 4; ++b) {
        const int i = ti + 16 * a, j = tj + 16 * b;
        const float dec = (j <= i) ? __expf(gc[i] - gc[j]) : 0.f;
        PATT[i * 64 + j] = f2bf((j <= i) ? accA[a][b] * dec : 0.f);
        Nl[i * 68 + j] = (j < i) ? accN[a][b] * bt[i] * dec : 0.f;
      }
  }
  __syncthreads();
  {
    const float* Nl = Qf;
    float col[64];
    if (tid < 128) {
      const int colg = 1024 + h * 128 + c;
      const float w0 = cw[colg], w1 = cw[1536 + colg], w2 = cw[2 * 1536 + colg], w3 = cw[3 * 1536 + colg];
      float x3 = getx(-3, colg), x2 = getx(-2, colg), x1 = getx(-1, colg);
#pragma unroll
      for (int i = 0; i < 64; ++i) {
        const float x = getx(i, colg);
        float y = w0 * x3 + w1 * x2 + w2 * x1 + w3 * x;
        y = (i < L) ? silu_f(y) : 0.f;
        col[i] = y * bt[i];
        x3 = x2; x2 = x1; x1 = x;
      }
    } else {
#pragma unroll
      for (int i = 0; i < 64; ++i) col[i] = Kf[i * 132 + c] * bt[i] * eg[i];
    }
#pragma unroll
    for (int i = 1; i < 64; ++i) {
      float sacc = 0.f;
#pragma unroll
      for (int j4 = 0; j4 < (i + 3) / 4; ++j4) {
        const f32x4 nv = *(const f32x4*)(Nl + i * 68 + j4 * 4);
#pragma unroll
        for (int e = 0; e < 4; ++e)
          if (j4 * 4 + e < i) sacc += nv[e] * col[j4 * 4 + e];
      }
      col[i] -= sacc;
    }
    if (tid < 128) {
#pragma unroll
      for (int j8 = 0; j8 < 8; ++j8) {
        u32x4 o;
        o[0] = pack2(col[j8 * 8 + 0], col[j8 * 8 + 1]); o[1] = pack2(col[j8 * 8 + 2], col[j8 * 8 + 3]);
        o[2] = pack2(col[j8 * 8 + 4], col[j8 * 8 + 5]); o[3] = pack2(col[j8 * 8 + 6], col[j8 * 8 + 7]);
        *(u32x4*)(PUT + c * 64 + j8 * 8) = o;
      }
    } else {
#pragma unroll
      for (int i = 0; i < 64; ++i) PW[i * 128 + c] = f2bf(col[i]);
    }
  }
  __syncthreads();
}

struct GdnFr { bf16x8 w[4], qg[4], att[2], kd[2][2]; u32x2 u; float gl; };
DEV void gdn_load(GdnFr& f, const P& p, int item, int sl, int wave, int lane) {
  const int r16 = lane & 15, q4 = lane >> 4;
  const bf16_t* PW = (const bf16_t*)(p.ws + A_PW) + (size_t)item * 8192;
  const bf16_t* PQG = (const bf16_t*)(p.ws + A_PQG) + (size_t)item * 8192;
  const bf16_t* PKDT = (const bf16_t*)(p.ws + A_PKDT) + (size_t)item * 8192;
  const bf16_t* PUT = (const bf16_t*)(p.ws + A_PUT) + (size_t)item * 8192;
  const bf16_t* PATT = (const bf16_t*)(p.ws + A_PATT) + (size_t)item * 4096;
#pragma unroll
  for (int ks = 0; ks < 4; ++ks) {
    f.w[ks] = *(const bf16x8*)(PW + (wave * 16 + r16) * 128 + ks * 32 + q4 * 8);
    f.qg[ks] = *(const bf16x8*)(PQG + (wave * 16 + r16) * 128 + ks * 32 + q4 * 8);
  }
#pragma unroll
  for (int ks = 0; ks < 2; ++ks) {
    f.att[ks] = *(const bf16x8*)(PATT + (wave * 16 + r16) * 64 + ks * 32 + q4 * 8);
#pragma unroll
    for (int mt = 0; mt < 2; ++mt) f.kd[mt][ks] = *(const bf16x8*)(PKDT + (wave * 32 + mt * 16 + r16) * 64 + ks * 32 + q4 * 8);
  }
  f.u = *(const u32x2*)(PUT + (sl * 16 + r16) * 64 + wave * 16 + q4 * 4);
  f.gl = ((const float*)(p.ws + A_PGL))[item];
}

DEV void gdn_scan_chain(const P& p, int chain, unsigned char* smem) {
  const int tid = ltid(), lane = tid & 63, wave = tid >> 6;
  const int r16 = lane & 15, q4 = lane >> 4;
  bf16_t* Sb = (bf16_t*)smem;
  bf16_t* Vn = Sb + 16 * 136;
  float* ORAW = (float*)(p.ws + R_GB);
  int sl, h, nchunks, item0, rowbase, nvalid; float* sout; const float* s0 = nullptr;
  if (chain < 64) { sl = chain & 7; h = (chain >> 3) & 3; const int b = chain >> 5; nchunks = 256; item0 = b * 1024 + h; rowbase = b * T; nvalid = 64;
    sout = p.out + O_GSP + (size_t)(b * 4 + h) * 16384; }
  else { const int cs = chain - 64; sl = cs & 7; h = (cs >> 3) & 3; const int sb = cs >> 5; nchunks = 1; item0 = 2048 + sb * 4 + h; rowbase = MP + sb * 32; nvalid = 32;
    sout = p.out + O_GSS + (size_t)(sb * 4 + h) * 16384; s0 = p.in[5] + (size_t)(sb * 4 + h) * 16384; }
  f32x4 S[2];
#pragma unroll
  for (int mt = 0; mt < 2; ++mt)
#pragma unroll
    for (int e = 0; e < 4; ++e) S[mt][e] = s0 ? s0[(size_t)(wave * 32 + mt * 16 + q4 * 4 + e) * 128 + sl * 16 + r16] : 0.f;
#pragma unroll
  for (int mt = 0; mt < 2; ++mt) {
    u32x2 o; o[0] = pack2(S[mt][0], S[mt][1]); o[1] = pack2(S[mt][2], S[mt][3]);
    *(u32x2*)(Sb + r16 * 136 + wave * 32 + mt * 16 + q4 * 4) = o;
  }
  __builtin_amdgcn_s_setprio(3);
  GdnFr cur, nxt;
  gdn_load(cur, p, item0, sl, wave, lane);
  __syncthreads();
  for (int ch = 0; ch < nchunks; ++ch) {
    if (ch + 1 < nchunks) gdn_load(nxt, p, item0 + (ch + 1) * 4, sl, wave, lane);
    f32x4 ws = {0.f, 0.f, 0.f, 0.f}, ws2 = {0.f, 0.f, 0.f, 0.f}, qs = {0.f, 0.f, 0.f, 0.f}, qs2 = {0.f, 0.f, 0.f, 0.f};
    {
      bf16x8 sf[4];
#pragma unroll
      for (int ks = 0; ks < 4; ++ks) sf[ks] = *(const bf16x8*)(Sb + r16 * 136 + ks * 32 + q4 * 8);
      ws = mfma16(cur.w[0], sf[0], ws);
      ws2 = mfma16(cur.w[1], sf[1], ws2);
      ws = mfma16(cur.w[2], sf[2], ws);
      ws2 = mfma16(cur.w[3], sf[3], ws2);
      qs = mfma16(cur.qg[0], sf[0], qs);
      qs2 = mfma16(cur.qg[1], sf[1], qs2);
      qs = mfma16(cur.qg[2], sf[2], qs);
      qs2 = mfma16(cur.qg[3], sf[3], qs2);
    }
    ws = ws + ws2;
    qs = qs + qs2;
    f32x4 vn;
    vn[0] = bf2f((bf16_t)(cur.u[0] & 0xffff)) - ws[0];
    vn[1] = bf2f((bf16_t)(cur.u[0] >> 16)) - ws[1];
    vn[2] = bf2f((bf16_t)(cur.u[1] & 0xffff)) - ws[2];
    vn[3] = bf2f((bf16_t)(cur.u[1] >> 16)) - ws[3];
    {
      u32x2 o; o[0] = pack2(vn[0], vn[1]); o[1] = pack2(vn[2], vn[3]);
      *(u32x2*)(Vn + r16 * 72 + wave * 16 + q4 * 4) = o;
    }
    __syncthreads();
    bf16x8 vf[2];
#pragma unroll
    for (int ks = 0; ks < 2; ++ks) vf[ks] = *(const bf16x8*)(Vn + r16 * 72 + ks * 32 + q4 * 8);
#pragma unroll
    for (int ks = 0; ks < 2; ++ks) qs = mfma16(cur.att[ks], vf[ks], qs);
#pragma unroll
    for (int e = 0; e < 4; ++e) {
      const int i = wave * 16 + q4 * 4 + e;
      if (i < nvalid) ORAW[(size_t)(rowbase + ch * 64 + i) * 512 + h * 128 + sl * 16 + r16] = qs[e];
    }
#pragma unroll
    for (int mt = 0; mt < 2; ++mt) {
      f32x4 sn = S[mt] * cur.gl;
#pragma unroll
      for (int ks = 0; ks < 2; ++ks) sn = mfma16(cur.kd[mt][ks], vf[ks], sn);
      S[mt] = sn;
      u32x2 o; o[0] = pack2(sn[0], sn[1]); o[1] = pack2(sn[2], sn[3]);
      *(u32x2*)(Sb + r16 * 136 + wave * 32 + mt * 16 + q4 * 4) = o;
    }
    __syncthreads();
    if (ch + 1 < nchunks) cur = nxt;
  }
#pragma unroll
  for (int mt = 0; mt < 2; ++mt)
#pragma unroll
    for (int e = 0; e < 4; ++e) sout[(size_t)(wave * 32 + mt * 16 + q4 * 4 + e) * 128 + sl * 16 + r16] = S[mt][e];
  __builtin_amdgcn_s_setprio(0);
  __syncthreads();
}

struct TagTrue { static constexpr bool value = true; };
struct TagFalse { static constexpr bool value = false; };
DEV void attn_prompt_item(const P& p, int bh, int qb, unsigned char* smem) {
  const int tid = ltid(), lane = tid & 63, wave = tid >> 6;
  const int r = lane & 31, hh = lane >> 5;
  const int b = bh >> 3, hd = bh & 7;
  bf16_t* Ks = (bf16_t*)smem;
  bf16_t* Vs = Ks + 2 * 64 * 72;
  float* Bi = (float*)(Vs + 2 * 64 * 72);
  bf16_t* MIX = (bf16_t*)(p.ws + R_MIX);
  const bf16_t* KB = (const bf16_t*)(p.ws + R_KB);
  const bf16_t* VT = (const bf16_t*)(p.ws + R_VT);
  const float* CUM = (const float*)(p.ws + R_CUM);
  const int qpos = qb * 128 + wave * 32 + r;
  const size_t qrow = (size_t)b * T + qpos;
  bf16x8 qf[4];
#pragma unroll
  for (int ks = 0; ks < 4; ++ks) qf[ks] = *(const bf16x8*)(MIX + qrow * 1024 + hd * 64 + ks * 16 + hh * 8);
  f32x16 o[2];
#pragma unroll
  for (int dt = 0; dt < 2; ++dt)
#pragma unroll
    for (int q = 0; q < 16; ++q) o[dt][q] = 0.f;
  float m = -INFINITY, moff = 0.f, lsum = 0.f;
  const int nkt = qb * 2 + 2;
  const int lrow = tid >> 3, lcc = tid & 7;
  const bf16_t* Kg = KB + ((size_t)b * T + lrow) * 512 + hd * 64 + lcc * 8;
  const bf16_t* Vg = VT + ((size_t)bh * 64 + lrow) * T + lcc * 8;
  const int qlast = qb * 128 + wave * 32 + 31, qfirst = qb * 128 + wave * 32;
  constexpr float SC = 0.125f * LOG2E, RSC = 1.f / SC;
  auto tile_body = [&](const bf16_t* ks_, const bf16_t* vs_, const float* bi_, int kt, auto masked_tag) {
    constexpr bool MASKED = decltype(masked_tag)::value;
    f32x16 s[2];
    const float sinit = -moff * RSC;
#pragma unroll
    for (int k2 = 0; k2 < 2; ++k2) {
#pragma unroll
      for (int q = 0; q < 16; ++q) s[k2][q] = sinit;
#pragma unroll
      for (int ks = 0; ks < 4; ++ks) {
        const bf16x8 kf = *(const bf16x8*)(ks_ + (32 * k2 + r) * 72 + ks * 16 + hh * 8);
        s[k2] = mfma32(kf, qf[ks], s[k2]);
      }
    }
    float mx = -INFINITY;
#pragma unroll
    for (int k2 = 0; k2 < 2; ++k2)
#pragma unroll
      for (int g = 0; g < 4; ++g) {
        const f32x4 bb = *(const f32x4*)(bi_ + 32 * k2 + 8 * g + 4 * hh);
#pragma unroll
        for (int e = 0; e < 4; ++e) {
          float tv = s[k2][4 * g + e] * SC + bb[e];
          if (MASKED) { const int key = kt * 64 + 32 * k2 + 8 * g + 4 * hh + e; if (key > qpos) tv = -INFINITY; }
          s[k2][4 * g + e] = tv;
          mx = fmaxf(mx, tv);
        }
      }
    mx = fmaxf(mx, __shfl_xor(mx, 32));
    float ps = 0.f;
    bf16x8 pb[2][2];
    auto make_p = [&](float sub, auto sub_tag) {
      constexpr bool SUB = decltype(sub_tag)::value;
#pragma unroll
      for (int k2 = 0; k2 < 2; ++k2)
#pragma unroll
        for (int s2 = 0; s2 < 2; ++s2) {
          u32x4 pk;
#pragma unroll
          for (int j = 0; j < 4; ++j) {
            float x0 = s[k2][8 * s2 + 2 * j], x1 = s[k2][8 * s2 + 2 * j + 1];
            if (SUB) { x0 -= sub; x1 -= sub; }
            const float p0 = fexp2(x0), p1 = fexp2(x1);
            ps += p0 + p1;
            pk[j] = pack2(p0, p1);
          }
          pb[k2][s2] = __builtin_bit_cast(bf16x8, pk);
        }
    };
    if (__builtin_amdgcn_ballot_w64(mx + moff > m + 8.f) != 0ull) {
      const float mnew = fmaxf(m, mx + moff);
      const float alpha = fexp2(m - mnew);
      m = mnew;
      lsum *= alpha;
#pragma unroll
      for (int dt = 0; dt < 2; ++dt) o[dt] = o[dt] * alpha;
      const float sub = mnew - moff;
      moff = mnew;
      make_p(sub, TagTrue{});
    } else {
      make_p(0.f, TagFalse{});
    }
    lsum += ps;
#pragma unroll
    for (int dt = 0; dt < 2; ++dt) {
#pragma unroll
      for (int k2 = 0; k2 < 2; ++k2)
#pragma unroll
        for (int s2 = 0; s2 < 2; ++s2) {
          const bf16_t* vp = vs_ + (32 * dt + r) * 72 + 32 * k2 + 16 * s2 + 4 * hh;
          const bf16x4 lo = *(const bf16x4*)vp, hi = *(const bf16x4*)(vp + 8);
          bf16x8 vf;
          vf[0] = lo[0]; vf[1] = lo[1]; vf[2] = lo[2]; vf[3] = lo[3]; vf[4] = hi[0]; vf[5] = hi[1]; vf[6] = hi[2]; vf[7] = hi[3];
          o[dt] = mfma32(vf, pb[k2][s2], o[dt]);
        }
    }
  };
  u32x4 rk0[2], rv0[2], rk1[2], rv1[2]; float rb0 = 0.f, rb1 = 0.f;
#define A_LOAD(RK, RV, RB, KT)                                                                \
  { _Pragma("unroll") for (int i = 0; i < 2; ++i) {                                           \
      RK[i] = *(const u32x4*)(Kg + (size_t)((KT) * 64 + 32 * i) * 512);                        \
      RV[i] = *(const u32x4*)(Vg + (size_t)(32 * i) * T + (KT) * 64); }                        \
    if (tid < 64) RB = -CUM[((size_t)b * T + (KT) * 64 + tid) * 8 + hd] * LOG2E; }
#define A_WRITE(RK, RV, RB, BUF)                                                              \
  { _Pragma("unroll") for (int i = 0; i < 2; ++i) {                                           \
      *(u32x4*)(Ks + (BUF) * 64 * 72 + (lrow + 32 * i) * 72 + lcc * 8) = RK[i];                \
      *(u32x4*)(Vs + (BUF) * 64 * 72 + (lrow + 32 * i) * 72 + lcc * 8) = RV[i]; }              \
    if (tid < 64) Bi[(BUF) * 64 + tid] = RB; }
#define A_COMPUTE(BUF, KT)                                                                    \
  if ((KT) * 64 <= qlast) {                                                                   \
    if ((KT) * 64 + 63 > qfirst) tile_body(Ks + (BUF) * 64 * 72, Vs + (BUF) * 64 * 72, Bi + (BUF) * 64, (KT), TagTrue{});   \
    else tile_body(Ks + (BUF) * 64 * 72, Vs + (BUF) * 64 * 72, Bi + (BUF) * 64, (KT), TagFalse{}); }
  A_LOAD(rk0, rv0, rb0, 0)
  A_WRITE(rk0, rv0, rb0, 0)
  A_LOAD(rk0, rv0, rb0, 1)
  if (nkt > 2) A_LOAD(rk1, rv1, rb1, 2)
  __syncthreads();
  for (int kt = 0; kt < nkt; kt += 2) {
    A_WRITE(rk0, rv0, rb0, 1)
    if (kt + 3 < nkt) A_LOAD(rk0, rv0, rb0, kt + 3)
    __builtin_amdgcn_sched_barrier(0);
    A_COMPUTE(0, kt)
    __syncthreads();
    if (kt + 2 < nkt) A_WRITE(rk1, rv1, rb1, 0)
    if (kt + 4 < nkt) A_LOAD(rk1, rv1, rb1, kt + 4)
    __builtin_amdgcn_sched_barrier(0);
    A_COMPUTE(1, kt + 1)
    __syncthreads();
  }
#undef A_LOAD
#undef A_WRITE
#undef A_COMPUTE
  lsum += __shfl_xor(lsum, 32);
  const float inv = 1.f / lsum;
#pragma unroll
  for (int dt = 0; dt < 2; ++dt)
#pragma unroll
    for (int g = 0; g < 4; ++g) {
      u32x2 ov; ov[0] = pack2(o[dt][4 * g] * inv, o[dt][4 * g + 1] * inv); ov[1] = pack2(o[dt][4 * g + 2] * inv, o[dt][4 * g + 3] * inv);
      *(u32x2*)(MIX + qrow * 1024 + hd * 64 + 32 * dt + 8 * g + 4 * hh) = ov;
    }
  __syncthreads();
}

DEV void attn_sample_item(const P& p, int item, unsigned char* smem) {
  const int tid = ltid(), lane = tid & 63, wave = tid >> 6;
  const int qg = item & 3, hd = (item >> 2) & 7, sb = item >> 5;
  float* cs = (float*)smem;
  float* qs = cs + 1088;
  float* ps = qs + 256;
  const float* ck = p.in[2] + (size_t)sb * 1024 * 512;
  const float* cv = p.in[3] + (size_t)sb * 1024 * 512;
  const float* clf = p.in[4] + (size_t)sb * 1024 * 8;
  const float* nk = p.out + O_FKS + (size_t)sb * 32 * 512;
  const float* nv = p.out + O_FVS + (size_t)sb * 32 * 512;
  const float* nlf = (const float*)(p.ws + R_LOGF) + (size_t)(MP + sb * 32) * 8;
  const float* QS = (const float*)(p.ws + R_QS) + (size_t)sb * 32 * 512;
  bf16_t* MIX = (bf16_t*)(p.ws + R_MIX);
  if (wave == 0) {
    float s = 0.f;
    for (int i = 0; i < 17; ++i) {
      const int j = lane * 17 + i;
      float x = 0.f;
      if (j < 1024) x = clf[(size_t)j * 8 + hd]; else if (j < 1056) x = nlf[(size_t)(j - 1024) * 8 + hd];
      s += x; cs[j] = s;
    }
    float inc = s;
#pragma unroll
    for (int o = 1; o < 64; o <<= 1) { const float tt = __shfl_up(inc, o); if (lane >= o) inc += tt; }
    const float ex = inc - s;
    for (int i = 0; i < 17; ++i) cs[lane * 17 + i] += ex;
  }
  __syncthreads();
  for (int qi = qg * 8 + wave * 2; qi < qg * 8 + wave * 2 + 2; ++qi) {
    qs[wave * 64 + lane] = QS[(size_t)qi * 512 + hd * 64 + lane];
    __syncthreads();
    const int nkeys = 1024 + qi + 1;
    const float cq = cs[1024 + qi];
    float mx = -INFINITY;
#pragma unroll 2
    for (int n = 0; n < 17; ++n) {
      const int j = lane + 64 * n;
      float sv = -INFINITY;
      if (j < nkeys) {
        const float* kr = (j < 1024) ? (ck + (size_t)j * 512 + hd * 64) : (nk + (size_t)(j - 1024) * 512 + hd * 64);
        float d = 0.f;
#pragma unroll
        for (int c4 = 0; c4 < 16; ++c4) {
          const f32x4 kk = *(const f32x4*)(kr + c4 * 4);
          const f32x4 qq = *(const f32x4*)(qs + wave * 64 + c4 * 4);
          d += kk[0] * qq[0] + kk[1] * qq[1] + kk[2] * qq[2] + kk[3] * qq[3];
        }
        sv = d * 0.125f + cq - cs[j];
      }
      ps[wave * 1088 + j] = sv; mx = fmaxf(mx, sv);
    }
    mx = wave_max(mx);
    float sum = 0.f;
    for (int n = 0; n < 17; ++n) {
      const int j = lane + 64 * n;
      const float pv = (j < nkeys) ? __expf(ps[wave * 1088 + j] - mx) : 0.f;
      sum += pv;
      ps[wave * 1088 + j] = pv;
    }
    sum = wave_sum(sum);
    __syncthreads();
    float acc0 = 0.f, acc1 = 0.f, acc2 = 0.f, acc3 = 0.f;
    const float* cvh = cv + hd * 64 + lane;
#pragma unroll 4
    for (int j = 0; j < 1024; j += 4) {
      const f32x4 pp = *(const f32x4*)(ps + wave * 1088 + j);
      acc0 += pp[0] * cvh[(size_t)(j + 0) * 512];
      acc1 += pp[1] * cvh[(size_t)(j + 1) * 512];
      acc2 += pp[2] * cvh[(size_t)(j + 2) * 512];
      acc3 += pp[3] * cvh[(size_t)(j + 3) * 512];
    }
    for (int j = 1024; j < nkeys; ++j) acc0 += ps[wave * 1088 + j] * nv[(size_t)(j - 1024) * 512 + hd * 64 + lane];
    const float acc = (acc0 + acc1) + (acc2 + acc3);
    MIX[(size_t)(MP + sb * 32 + qi) * 1024 + hd * 64 + lane] = f2bf(acc / sum);
    __syncthreads();
  }
}

DEV void gdn_gate_phase(const P& p) {
  const int tid_ = ltid();
  const int lane = tid_ & 63, wave = tid_ >> 6;
  const float* ORAW = (const float*)(p.ws + R_GB);
  bf16_t* MIX = (bf16_t*)(p.ws + R_MIX);
  const float* ng = p.in[18];
  const f32x2 g2 = *(const f32x2*)(ng + 2 * lane);
  for (int it = blockIdx.x * 4 + wave; it < M * 4; it += gridDim.x * 4) {
    const int row = it >> 2, h = it & 3;
    const f32x2 ov = *(const f32x2*)(ORAW + (size_t)row * 512 + h * 128 + 2 * lane);
    unsigned* zp = (unsigned*)(MIX + (size_t)row * 1024 + 512 + h * 128 + 2 * lane);
    const unsigned zz = *zp;
    const float z0 = bf2f((bf16_t)(zz & 0xffff)), z1 = bf2f((bf16_t)(zz >> 16));
    const float ss = wave_sum(ov[0] * ov[0] + ov[1] * ov[1]);
    const float rs = rsqrtf(ss * (1.f / 128.f) + 1e-6f);
    *zp = pack2(ov[0] * rs * g2[0] * silu_f(z0), ov[1] * rs * g2[1] * silu_f(z1));
  }
}

template <int PASS>
DEV void s5_item(const P& p, int item, unsigned char* smem) {
  const int tid = ltid(), lane = tid & 63, wave = tid >> 6;
  const int r = lane & 31, hh = lane >> 5, r16 = lane & 15, q4 = lane >> 4;
  bf16_t* HB = (bf16_t*)smem + wave * 64 * 136;
  const float* U = (const float*)(p.ws + R_U);
  bf16_t* ZZB = (bf16_t*)(p.ws + R_ZZB);
  f32x2* E = (f32x2*)(p.ws + R_E);
  const f32x2* LAMB = (const f32x2*)(p.ws + W_LAMB);
  const f32x2* LAM256 = (const f32x2*)(p.ws + W_LAM256);
  const bf16_t* Bp = (const bf16_t*)(p.ws + W_S5B);
  const bf16_t* Cp = (const bf16_t*)(p.ws + W_S5C);
  int g, seq, span, row0, nchunk, ntok; bool samp;
  if (item < 2048) { samp = false; const int gq = item & 15; span = (item >> 4) & 63; seq = item >> 10; g = gq * 4 + wave; row0 = seq * T + span * 256; nchunk = 4; ntok = 64; }
  else { samp = true; const int it = item - 2048; const int gq = it & 15; seq = it >> 4; span = 0; g = gq * 4 + wave; row0 = MP + seq * 32; nchunk = 1; ntok = 32; }
  const f32x2 lam = LAMB[g * 64 + lane];
  float hr = 0.f, hi = 0.f;
  if (PASS == 2) {
    if (samp) { hr = p.in[7][(size_t)(seq * 64 + g) * 64 + lane]; hi = p.in[8][(size_t)(seq * 64 + g) * 64 + lane]; }
    else {
      const f32x2 l256 = LAM256[g * 64 + lane];
#pragma unroll 8
      for (int j = 0; j < span; ++j) {
        const f32x2 e = E[((size_t)(seq * 64 + j) * 64 + g) * 64 + lane];
        const float nr = l256[0] * hr - l256[1] * hi + e[0];
        const float ni = l256[0] * hi + l256[1] * hr + e[1];
        hr = nr; hi = ni;
      }
    }
  }
  bf16x8 bfr[4];
#pragma unroll
  for (int nt = 0; nt < 4; ++nt) bfr[nt] = *(const bf16x8*)(Bp + ((size_t)g * 128 + nt * 32 + r) * 16 + hh * 8);
  bf16x8 cfr[4];
#pragma unroll
  for (int ks = 0; ks < 4; ++ks) cfr[ks] = *(const bf16x8*)(Cp + ((size_t)g * 16 + r16) * 128 + ks * 32 + q4 * 8);
  const float dd = p.in[28][g * 16 + r16];
  for (int ch = 0; ch < nchunk; ++ch) {
    const int rowc = row0 + ch * 64;
#pragma unroll
    for (int mt = 0; mt < 2; ++mt) {
      bf16x8 uf;
      if (mt * 32 < ntok) {
        const float* up = U + (size_t)(rowc + mt * 32 + r) * D + g * 16 + hh * 8;
        const f32x4 u0 = *(const f32x4*)up, u1 = *(const f32x4*)(up + 4);
        uf[0] = (short)f2bf(u0[0]); uf[1] = (short)f2bf(u0[1]); uf[2] = (short)f2bf(u0[2]); uf[3] = (short)f2bf(u0[3]);
        uf[4] = (short)f2bf(u1[0]); uf[5] = (short)f2bf(u1[1]); uf[6] = (short)f2bf(u1[2]); uf[7] = (short)f2bf(u1[3]);
      } else {
#pragma unroll
        for (int j = 0; j < 8; ++j) uf[j] = 0;
      }
#pragma unroll
      for (int nt = 0; nt < 4; ++nt) {
        f32x16 acc;
#pragma unroll
        for (int q = 0; q < 16; ++q) acc[q] = 0.f;
        acc = mfma32(uf, bfr[nt], acc);
#pragma unroll
        for (int q = 0; q < 16; ++q) HB[(mt * 32 + (q & 3) + 8 * (q >> 2) + 4 * hh) * 136 + nt * 32 + r] = f2bf(acc[q]);
      }
    }
    __syncthreads();
    for (int t = 0; t < ntok; ++t) {
      const float br = bf2f(HB[t * 136 + lane]), bi = bf2f(HB[t * 136 + 64 + lane]);
      const float nr = lam[0] * hr - lam[1] * hi + br;
      const float ni = lam[0] * hi + lam[1] * hr + bi;
      hr = nr; hi = ni;
      if (PASS == 2) { HB[t * 136 + lane] = f2bf(hr); HB[t * 136 + 64 + lane] = f2bf(hi); }
    }
    __syncthreads();
    if (PASS == 2) {
#pragma unroll
      for (int m4 = 0; m4 < 4; ++m4) {
        if (m4 * 16 < ntok) {
          f32x4 y = {0.f, 0.f, 0.f, 0.f};
#pragma unroll
          for (int ks = 0; ks < 4; ++ks) {
            const bf16x8 hf = *(const bf16x8*)(HB + (m4 * 16 + r16) * 136 + ks * 32 + q4 * 8);
            y = mfma16(hf, cfr[ks], y);
          }
#pragma unroll
          for (int e = 0; e < 4; ++e) {
            const size_t idx = (size_t)(rowc + m4 * 16 + q4 * 4 + e) * D + g * 16 + r16;
            const float yy = y[e] + dd * U[idx];
            ZZB[idx] = f2bf(gelu_tanh(yy));
          }
        }
      }
      __syncthreads();
    }
  }
  if (PASS == 1) E[((size_t)(seq * 64 + span) * 64 + g) * 64 + lane] = (f32x2){hr, hi};
  else {
    if (samp) { p.out[O_S5RS + (size_t)(seq * 64 + g) * 64 + lane] = hr; p.out[O_S5IS + (size_t)(seq * 64 + g) * 64 + lane] = hi; }
    else if (span == 63) { p.out[O_S5RP + (size_t)(seq * 64 + g) * 64 + lane] = hr; p.out[O_S5IP + (size_t)(seq * 64 + g) * 64 + lane] = hi; }
  }
}

DEV void gsync(unsigned* bar, unsigned& epoch) {
  epoch += gridDim.x;
  asm volatile("s_waitcnt vmcnt(0) lgkmcnt(0)" ::: "memory");
  __syncthreads();
  if (threadIdx.x == 0) {
    __builtin_amdgcn_fence(__ATOMIC_RELEASE, "agent");
    __hip_atomic_fetch_add(bar, 1u, __ATOMIC_RELAXED, __HIP_MEMORY_SCOPE_AGENT);
    while (__hip_atomic_load(bar, __ATOMIC_RELAXED, __HIP_MEMORY_SCOPE_AGENT) < epoch) __builtin_amdgcn_s_sleep(1);
    __builtin_amdgcn_fence(__ATOMIC_ACQUIRE, "agent");
    asm volatile("s_waitcnt vmcnt(0) lgkmcnt(0)" ::: "memory");
  }
  __syncthreads();
}
#ifndef MINW
#define MINW 2
#endif
__global__ void __launch_bounds__(256, MINW) fwd_mega(P p) {
  extern __shared__ __attribute__((aligned(16))) unsigned char smem[];
  cg::grid_group grid = cg::this_grid();
  const int tid = threadIdx.x;
  float* X = p.out + O_Y;
  bf16_t* Xb = (bf16_t*)(p.ws + A_XB);
  bf16_t* ACT = (bf16_t*)(p.ws + R_ACT);

#ifndef NO_P0
  unsigned* bar = (unsigned*)(p.ws + W_CTR + 1024);
  unsigned epoch = 0;
  phase0(p, smem);
#endif
  grid.sync();
  gsync(bar, epoch);

#pragma unroll 1
  for (int layer = 0; layer < 2; ++layer) {
#pragma unroll 1
    for (int f = 0; f < 2; ++f) {
      if (f == 1) {
        if (layer == 0) {
#ifndef NO_EVENIN
          gemm_phase(Xb, 1024, (const bf16_t*)(p.ws + W_EVEN_IN), 1024, 29, EpiEvenIn{p}, smem);
#endif
          gsync(bar, epoch);
#ifndef NO_CUM
          if (blockIdx.x < 2) cumsum_prompt(p, blockIdx.x, smem);
#endif
#ifndef NO_PREP
          for (int it = blockIdx.x; it < NPREP; it += gridDim.x) gdn_prep_item(p, it, smem);
#endif
          gsync(bar, epoch);
          {
            unsigned* ctr = (unsigned*)(p.ws + W_CTR);
            int* sh = (int*)(smem + LDS_BYTES - 16);
            for (;;) {
              if (tid == 0) *sh = (int)atomicAdd(ctr, 1u);
              __syncthreads();
              const int it = *sh;
              __syncthreads();
              if (it >= 64 + 256 + 256) break;
              if (it < 64) gdn_scan_chain(p, it, smem);
              else if (it < 64 + 256) attn_sample_item(p, it - 64, smem);
              else gdn_scan_chain(p, 64 + (it - 64 - 256), smem);
            }
            for (int sx = 0; sx < 8; ++sx) {
              const int x = ((blockIdx.x & 7) + sx) & 7;
              for (;;) {
                if (tid == 0) *sh = (int)atomicAdd(ctr + 8 + x, 1u);
                __syncthreads();
                const int it = *sh;
                __syncthreads();
                if (it >= 256) break;
                attn_prompt_item(p, 2 * x + (it & 1), 127 - (it >> 1), smem);
              }
            }
          }
          gsync(bar, epoch);
          gdn_gate_phase(p);
          gsync(bar, epoch);
          gemm_phase((const bf16_t*)(p.ws + R_MIX), 1024, (const bf16_t*)(p.ws + W_EVEN_OUT), 1024, 8, EpiElem<FResidX>{FResidX{X, 1.0f}}, smem);
          gsync(bar, epoch);
        } else {
          gemm_phase(Xb, 1024, (const bf16_t*)(p.ws + W_ODD_IN), 1024, 8, EpiElem<FStoreF32>{FStoreF32{(float*)(p.ws + R_U)}}, smem);
          gsync(bar, epoch);
#ifndef NO_S5
          for (int it = blockIdx.x; it < 2048; it += gridDim.x) if (((it >> 4) & 63) != 63) s5_item<1>(p, it, smem);
#endif
          gsync(bar, epoch);
#ifndef NO_S5
          for (int it = blockIdx.x; it < 2048 + 128; it += gridDim.x) s5_item<2>(p, it, smem);
#endif
          gsync(bar, epoch);
          gemm_phase((const bf16_t*)(p.ws + R_ZZB), 1024, (const bf16_t*)(p.ws + W_GLU), 1024, 8,
                     EpiElem<FGlu>{FGlu{(const bf16_t*)(p.ws + R_ZZB), p.in[30], (bf16_t*)(p.ws + A_GATED)}}, smem);
          gsync(bar, epoch);
          gemm_phase((const bf16_t*)(p.ws + A_GATED), 1024, (const bf16_t*)(p.ws + W_ODD_OUT), 1024, 8, EpiElem<FResid>{FResid{X, Xb, 1.0f}}, smem);
          gsync(bar, epoch);
        }
        ln_phase(X, Xb, p.in[11] + (layer * 3 + 1) * D, p.in[12] + (layer * 3 + 1) * D, true, false);
        gsync(bar, epoch);
      }
      const int idx = layer * 2 + f;
      gemm_phase(Xb, 1024, (const bf16_t*)(p.ws + W_FFN_IN + idx * SZ_FFN_IN), 1024, 44, EpiSwiglu{ACT}, smem);
      gsync(bar, epoch);
      gemm_phase(ACT, DFF, (const bf16_t*)(p.ws + W_FFN_OUT + idx * SZ_FFN_OUT), DFF, 8, EpiElem<FResid>{FResid{X, Xb, 0.5f}}, smem);
      gsync(bar, epoch);
      const bool last = (layer == 1 && f == 1);
      ln_phase(X, Xb, p.in[11] + (layer * 3 + f * 2) * D, p.in[12] + (layer * 3 + f * 2) * D, !last, last || (layer == 0 && f == 0));
      if (!last) gsync(bar, epoch);
    }
  }
}

extern "C" void kernel_launch(void* const* d_in, const int* in_sizes, int n_in, void* d_out, int out_size, void* d_ws, size_t ws_size,
                              hipStream_t stream) {
  static int grid_blocks = 0;
  if (grid_blocks == 0) {
    int dev = 0, cus = 0, per_cu = 0;
    (void)hipGetDevice(&dev);
    (void)hipDeviceGetAttribute(&cus, hipDeviceAttributeMultiprocessorCount, dev);
    if (hipFuncSetAttribute((const void*)fwd_mega, hipFuncAttributeMaxDynamicSharedMemorySize, LDS_BYTES) != hipSuccess) {
      fprintf(stderr, "hipFuncSetAttribute failed\n");
    }
    (void)hipOccupancyMaxActiveBlocksPerMultiprocessor(&per_cu, (const void*)fwd_mega, 256, LDS_BYTES);
    if (per_cu < 1) per_cu = 1;
    if (per_cu > MINW) per_cu = MINW;
    grid_blocks = cus * per_cu;
    if (ws_size < WS_NEED) fprintf(stderr, "workspace too small: %zu < %zu\n", ws_size, (size_t)WS_NEED);
  }
  P p{};
  for (int i = 0; i < 32; ++i) p.in[i] = (const float*)d_in[i];
  p.out = (float*)d_out;
  p.ws = (unsigned char*)d_ws;
  (void)hipMemsetAsync((unsigned char*)d_ws + W_CTR + 1024, 0, 256, stream);
  void* args[] = {&p};
  hipError_t e = hipLaunchCooperativeKernel((const void*)fwd_mega, dim3(grid_blocks), dim3(256), args, LDS_BYTES, stream);
  if (e != hipSuccess) fprintf(stderr, "cooperative launch failed: %s (grid %d)\n", hipGetErrorString(e), grid_blocks);
}
```

```cpp
#include <hip/hip_runtime.h>
#include <hip/hip_cooperative_groups.h>
#include <cstdio>
#include <cstdint>
namespace cg = cooperative_groups;

typedef unsigned short bf16_t;
typedef short bf16x8 __attribute__((ext_vector_type(8)));
typedef short bf16x4 __attribute__((ext_vector_type(4)));
typedef float f32x4 __attribute__((ext_vector_type(4)));
typedef float f32x2 __attribute__((ext_vector_type(2)));
typedef float f32x16 __attribute__((ext_vector_type(16)));
typedef unsigned u32x4 __attribute__((ext_vector_type(4)));
typedef unsigned u32x2 __attribute__((ext_vector_type(2)));

#define DEV __device__ __forceinline__

constexpr int D = 1024, T = 16384, MP = 32768, MS = 256, M = MP + MS, DFF = 2816;
constexpr int MT = M / 128;
constexpr float ALPHA = 1.41421356237f;
constexpr float LOG2E = 1.44269504089f;
constexpr int LDS_BYTES = 73728;
constexpr int NPREP = 2048 + 32;

constexpr size_t O_Y = 0;
constexpr size_t O_FKP = 33816576, O_FVP = 50593792, O_FLP = 67371008, O_GSP = 67633152, O_GCP = 67764224;
constexpr size_t O_S5RP = 67773440, O_S5IP = 67781632, O_FKS = 67789824, O_FVS = 67920896, O_FLS = 68051968;
constexpr size_t O_GSS = 68054016, O_GCS = 68578304, O_S5RS = 68615168, O_S5IS = 68647936;

constexpr size_t MB = 1u << 20;
constexpr size_t W_FFN_IN = 0;
constexpr size_t SZ_FFN_IN = (size_t)5632 * 1024 * 2;
constexpr size_t W_FFN_OUT = W_FFN_IN + 4 * SZ_FFN_IN;
constexpr size_t SZ_FFN_OUT = (size_t)1024 * 2816 * 2;
constexpr size_t W_EVEN_IN = W_FFN_OUT + 4 * SZ_FFN_OUT;
constexpr size_t W_EVEN_OUT = W_EVEN_IN + (size_t)3712 * 1024 * 2;
constexpr size_t W_ODD_IN = W_EVEN_OUT + 2 * MB;
constexpr size_t W_GLU = W_ODD_IN + 2 * MB;
constexpr size_t W_ODD_OUT = W_GLU + 2 * MB;
constexpr size_t W_S5B = W_ODD_OUT + 2 * MB;
constexpr size_t W_S5C = W_S5B + 262144;
constexpr size_t W_LAMB = W_S5C + 262144;
constexpr size_t W_LAM256 = W_LAMB + 32768;
constexpr size_t W_CTR = W_LAM256 + 32768;
constexpr size_t W_END = W_CTR + 4096;
static_assert(W_END < 90 * MB, "weights region");
constexpr size_t A_XB = 90 * MB;
constexpr size_t SZ_XB = (size_t)M * 1024 * 2;
constexpr size_t A_PW = A_XB;
constexpr size_t A_PQG = A_PW + (size_t)NPREP * 8192 * 2;
constexpr size_t A_PKDT = A_PQG + (size_t)NPREP * 8192 * 2;
constexpr size_t A_PUT = A_PKDT + (size_t)NPREP * 8192 * 2;
constexpr size_t A_PATT = A_PUT + (size_t)NPREP * 8192 * 2;
constexpr size_t A_PGL = A_PATT + (size_t)NPREP * 4096 * 2;
constexpr size_t A_PEND = A_PGL + 16384;
constexpr size_t A_GATED = A_XB + 70 * MB;
static_assert(A_PEND < 90 * MB + 154 * MB, "prep region");
static_assert(A_GATED + SZ_XB < 90 * MB + 154 * MB, "gated region");
constexpr size_t R0 = 244 * MB;
constexpr size_t R_ACT = R0;
constexpr size_t R_MIX = R0;
constexpr size_t R_KB = R_MIX + SZ_XB;
constexpr size_t R_VT = R_KB + (size_t)M * 512 * 2;
constexpr size_t R_GB = R_VT + (size_t)16 * 64 * 16384 * 2;
constexpr size_t R_LOGF = R_GB + (size_t)M * 1536 * 2;
constexpr size_t R_CUM = R_LOGF + (size_t)M * 8 * 4;
constexpr size_t R_GG = R_CUM + (size_t)M * 8 * 4;
constexpr size_t R_BETA = R_GG + (size_t)M * 4 * 4;
constexpr size_t R_QS = R_BETA + (size_t)M * 4 * 4;
constexpr size_t R_EVEN_END = R_QS + (size_t)256 * 512 * 4;
constexpr size_t R_U = R0;
constexpr size_t R_ZZB = R_U + (size_t)M * 1024 * 4;
constexpr size_t R_E = R_ZZB + SZ_XB;
constexpr size_t R_ODD_END = R_E + (size_t)2 * 64 * 4096 * 8;
constexpr size_t WS_NEED = 490 * MB;
static_assert(R_EVEN_END < WS_NEED && R_ODD_END < WS_NEED && R_ACT + (size_t)M * DFF * 2 < WS_NEED, "ws");

struct P {
  const float* in[32];
  float* out;
  unsigned char* ws;
};

DEV int ltid() { int t = threadIdx.x; asm volatile("" : "+v"(t)); return t; }
typedef __bf16 hbf16x2 __attribute__((ext_vector_type(2)));
DEV unsigned pack2(float a, float b) {
  f32x2 v = {a, b};
  hbf16x2 h = __builtin_convertvector(v, hbf16x2);
  return __builtin_bit_cast(unsigned, h);
}
DEV bf16_t f2bf(float f) { return (bf16_t)(pack2(f, 0.f) & 0xffffu); }
DEV float bf2f(bf16_t h) { return __uint_as_float(((unsigned)h) << 16); }
DEV float fexp2(float x) { return __builtin_amdgcn_exp2f(x); }
DEV float frcp(float x) { return __builtin_amdgcn_rcpf(x); }
DEV float silu_f(float x) { return x * frcp(1.f + fexp2(-LOG2E * x)); }
DEV float sigmoid_f(float x) { return frcp(1.f + fexp2(-LOG2E * x)); }
DEV float softplus_f(float x) { return fmaxf(x, 0.f) + log1pf(__expf(-fabsf(x))); }
DEV float gelu_tanh(float x) {
  float u = 0.7978845608028654f * (x + 0.044715f * x * x * x);
  float t = 1.f - 2.f / (1.f + __expf(2.f * u));
  return 0.5f * x * (1.f + t);
}
DEV float wave_sum(float v) {
#pragma unroll
  for (int o = 32; o >= 1; o >>= 1) v += __shfl_xor(v, o);
  return v;
}
DEV float wave_max(float v) {
#pragma unroll
  for (int o = 32; o >= 1; o >>= 1) v = fmaxf(v, __shfl_xor(v, o));
  return v;
}
DEV f32x16 mfma32(bf16x8 a, bf16x8 b, f32x16 c) { return __builtin_amdgcn_mfma_f32_32x32x16_bf16(a, b, c, 0, 0, 0); }
DEV f32x4 mfma16(bf16x8 a, bf16x8 b, f32x4 c) { return __builtin_amdgcn_mfma_f32_16x16x32_bf16(a, b, c, 0, 0, 0); }

struct MapId { DEV int operator()(int n) const { return n; } };
struct MapFfnIn {
  DEV int operator()(int n) const {
    int t = n >> 7, w = n & 127;
    int wn = w >> 6, nt = (w >> 5) & 1, c = w & 31;
    return nt * DFF + t * 64 + wn * 32 + c;
  }
};
struct MapEvenIn {
  DEV int operator()(int n) const {
    if (n < 1536) return n;
    if (n < 3072) return 1544 + (n - 1536);
    if (n < 3584) return 3088 + (n - 3072);
    if (n < 3592) return 1536 + (n - 3584);
    if (n < 3600) return 3080 + (n - 3592);
    return -1;
  }
};

template <class Map>
DEV void conv_t(const float* __restrict__ src, int Nsrc, int K, bf16_t* __restrict__ dst, int Np, Map map, unsigned char* smem) {
  float* tile = (float*)smem;
  const int tid = ltid();
  const int ntn = Np >> 6, ntk = K >> 6;
  for (int t = blockIdx.x; t < ntn * ntk; t += gridDim.x) {
    const int tn = t % ntn, tk = t / ntn;
    {
      const int n4 = (tid & 15) * 4, k0 = tid >> 4;
      const int sc = map(tn * 64 + n4);
#pragma unroll
      for (int i = 0; i < 4; ++i) {
        const int k = k0 + 16 * i;
        f32x4 v = {0.f, 0.f, 0.f, 0.f};
        if (sc >= 0) v = *(const f32x4*)(src + (size_t)(tk * 64 + k) * Nsrc + sc);
        *(f32x4*)(tile + k * 68 + n4) = v;
      }
    }
    __syncthreads();
    {
      const int n = tid >> 2, kq = (tid & 3) * 16;
      u32x4 o0, o1;
#pragma unroll
      for (int j = 0; j < 4; ++j) {
        o0[j] = pack2(tile[(kq + 2 * j) * 68 + n], tile[(kq + 2 * j + 1) * 68 + n]);
        o1[j] = pack2(tile[(kq + 8 + 2 * j) * 68 + n], tile[(kq + 8 + 2 * j + 1) * 68 + n]);
      }
      bf16_t* dp = dst + (size_t)(tn * 64 + n) * K + tk * 64 + kq;
      *(u32x4*)dp = o0;
      *(u32x4*)(dp + 8) = o1;
    }
    __syncthreads();
  }
}

DEV void phase0(const P& p, unsigned char* smem) {
  const int tid = ltid();
  const size_t gt = (size_t)blockIdx.x * 256 + tid, gn = (size_t)gridDim.x * 256;
  {
    bf16_t* Xb = (bf16_t*)(p.ws + A_XB);
    const size_t n4p = (size_t)MP * D / 4, n4 = (size_t)M * D / 4;
    for (size_t i = gt; i < n4; i += gn) {
      f32x4 v = (i < n4p) ? ((const f32x4*)p.in[0])[i] : ((const f32x4*)p.in[1])[i - n4p];
      u32x2 o; o[0] = pack2(v[0], v[1]); o[1] = pack2(v[2], v[3]);
      ((u32x2*)Xb)[i] = o;
    }
  }
  for (int l = 0; l < 2; ++l)
    for (int f = 0; f < 2; ++f) {
      const int idx = l * 2 + f;
      conv_t(p.in[9] + (size_t)idx * 1024 * 5632, 5632, 1024, (bf16_t*)(p.ws + W_FFN_IN + idx * SZ_FFN_IN), 5632, MapFfnIn(), smem);
      conv_t(p.in[10] + (size_t)idx * 2816 * 1024, 1024, 2816, (bf16_t*)(p.ws + W_FFN_OUT + idx * SZ_FFN_OUT), 1024, MapId(), smem);
    }
  conv_t(p.in[13], 3600, 1024, (bf16_t*)(p.ws + W_EVEN_IN), 3712, MapEvenIn(), smem);
  conv_t(p.in[19], 1024, 1024, (bf16_t*)(p.ws + W_EVEN_OUT), 1024, MapId(), smem);
  conv_t(p.in[20], 1024, 1024, (bf16_t*)(p.ws + W_ODD_IN), 1024, MapId(), smem);
  conv_t(p.in[29], 1024, 1024, (bf16_t*)(p.ws + W_GLU), 1024, MapId(), smem);
  conv_t(p.in[31], 1024, 1024, (bf16_t*)(p.ws + W_ODD_OUT), 1024, MapId(), smem);
  if (gt < 4096) {
    const int g = (int)gt >> 6, pp = (int)gt & 63;
    const float step = expf(p.in[23][g]);
    const float lr = p.in[21][gt], li = p.in[22][gt];
    const float a = lr * step, b = li * step;
    const float ea = expf(a);
    float sb, cb; sincosf(b, &sb, &cb);
    const float lbr = ea * cb, lbi = ea * sb;
    const float sh = sinf(0.5f * b);
    const float nr = expm1f(a) * cb - 2.f * sh * sh, ni = lbi;
    const float dd = lr * lr + li * li;
    const float cr = (nr * lr + ni * li) / dd, ci = (ni * lr - nr * li) / dd;
    bf16_t* Bp = (bf16_t*)(p.ws + W_S5B);
    bf16_t* Cp = (bf16_t*)(p.ws + W_S5C);
    for (int c = 0; c < 16; ++c) {
      const float br = p.in[24][gt * 16 + c], bi = p.in[25][gt * 16 + c];
      Bp[((size_t)g * 128 + pp) * 16 + c] = f2bf(cr * br - ci * bi);
      Bp[((size_t)g * 128 + 64 + pp) * 16 + c] = f2bf(cr * bi + ci * br);
      Cp[((size_t)g * 16 + c) * 128 + pp] = f2bf(p.in[26][((size_t)g * 16 + c) * 64 + pp]);
      Cp[((size_t)g * 16 + c) * 128 + 64 + pp] = f2bf(-p.in[27][((size_t)g * 16 + c) * 64 + pp]);
    }
    ((f32x2*)(p.ws + W_LAMB))[gt] = (f32x2){lbr, lbi};
    float xr = lbr, xi = lbi;
    for (int i = 0; i < 8; ++i) { const float nr2 = xr * xr - xi * xi, ni2 = 2.f * xr * xi; xr = nr2; xi = ni2; }
    ((f32x2*)(p.ws + W_LAM256))[gt] = (f32x2){xr, xi};
  }
  if (gt < 64) ((unsigned*)(p.ws + W_CTR))[gt] = 0u;
}

template <class Epi>
DEV void gemm_phase(const bf16_t* __restrict__ A, int lda, const bf16_t* __restrict__ Wt, int K, int NT, Epi epi, unsigned char* smem) {
  const int tid = ltid(), lane = tid & 63, wave = tid >> 6, wm = wave >> 1, wn = wave & 1;
  const int r = lane & 31, hh = lane >> 5;
  bf16_t* As = (bf16_t*)smem;
  bf16_t* Bs = As + 2 * 128 * 72;
  const int nk = K >> 6;
  const int lrow = tid >> 3, lcc = tid & 7;
  const int xcd = blockIdx.x & 7, jx = blockIdx.x >> 3, nb = gridDim.x >> 3;
  const int U = (64 + nb - 1) / nb;
  const int n8 = NT >> 3, remc = NT & 7, has4 = (remc >= 4) ? 1 : 0, rem1 = remc - 4 * has4;
  const int NP = n8 * 32 + has4 * 16 + rem1 * 4;
  const int nPI = (xcd < NP) ? ((NP - xcd + 7) >> 3) * U : 0;
  const int nS = (blockIdx.x < 2 * NT) ? (2 * NT - blockIdx.x + gridDim.x - 1) / gridDim.x : 0;
  for (int w = 0; w < nPI + nS; ++w) {
    int tm, tn;
    if (w < nPI) {
      const int q = xcd + 8 * (w / U), jj = jx + nb * (w % U);
      if (jj >= 64) continue;
      if (q < n8 * 32) { const int c = q >> 5, lp = q & 31; tm = lp * 8 + (jj & 7); tn = c * 8 + (jj >> 3); }
      else {
        const int q2 = q - n8 * 32;
        if (has4 && q2 < 16) { tm = q2 * 16 + (jj & 15); tn = n8 * 8 + (jj >> 4); }
        else { const int q3 = q2 - has4 * 16; tm = (q3 & 3) * 64 + jj; tn = n8 * 8 + has4 * 4 + (q3 >> 2); }
      }
    } else {
      const int sidx = blockIdx.x + (w - nPI) * gridDim.x;
      tm = 256 + (sidx & 1); tn = sidx >> 1;
    }
    const int swz = (((wave & 1) << 2) + (lane >> 4)) & 7;
    const int csrc = ((lane & 7) ^ swz) * 8;
    const bf16_t* Ag = A + (size_t)(tm * 128 + wave * 8 + (lane >> 3)) * lda + csrc;
    const bf16_t* Bg = Wt + (size_t)(tn * 128 + wave * 8 + (lane >> 3)) * K + csrc;
    f32x16 acc[2][2];
#pragma unroll
    for (int i = 0; i < 2; ++i)
#pragma unroll
      for (int j = 0; j < 2; ++j)
#pragma unroll
        for (int q = 0; q < 16; ++q) acc[i][j][q] = 0.f;
    const int rsw = (r >> 1) & 7;
#define G_STAGE(BUF, KT)                                                                                         \
    _Pragma("unroll") for (int i = 0; i < 4; ++i) {                                                             \
      __builtin_amdgcn_global_load_lds((const unsigned*)(Ag + (size_t)(32 * i) * lda + (KT) * 64),               \
                                       (unsigned*)(smem + (BUF) * 32768 + (wave + 4 * i) * 1024), 16, 0, 0);     \
      __builtin_amdgcn_global_load_lds((const unsigned*)(Bg + (size_t)(32 * i) * K + (KT) * 64),                 \
                                       (unsigned*)(smem + (BUF) * 32768 + 16384 + (wave + 4 * i) * 1024), 16, 0, 0); }
#define G_COMPUTE(BUF)                                                                                           \
    _Pragma("unroll") for (int ks = 0; ks < 4; ++ks) {                                                          \
      bf16x8 af[2], bfr[2];                                                                                      \
      const int co = (((2 * ks + hh) ^ rsw) << 4);                                                               \
      _Pragma("unroll") for (int i = 0; i < 2; ++i) {                                                           \
        af[i] = *(const bf16x8*)(smem + (BUF) * 32768 + (wm * 64 + i * 32 + r) * 128 + co);                      \
        bfr[i] = *(const bf16x8*)(smem + (BUF) * 32768 + 16384 + (wn * 64 + i * 32 + r) * 128 + co); }           \
      _Pragma("unroll") for (int i = 0; i < 2; ++i)                                                             \
        _Pragma("unroll") for (int j = 0; j < 2; ++j) acc[i][j] = mfma32(af[i], bfr[j], acc[i][j]); }
    G_STAGE(0, 0)
    asm volatile("s_waitcnt vmcnt(0)" ::: "memory");
    __syncthreads();
    for (int kt = 0; kt < nk; kt += 2) {
      G_STAGE(1, kt + 1)
      G_COMPUTE(0)
      asm volatile("s_waitcnt vmcnt(0)" ::: "memory");
      __syncthreads();
      if (kt + 2 < nk) { G_STAGE(0, kt + 2) }
      G_COMPUTE(1)
      asm volatile("s_waitcnt vmcnt(0)" ::: "memory");
      __syncthreads();
    }
#undef G_STAGE
#undef G_COMPUTE
    epi(acc, tm * 128 + wm * 64, tn, wn, lane);
    __syncthreads();
  }
}

struct EpiSwiglu {
  bf16_t* act;
  DEV void operator()(const f32x16 (&acc)[2][2], int row0, int tn, int wn, int lane) const {
    const int r = lane & 31, hh = lane >> 5;
    const int col = tn * 64 + wn * 32 + r;
#pragma unroll
    for (int mt = 0; mt < 2; ++mt)
#pragma unroll
      for (int q = 0; q < 16; ++q) {
        const int row = row0 + mt * 32 + (q & 3) + 8 * (q >> 2) + 4 * hh;
        const float a = acc[mt][0][q], b = acc[mt][1][q];
        act[(size_t)row * DFF + col] = f2bf(silu_f(a) * b);
      }
  }
};
template <class F>
struct EpiElem {
  F f;
  DEV void operator()(const f32x16 (&acc)[2][2], int row0, int tn, int wn, int lane) const {
    const int r = lane & 31, hh = lane >> 5;
#pragma unroll
    for (int mt = 0; mt < 2; ++mt)
#pragma unroll
      for (int nt = 0; nt < 2; ++nt)
#pragma unroll
        for (int q = 0; q < 16; ++q) {
          const int row = row0 + mt * 32 + (q & 3) + 8 * (q >> 2) + 4 * hh;
          const int col = tn * 128 + wn * 64 + nt * 32 + r;
          f(row, col, acc[mt][nt][q]);
        }
  }
};
struct FResidX {
  float* X; float scale;
  DEV void operator()(int row, int col, float v) const {
    float* px = X + (size_t)row * D + col;
    *px = ALPHA * (*px) + scale * v;
  }
};
struct FResid {
  float* X; const bf16_t* Xb; float scale;
  DEV void operator()(int row, int col, float v) const {
    const size_t i = (size_t)row * D + col;
    X[i] = ALPHA * bf2f(Xb[i]) + scale * v;
  }
};
struct FStoreF32 {
  float* U;
  DEV void operator()(int row, int col, float v) const { U[(size_t)row * D + col] = v; }
};
struct FGlu {
  const bf16_t* zz; const float* bias; bf16_t* out;
  DEV void operator()(int row, int col, float v) const {
    const size_t i = (size_t)row * D + col;
    out[i] = f2bf(bf2f(zz[i]) * sigmoid_f(v + bias[col]));
  }
};
#define EACH_TILE(FN) FN(acc[0][0], 0, 0); FN(acc[0][1], 0, 1); FN(acc[1][0], 1, 0); FN(acc[1][1], 1, 1);
struct EpiEvenIn {
  P p;
  DEV void operator()(const f32x16 (&acc)[2][2], int row0, int tn, int wn, int lane) const {
    const int r = lane & 31, hh = lane >> 5;
    const bool samp = row0 >= MP;
    const int clb = wn * 64 + r;
    if (tn < 4) {
      bf16_t* MIX = (bf16_t*)(p.ws + R_MIX);
      float* QS = (float*)(p.ws + R_QS);
      auto fn = [&](const f32x16& a, int mt, int nt) {
        const int col = tn * 128 + clb + nt * 32;
#pragma unroll
        for (int q = 0; q < 16; ++q) {
          const int row = row0 + mt * 32 + (q & 3) + 8 * (q >> 2) + 4 * hh;
          MIX[(size_t)row * 1024 + col] = f2bf(a[q]);
          if (samp) QS[(size_t)(row - MP) * 512 + col] = a[q];
        }
      };
      EACH_TILE(fn)
    } else if (tn < 8) {
      bf16_t* KB = (bf16_t*)(p.ws + R_KB);
      float* ok = samp ? (p.out + O_FKS - (size_t)MP * 512) : (p.out + O_FKP);
      auto fn = [&](const f32x16& a, int mt, int nt) {
        const int col = (tn - 4) * 128 + clb + nt * 32;
#pragma unroll
        for (int q = 0; q < 16; ++q) {
          const int row = row0 + mt * 32 + (q & 3) + 8 * (q >> 2) + 4 * hh;
          KB[(size_t)row * 512 + col] = f2bf(a[q]);
          ok[(size_t)row * 512 + col] = a[q];
        }
      };
      EACH_TILE(fn)
    } else if (tn < 12) {
      if (!samp) {
        bf16_t* VT = (bf16_t*)(p.ws + R_VT);
        auto fn = [&](const f32x16& a, int mt, int nt) {
          const int col = (tn - 8) * 128 + clb + nt * 32;
          const int hd = col >> 6, dh = col & 63;
#pragma unroll
          for (int g = 0; g < 4; ++g) {
            const int row = row0 + mt * 32 + 8 * g + 4 * hh;
            const int b = row >> 14, tt = row & (T - 1);
            u32x2 o; o[0] = pack2(a[4 * g], a[4 * g + 1]); o[1] = pack2(a[4 * g + 2], a[4 * g + 3]);
            *(u32x2*)(VT + ((size_t)(b * 8 + hd) * 64 + dh) * T + tt) = o;
#pragma unroll
            for (int e = 0; e < 4; ++e) p.out[O_FVP + (size_t)(row + e) * 512 + col] = a[4 * g + e];
          }
        };
        EACH_TILE(fn)
      } else {
        auto fn = [&](const f32x16& a, int mt, int nt) {
          const int col = (tn - 8) * 128 + clb + nt * 32;
#pragma unroll
          for (int q = 0; q < 16; ++q) {
            const int row = row0 + mt * 32 + (q & 3) + 8 * (q >> 2) + 4 * hh;
            p.out[O_FVS + (size_t)(row - MP) * 512 + col] = a[q];
          }
        };
        EACH_TILE(fn)
      }
    } else if (tn < 24) {
      bf16_t* GB = (bf16_t*)(p.ws + R_GB);
      auto fn = [&](const f32x16& a, int mt, int nt) {
        const int col = (tn - 12) * 128 + clb + nt * 32;
#pragma unroll
        for (int q = 0; q < 16; ++q) {
          const int row = row0 + mt * 32 + (q & 3) + 8 * (q >> 2) + 4 * hh;
          const float v = a[q];
          GB[(size_t)row * 1536 + col] = f2bf(v);
          if (!samp) {
            const int tt = row & (T - 1);
            if (tt >= T - 3) p.out[O_GCP + (size_t)((row >> 14) * 3 + (tt - (T - 3))) * 1536 + col] = v;
          } else {
            const int tt = (row - MP) & 31;
            if (tt >= 29) p.out[O_GCS + (size_t)(((row - MP) >> 5) * 3 + (tt - 29)) * 1536 + col] = v;
          }
        }
      };
      EACH_TILE(fn)
    } else if (tn < 28) {
      bf16_t* MIX = (bf16_t*)(p.ws + R_MIX);
      auto fn = [&](const f32x16& a, int mt, int nt) {
        const int col = (tn - 24) * 128 + clb + nt * 32;
#pragma unroll
        for (int q = 0; q < 16; ++q) {
          const int row = row0 + mt * 32 + (q & 3) + 8 * (q >> 2) + 4 * hh;
          MIX[(size_t)row * 1024 + 512 + col] = f2bf(a[q]);
        }
      };
      EACH_TILE(fn)
    } else {
      float* LOGF = (float*)(p.ws + R_LOGF);
      float* GG = (float*)(p.ws + R_GG);
      float* BETA = (float*)(p.ws + R_BETA);
      if (wn == 0 && r < 16) {
        const int cl = r;
        float* ol = samp ? (p.out + O_FLS - (size_t)MP * 8) : (p.out + O_FLP);
        const float bias = (cl < 8) ? p.in[14][cl] : ((cl < 12) ? p.in[17][cl - 8] : 0.f);
        const float ea = (cl >= 8 && cl < 12) ? __expf(p.in[16][cl - 8]) : 0.f;
        auto fn = [&](const f32x16& a, int mt, int nt) {
          if (nt == 0) {
#pragma unroll
            for (int q = 0; q < 16; ++q) {
              const int row = row0 + mt * 32 + (q & 3) + 8 * (q >> 2) + 4 * hh;
              const float v = a[q];
              if (cl < 8) {
                const float lf = -softplus_f(-(v + bias));
                LOGF[(size_t)row * 8 + cl] = lf;
                ol[(size_t)row * 8 + cl] = lf;
              } else if (cl < 12) {
                GG[(size_t)row * 4 + (cl - 8)] = -ea * softplus_f(v + bias);
              } else {
                BETA[(size_t)row * 4 + (cl - 12)] = sigmoid_f(v);
              }
            }
          }
        };
        EACH_TILE(fn)
      }
    }
  }
};

DEV void ln_phase(float* __restrict__ X, bf16_t* __restrict__ Xb, const float* __restrict__ g, const float* __restrict__ b, bool write_bf, bool write_x) {
  const int tid_ = ltid();
  const int lane = tid_ & 63, wave = tid_ >> 6;
  const int gw = blockIdx.x * 4 + wave, nw = gridDim.x * 4;
  f32x4 gv[4], bv[4];
#pragma unroll
  for (int i = 0; i < 4; ++i) { gv[i] = ((const f32x4*)g)[i * 64 + lane]; bv[i] = ((const f32x4*)b)[i * 64 + lane]; }
  for (int row = gw; row < M; row += nw) {
    f32x4* xr = (f32x4*)(X + (size_t)row * D);
    f32x4 v[4];
    float s = 0.f;
#pragma unroll
    for (int i = 0; i < 4; ++i) { v[i] = xr[i * 64 + lane]; s += (v[i][0] + v[i][1]) + (v[i][2] + v[i][3]); }
    const float mu = wave_sum(s) * (1.f / D);
    float q = 0.f;
#pragma unroll
    for (int i = 0; i < 4; ++i) { v[i] = v[i] - mu; q += (v[i][0] * v[i][0] + v[i][1] * v[i][1]) + (v[i][2] * v[i][2] + v[i][3] * v[i][3]); }
    const float rs = rsqrtf(wave_sum(q) * (1.f / D) + 1e-5f);
#pragma unroll
    for (int i = 0; i < 4; ++i) {
      f32x4 o = v[i] * rs * gv[i] + bv[i];
      if (write_x) xr[i * 64 + lane] = o;
      if (write_bf) {
        u32x2 pk; pk[0] = pack2(o[0], o[1]); pk[1] = pack2(o[2], o[3]);
        ((u32x2*)(Xb + (size_t)row * D))[i * 64 + lane] = pk;
      }
    }
  }
}

DEV void cumsum_prompt(const P& p, int b, unsigned char* smem) {
  const float* LOGF = (const float*)(p.ws + R_LOGF) + (size_t)b * T * 8;
  float* CUM = (float*)(p.ws + R_CUM) + (size_t)b * T * 8;
  float* tot = (float*)smem;
  const int tid = ltid();
  float s[8];
#pragma unroll
  for (int h = 0; h < 8; ++h) s[h] = 0.f;
  for (int i = 0; i < 64; ++i) {
    const f32x4* r = (const f32x4*)(LOGF + (size_t)(tid * 64 + i) * 8);
    f32x4 a = r[0], c = r[1];
    s[0] += a[0]; s[1] += a[1]; s[2] += a[2]; s[3] += a[3]; s[4] += c[0]; s[5] += c[1]; s[6] += c[2]; s[7] += c[3];
  }
#pragma unroll
  for (int h = 0; h < 8; ++h) tot[tid * 8 + h] = s[h];
  __syncthreads();
  if (tid < 8) {
    float run = 0.f;
    for (int i = 0; i < 256; ++i) { const float v = tot[i * 8 + tid]; tot[i * 8 + tid] = run; run += v; }
  }
  __syncthreads();
#pragma unroll
  for (int h = 0; h < 8; ++h) s[h] = tot[tid * 8 + h];
  for (int i = 0; i < 64; ++i) {
    const f32x4* r = (const f32x4*)(LOGF + (size_t)(tid * 64 + i) * 8);
    f32x4 a = r[0], c = r[1];
    s[0] += a[0]; s[1] += a[1]; s[2] += a[2]; s[3] += a[3]; s[4] += c[0]; s[5] += c[1]; s[6] += c[2]; s[7] += c[3];
    f32x4* w = (f32x4*)(CUM + (size_t)(tid * 64 + i) * 8);
    w[0] = (f32x4){s[0], s[1], s[2], s[3]};
    w[1] = (f32x4){s[4], s[5], s[6], s[7]};
  }
  __syncthreads();
}

DEV void gdn_prep_item(const P& p, int item, unsigned char* smem) {
  const int tid = ltid(), lane = tid & 63, wave = tid >> 6;
  float* Kf = (float*)smem;
  float* Qf = Kf + 64 * 132;
  float* gc = Qf + 64 * 132;
  float* bt = gc + 64;
  float* eg = bt + 64;
  float* rk = eg + 64;
  float* rq = rk + 64;
  const bf16_t* GB = (const bf16_t*)(p.ws + R_GB);
  const float* GG = (const float*)(p.ws + R_GG);
  const float* BETA = (const float*)(p.ws + R_BETA);
  const float* cw = p.in[15];
  const bool samp = item >= 2048;
  const int h = item & 3;
  int row0, L; bool has_prev; const float* cbuf = nullptr;
  if (!samp) { const int chunk = (item >> 2) & 255, b = item >> 10; row0 = b * T + chunk * 64; L = 64; has_prev = chunk > 0; }
  else { const int sb = (item - 2048) >> 2; row0 = MP + sb * 32; L = 32; has_prev = false; cbuf = p.in[6] + (size_t)sb * 3 * 1536; }
  auto getx = [&](int i, int colg) -> float {
    if (i >= 0) return (i < L) ? bf2f(GB[(size_t)(row0 + i) * 1536 + colg]) : 0.f;
    if (samp) return cbuf[(3 + i) * 1536 + colg];
    return has_prev ? bf2f(GB[(size_t)(row0 + i) * 1536 + colg]) : 0.f;
  };
  const int c = tid & 127;
  const int half = tid >> 7;
  {
    const int colk = 512 + h * 128 + c, colq = h * 128 + c;
    const float k0 = cw[colk], k1 = cw[1536 + colk], k2 = cw[2 * 1536 + colk], k3 = cw[3 * 1536 + colk];
    const float q0 = cw[colq], q1 = cw[1536 + colq], q2 = cw[2 * 1536 + colq], q3 = cw[3 * 1536 + colq];
    const int i0 = half * 32;
    float a3 = getx(i0 - 3, colk), a2 = getx(i0 - 2, colk), a1 = getx(i0 - 1, colk);
    float b3 = getx(i0 - 3, colq), b2 = getx(i0 - 2, colq), b1 = getx(i0 - 1, colq);
#pragma unroll 8
    for (int ii = 0; ii < 32; ++ii) {
      const int i = i0 + ii;
      const float xa = getx(i, colk), xb = getx(i, colq);
      float ya = k0 * a3 + k1 * a2 + k2 * a1 + k3 * xa;
      float yb = q0 * b3 + q1 * b2 + q2 * b1 + q3 * xb;
      ya = (i < L) ? silu_f(ya) : 0.f;
      yb = (i < L) ? silu_f(yb) : 0.f;
      Kf[i * 132 + c] = ya;
      Qf[i * 132 + c] = yb;
      a3 = a2; a2 = a1; a1 = xa;
      b3 = b2; b2 = b1; b1 = xb;
    }
  }
  __syncthreads();
  for (int i = wave * 16; i < wave * 16 + 16; ++i) {
    const float a0 = Kf[i * 132 + lane], a1 = Kf[i * 132 + 64 + lane];
    const float sk = wave_sum(a0 * a0 + a1 * a1);
    const float b0 = Qf[i * 132 + lane], b1 = Qf[i * 132 + 64 + lane];
    const float sq = wave_sum(b0 * b0 + b1 * b1);
    if (lane == 0) { rk[i] = rsqrtf(sk + 1e-6f); rq[i] = rsqrtf(sq + 1e-6f) * 0.08838834764831845f; }
  }
  if (wave == 0) {
    float gi = (lane < L) ? GG[(size_t)(row0 + lane) * 4 + h] : 0.f;
    const float bi = (lane < L) ? BETA[(size_t)(row0 + lane) * 4 + h] : 0.f;
#pragma unroll
    for (int o = 1; o < 64; o <<= 1) { const float tt = __shfl_up(gi, o); if (lane >= o) gi += tt; }
    gc[lane] = gi; eg[lane] = __expf(gi); bt[lane] = bi;
  }
  __syncthreads();
  {
#pragma unroll 4
    for (int ii = 0; ii < 32; ++ii) {
      const int i = half * 32 + ii;
      Kf[i * 132 + c] *= rk[i];
      Qf[i * 132 + c] *= rq[i];
    }
  }
  __syncthreads();
  bf16_t* PW = (bf16_t*)(p.ws + A_PW) + (size_t)item * 8192;
  bf16_t* PQG = (bf16_t*)(p.ws + A_PQG) + (size_t)item * 8192;
  bf16_t* PKDT = (bf16_t*)(p.ws + A_PKDT) + (size_t)item * 8192;
  bf16_t* PUT = (bf16_t*)(p.ws + A_PUT) + (size_t)item * 8192;
  bf16_t* PATT = (bf16_t*)(p.ws + A_PATT) + (size_t)item * 4096;
  float* PGL = (float*)(p.ws + A_PGL);
  const float gl = gc[63];
  {
#pragma unroll 4
    for (int ii = 0; ii < 32; ++ii) {
      const int i = half * 32 + ii;
      PQG[i * 128 + c] = f2bf(Qf[i * 132 + c] * eg[i]);
    }
#pragma unroll
    for (int j8 = 0; j8 < 4; ++j8) {
      const int j0 = half * 32 + j8 * 8;
      float e[8];
#pragma unroll
      for (int t = 0; t < 8; ++t) e[t] = Kf[(j0 + t) * 132 + c] * __expf(gl - gc[j0 + t]);
      u32x4 o;
      o[0] = pack2(e[0], e[1]); o[1] = pack2(e[2], e[3]); o[2] = pack2(e[4], e[5]); o[3] = pack2(e[6], e[7]);
      *(u32x4*)(PKDT + c * 64 + j0) = o;
    }
    if (tid == 0) PGL[item] = __expf(gl);
  }
  const int ti = tid >> 4, tj = tid & 15;
  {
    float accA[4][4], accN[4][4];
#pragma unroll
    for (int a = 0; a < 4; ++a)
#pragma unroll
      for (int b = 0; b < 4; ++b) { accA[a][b] = 0.f; accN[a][b] = 0.f; }
#pragma unroll 2
    for (int cc = 0; cc < 128; cc += 4) {
      f32x4 qi[4], ki[4], kj[4];
#pragma unroll
      for (int a = 0; a < 4; ++a) {
        qi[a] = *(const f32x4*)(Qf + (ti + 16 * a) * 132 + cc);
        ki[a] = *(const f32x4*)(Kf + (ti + 16 * a) * 132 + cc);
        kj[a] = *(const f32x4*)(Kf + (tj + 16 * a) * 132 + cc);
      }
#pragma unroll
      for (int a = 0; a < 4; ++a)
#pragma unroll
        for (int b = 0; b < 4; ++b) {
          accA[a][b] += qi[a][0] * kj[b][0] + qi[a][1] * kj[b][1] + qi[a][2] * kj[b][2] + qi[a][3] * kj[b][3];
          accN[a][b] += ki[a][0] * kj[b][0] + ki[a][1] * kj[b][1] + ki[a][2] * kj[b][2] + ki[a][3] * kj[b][3];
        }
    }
    __syncthreads();
    float* Nl = Qf;
#pragma unroll
    for (int a = 0; a < 4; ++a)
#pragma unroll
      for (int b = 0; b < 4; ++b) {
        const int i = ti + 16 * a, j = tj + 16 * b;
        const float dec = (j <= i) ? __expf(gc[i] - gc[j]) : 0.f;
        PATT[i * 64 + j] = f2bf((j <= i) ? accA[a][b] * dec : 0.f);
        Nl[i * 68 + j] = (j < i) ? accN[a][b] * bt[i] * dec : 0.f;
      }
  }
  __syncthreads();
  {
    const float* Nl = Qf;
    float col[64];
    if (tid < 128) {
      const int colg = 1024 + h * 128 + c;
      const float w0 = cw[colg], w1 = cw[1536 + colg], w2 = cw[2 * 1536 + colg], w3 = cw[3 * 1536 + colg];
      float x3 = getx(-3, colg), x2 = getx(-2, colg), x1 = getx(-1, colg);
#pragma unroll
      for (int i = 0; i < 64; ++i) {
        const float x = getx(i, colg);
        float y = w0 * x3 + w1 * x2 + w2 * x1 + w3 * x;
        y = (i < L) ? silu_f(y) : 0.f;
        col[i] = y * bt[i];
        x3 = x2; x2 = x1; x1 = x;
      }
    } else {
#pragma unroll
      for (int i = 0; i < 64; ++i) col[i] = Kf[i * 132 + c] * bt[i] * eg[i];
    }
#pragma unroll
    for (int i = 1; i < 64; ++i) {
      float sacc = 0.f;
#pragma unroll
      for (int j4 = 0; j4 < (i + 3) / 4; ++j4) {
        const f32x4 nv = *(const f32x4*)(Nl + i * 68 + j4 * 4);
#pragma unroll
        for (int e = 0; e < 4; ++e)
          if (j4 * 4 + e < i) sacc += nv[e] * col[j4 * 4 + e];
      }
      col[i] -= sacc;
    }
    if (tid < 128) {
#pragma unroll
      for (int j8 = 0; j8 < 8; ++j8) {
        u32x4 o;
        o[0] = pack2(col[j8 * 8 + 0], col[j8 * 8 + 1]); o[1] = pack2(col[j8 * 8 + 2], col[j8 * 8 + 3]);
        o[2] = pack2(col[j8 * 8 + 4], col[j8 * 8 + 5]); o[3] = pack2(col[j8 * 8 + 6], col[j8 * 8 + 7]);
        *(u32x4*)(PUT + c * 64 + j8 * 8) = o;
      }
    } else {
#pragma unroll
      for (int i = 0; i < 64; ++i) PW[i * 128 + c] = f2bf(col[i]);
    }
  }
  __syncthreads();
}

struct GdnFr { bf16x8 w[4], qg[4], att[2], kd[2][2]; u32x2 u; float gl; };
DEV void gdn_load(GdnFr& f, const P& p, int item, int sl, int wave, int lane) {
  const int r16 = lane & 15, q4 = lane >> 4;
  const bf16_t* PW = (const bf16_t*)(p.ws + A_PW) + (size_t)item * 8192;
  const bf16_t* PQG = (const bf16_t*)(p.ws + A_PQG) + (size_t)item * 8192;
  const bf16_t* PKDT = (const bf16_t*)(p.ws + A_PKDT) + (size_t)item * 8192;
  const bf16_t* PUT = (const bf16_t*)(p.ws + A_PUT) + (size_t)item * 8192;
  const bf16_t* PATT = (const bf16_t*)(p.ws + A_PATT) + (size_t)item * 4096;
#pragma unroll
  for (int ks = 0; ks < 4; ++ks) {
    f.w[ks] = *(const bf16x8*)(PW + (wave * 16 + r16) * 128 + ks * 32 + q4 * 8);
    f.qg[ks] = *(const bf16x8*)(PQG + (wave * 16 + r16) * 128 + ks * 32 + q4 * 8);
  }
#pragma unroll
  for (int ks = 0; ks < 2; ++ks) {
    f.att[ks] = *(const bf16x8*)(PATT + (wave * 16 + r16) * 64 + ks * 32 + q4 * 8);
#pragma unroll
    for (int mt = 0; mt < 2; ++mt) f.kd[mt][ks] = *(const bf16x8*)(PKDT + (wave * 32 + mt * 16 + r16) * 64 + ks * 32 + q4 * 8);
  }
  f.u = *(const u32x2*)(PUT + (sl * 16 + r16) * 64 + wave * 16 + q4 * 4);
  f.gl = ((const float*)(p.ws + A_PGL))[item];
}

DEV void gdn_scan_chain(const P& p, int chain, unsigned char* smem) {
  const int tid = ltid(), lane = tid & 63, wave = tid >> 6;
  const int r16 = lane & 15, q4 = lane >> 4;
  bf16_t* Sb = (bf16_t*)smem;
  bf16_t* Vn = Sb + 16 * 136;
  float* ORAW = (float*)(p.ws + R_GB);
  int sl, h, nchunks, item0, rowbase, nvalid; float* sout; const float* s0 = nullptr;
  if (chain < 64) { sl = chain & 7; h = (chain >> 3) & 3; const int b = chain >> 5; nchunks = 256; item0 = b * 1024 + h; rowbase = b * T; nvalid = 64;
    sout = p.out + O_GSP + (size_t)(b * 4 + h) * 16384; }
  else { const int cs = chain - 64; sl = cs & 7; h = (cs >> 3) & 3; const int sb = cs >> 5; nchunks = 1; item0 = 2048 + sb * 4 + h; rowbase = MP + sb * 32; nvalid = 32;
    sout = p.out + O_GSS + (size_t)(sb * 4 + h) * 16384; s0 = p.in[5] + (size_t)(sb * 4 + h) * 16384; }
  f32x4 S[2];
#pragma unroll
  for (int mt = 0; mt < 2; ++mt)
#pragma unroll
    for (int e = 0; e < 4; ++e) S[mt][e] = s0 ? s0[(size_t)(wave * 32 + mt * 16 + q4 * 4 + e) * 128 + sl * 16 + r16] : 0.f;
#pragma unroll
  for (int mt = 0; mt < 2; ++mt) {
    u32x2 o; o[0] = pack2(S[mt][0], S[mt][1]); o[1] = pack2(S[mt][2], S[mt][3]);
    *(u32x2*)(Sb + r16 * 136 + wave * 32 + mt * 16 + q4 * 4) = o;
  }
  __builtin_amdgcn_s_setprio(3);
  GdnFr cur, nxt;
  gdn_load(cur, p, item0, sl, wave, lane);
  __syncthreads();
  for (int ch = 0; ch < nchunks; ++ch) {
    if (ch + 1 < nchunks) gdn_load(nxt, p, item0 + (ch + 1) * 4, sl, wave, lane);
    f32x4 ws = {0.f, 0.f, 0.f, 0.f}, ws2 = {0.f, 0.f, 0.f, 0.f}, qs = {0.f, 0.f, 0.f, 0.f}, qs2 = {0.f, 0.f, 0.f, 0.f};
    {
      bf16x8 sf[4];
#pragma unroll
      for (int ks = 0; ks < 4; ++ks) sf[ks] = *(const bf16x8*)(Sb + r16 * 136 + ks * 32 + q4 * 8);
      ws = mfma16(cur.w[0], sf[0], ws);
      ws2 = mfma16(cur.w[1], sf[1], ws2);
      ws = mfma16(cur.w[2], sf[2], ws);
      ws2 = mfma16(cur.w[3], sf[3], ws2);
      qs = mfma16(cur.qg[0], sf[0], qs);
      qs2 = mfma16(cur.qg[1], sf[1], qs2);
      qs = mfma16(cur.qg[2], sf[2], qs);
      qs2 = mfma16(cur.qg[3], sf[3], qs2);
    }
    ws = ws + ws2;
    qs = qs + qs2;
    f32x4 vn;
    vn[0] = bf2f((bf16_t)(cur.u[0] & 0xffff)) - ws[0];
    vn[1] = bf2f((bf16_t)(cur.u[0] >> 16)) - ws[1];
    vn[2] = bf2f((bf16_t)(cur.u[1] & 0xffff)) - ws[2];
    vn[3] = bf2f((bf16_t)(cur.u[1] >> 16)) - ws[3];
    {
      u32x2 o; o[0] = pack2(vn[0], vn[1]); o[1] = pack2(vn[2], vn[3]);
      *(u32x2*)(Vn + r16 * 72 + wave * 16 + q4 * 4) = o;
    }
    __syncthreads();
    bf16x8 vf[2];
#pragma unroll
    for (int ks = 0; ks < 2; ++ks) vf[ks] = *(const bf16x8*)(Vn + r16 * 72 + ks * 32 + q4 * 8);
#pragma unroll
    for (int ks = 0; ks < 2; ++ks) qs = mfma16(cur.att[ks], vf[ks], qs);
#pragma unroll
    for (int e = 0; e < 4; ++e) {
      const int i = wave * 16 + q4 * 4 + e;
      if (i < nvalid) ORAW[(size_t)(rowbase + ch * 64 + i) * 512 + h * 128 + sl * 16 + r16] = qs[e];
    }
#pragma unroll
    for (int mt = 0; mt < 2; ++mt) {
      f32x4 sn = S[mt] * cur.gl;
#pragma unroll
      for (int ks = 0; ks < 2; ++ks) sn = mfma16(cur.kd[mt][ks], vf[ks], sn);
      S[mt] = sn;
      u32x2 o; o[0] = pack2(sn[0], sn[1]); o[1] = pack2(sn[2], sn[3]);
      *(u32x2*)(Sb + r16 * 136 + wave * 32 + mt * 16 + q4 * 4) = o;
    }
    __syncthreads();
    if (ch + 1 < nchunks) cur = nxt;
  }
#pragma unroll
  for (int mt = 0; mt < 2; ++mt)
#pragma unroll
    for (int e = 0; e < 4; ++e) sout[(size_t)(wave * 32 + mt * 16 + q4 * 4 + e) * 128 + sl * 16 + r16] = S[mt][e];
  __builtin_amdgcn_s_setprio(0);
  __syncthreads();
}

struct TagTrue { static constexpr bool value = true; };
struct TagFalse { static constexpr bool value = false; };
DEV void attn_prompt_item(const P& p, int bh, int qb, unsigned char* smem) {
  const int tid = ltid(), lane = tid & 63, wave = tid >> 6;
  const int r = lane & 31, hh = lane >> 5;
  const int b = bh >> 3, hd = bh & 7;
  bf16_t* Ks = (bf16_t*)smem;
  bf16_t* Vs = Ks + 2 * 64 * 72;
  float* Bi = (float*)(Vs + 2 * 64 * 72);
  bf16_t* MIX = (bf16_t*)(p.ws + R_MIX);
  const bf16_t* KB = (const bf16_t*)(p.ws + R_KB);
  const bf16_t* VT = (const bf16_t*)(p.ws + R_VT);
  const float* CUM = (const float*)(p.ws + R_CUM);
  const int qpos = qb * 128 + wave * 32 + r;
  const size_t qrow = (size_t)b * T + qpos;
  bf16x8 qf[4];
#pragma unroll
  for (int ks = 0; ks < 4; ++ks) qf[ks] = *(const bf16x8*)(MIX + qrow * 1024 + hd * 64 + ks * 16 + hh * 8);
  f32x16 o[2];
#pragma unroll
  for (int dt = 0; dt < 2; ++dt)
#pragma unroll
    for (int q = 0; q < 16; ++q) o[dt][q] = 0.f;
  float m = -INFINITY, moff = 0.f, lsum = 0.f;
  const int nkt = qb * 2 + 2;
  const int lrow = tid >> 3, lcc = tid & 7;
  const bf16_t* Kg = KB + ((size_t)b * T + lrow) * 512 + hd * 64 + lcc * 8;
  const bf16_t* Vg = VT + ((size_t)bh * 64 + lrow) * T + lcc * 8;
  const int qlast = qb * 128 + wave * 32 + 31, qfirst = qb * 128 + wave * 32;
  constexpr float SC = 0.125f * LOG2E, RSC = 1.f / SC;
  auto tile_body = [&](const bf16_t* ks_, const bf16_t* vs_, const float* bi_, int kt, auto masked_tag) {
    constexpr bool MASKED = decltype(masked_tag)::value;
    f32x16 s[2];
    f32x4 bbv[2][4];
#pragma unroll
    for (int k2 = 0; k2 < 2; ++k2)
#pragma unroll
      for (int g = 0; g < 4; ++g) bbv[k2][g] = *(const f32x4*)(bi_ + 32 * k2 + 8 * g + 4 * hh);
    __builtin_amdgcn_sched_barrier(0);
    const float sinit = -moff * RSC;
#pragma unroll
    for (int k2 = 0; k2 < 2; ++k2) {
#pragma unroll
      for (int q = 0; q < 16; ++q) s[k2][q] = sinit;
#pragma unroll
      for (int ks = 0; ks < 4; ++ks) {
        const bf16x8 kf = *(const bf16x8*)(ks_ + (32 * k2 + r) * 72 + ks * 16 + hh * 8);
        s[k2] = mfma32(kf, qf[ks], s[k2]);
      }
    }
    float mx = -INFINITY;
#pragma unroll
    for (int k2 = 0; k2 < 2; ++k2)
#pragma unroll
      for (int g = 0; g < 4; ++g) {
        const f32x4 bb = bbv[k2][g];
#pragma unroll
        for (int e = 0; e < 4; ++e) {
          float tv = s[k2][4 * g + e] * SC + bb[e];
          if (MASKED) { const int key = kt * 64 + 32 * k2 + 8 * g + 4 * hh + e; if (key > qpos) tv = -INFINITY; }
          s[k2][4 * g + e] = tv;
          mx = fmaxf(mx, tv);
        }
      }
    mx = fmaxf(mx, __shfl_xor(mx, 32));
    float ps = 0.f;
    bf16x8 pb[2][2];
    auto make_p = [&](float sub, auto sub_tag) {
      constexpr bool SUB = decltype(sub_tag)::value;
#pragma unroll
      for (int k2 = 0; k2 < 2; ++k2)
#pragma unroll
        for (int s2 = 0; s2 < 2; ++s2) {
          u32x4 pk;
#pragma unroll
          for (int j = 0; j < 4; ++j) {
            float x0 = s[k2][8 * s2 + 2 * j], x1 = s[k2][8 * s2 + 2 * j + 1];
            if (SUB) { x0 -= sub; x1 -= sub; }
            const float p0 = fexp2(x0), p1 = fexp2(x1);
            ps += p0 + p1;
            pk[j] = pack2(p0, p1);
          }
          pb[k2][s2] = __builtin_bit_cast(bf16x8, pk);
        }
    };
    if (__builtin_amdgcn_ballot_w64(mx + moff > m + 8.f) != 0ull) {
      const float mnew = fmaxf(m, mx + moff);
      const float alpha = fexp2(m - mnew);
      m = mnew;
      lsum *= alpha;
#pragma unroll
      for (int dt = 0; dt < 2; ++dt) o[dt] = o[dt] * alpha;
      const float sub = mnew - moff;
      moff = mnew;
      make_p(sub, TagTrue{});
    } else {
      make_p(0.f, TagFalse{});
    }
    lsum += ps;
#pragma unroll
    for (int dt = 0; dt < 2; ++dt) {
#pragma unroll
      for (int k2 = 0; k2 < 2; ++k2)
#pragma unroll
        for (int s2 = 0; s2 < 2; ++s2) {
          const bf16_t* vp = vs_ + (32 * dt + r) * 72 + 32 * k2 + 16 * s2 + 4 * hh;
          const bf16x4 lo = *(const bf16x4*)vp, hi = *(const bf16x4*)(vp + 8);
          bf16x8 vf;
          vf[0] = lo[0]; vf[1] = lo[1]; vf[2] = lo[2]; vf[3] = lo[3]; vf[4] = hi[0]; vf[5] = hi[1]; vf[6] = hi[2]; vf[7] = hi[3];
          o[dt] = mfma32(vf, pb[k2][s2], o[dt]);
        }
    }
  };
  u32x4 rk0[2], rv0[2], rk1[2], rv1[2]; float rb0 = 0.f, rb1 = 0.f;
#define A_LOAD(RK, RV, RB, KT)                                                                \
  { _Pragma("unroll") for (int i = 0; i < 2; ++i) {                                           \
      RK[i] = *(const u32x4*)(Kg + (size_t)((KT) * 64 + 32 * i) * 512);                        \
      RV[i] = *(const u32x4*)(Vg + (size_t)(32 * i) * T + (KT) * 64); }                        \
    if (tid < 64) RB = -CUM[((size_t)b * T + (KT) * 64 + tid) * 8 + hd] * LOG2E; }
#define A_WRITE(RK, RV, RB, BUF)                                                              \
  { _Pragma("unroll") for (int i = 0; i < 2; ++i) {                                           \
      *(u32x4*)(Ks + (BUF) * 64 * 72 + (lrow + 32 * i) * 72 + lcc * 8) = RK[i];                \
      *(u32x4*)(Vs + (BUF) * 64 * 72 + (lrow + 32 * i) * 72 + lcc * 8) = RV[i]; }              \
    if (tid < 64) Bi[(BUF) * 64 + tid] = RB; }
#define A_COMPUTE(BUF, KT)                                                                    \
  if ((KT) * 64 <= qlast) {                                                                   \
    if ((KT) * 64 + 63 > qfirst) tile_body(Ks + (BUF) * 64 * 72, Vs + (BUF) * 64 * 72, Bi + (BUF) * 64, (KT), TagTrue{});   \
    else tile_body(Ks + (BUF) * 64 * 72, Vs + (BUF) * 64 * 72, Bi + (BUF) * 64, (KT), TagFalse{}); }
  A_LOAD(rk0, rv0, rb0, 0)
  A_WRITE(rk0, rv0, rb0, 0)
  A_LOAD(rk0, rv0, rb0, 1)
  if (nkt > 2) A_LOAD(rk1, rv1, rb1, 2)
  __syncthreads();
  for (int kt = 0; kt < nkt; kt += 2) {
    A_WRITE(rk0, rv0, rb0, 1)
    if (kt + 3 < nkt) A_LOAD(rk0, rv0, rb0, kt + 3)
    __builtin_amdgcn_sched_barrier(0);
    A_COMPUTE(0, kt)
    __syncthreads();
    if (kt + 2 < nkt) A_WRITE(rk1, rv1, rb1, 0)
    if (kt + 4 < nkt) A_LOAD(rk1, rv1, rb1, kt + 4)
    __builtin_amdgcn_sched_barrier(0);
    A_COMPUTE(1, kt + 1)
    __syncthreads();
  }
#undef A_LOAD
#undef A_WRITE
#undef A_COMPUTE
  lsum += __shfl_xor(lsum, 32);
  const float inv = 1.f / lsum;
#pragma unroll
  for (int dt = 0; dt < 2; ++dt)
#pragma unroll
    for (int g = 0; g < 4; ++g) {
      u32x2 ov; ov[0] = pack2(o[dt][4 * g] * inv, o[dt][4 * g + 1] * inv); ov[1] = pack2(o[dt][4 * g + 2] * inv, o[dt][4 * g + 3] * inv);
      *(u32x2*)(MIX + qrow * 1024 + hd * 64 + 32 * dt + 8 * g + 4 * hh) = ov;
    }
  __syncthreads();
}

DEV void attn_sample_item(const P& p, int item, unsigned char* smem) {
  const int tid = ltid(), lane = tid & 63, wave = tid >> 6;
  const int qg = item & 3, hd = (item >> 2) & 7, sb = item >> 5;
  float* cs = (float*)smem;
  float* qs = cs + 1088;
  float* ps = qs + 256;
  const float* ck = p.in[2] + (size_t)sb * 1024 * 512;
  const float* cv = p.in[3] + (size_t)sb * 1024 * 512;
  const float* clf = p.in[4] + (size_t)sb * 1024 * 8;
  const float* nk = p.out + O_FKS + (size_t)sb * 32 * 512;
  const float* nv = p.out + O_FVS + (size_t)sb * 32 * 512;
  const float* nlf = (const float*)(p.ws + R_LOGF) + (size_t)(MP + sb * 32) * 8;
  const float* QS = (const float*)(p.ws + R_QS) + (size_t)sb * 32 * 512;
  bf16_t* MIX = (bf16_t*)(p.ws + R_MIX);
  if (wave == 0) {
    float s = 0.f;
    for (int i = 0; i < 17; ++i) {
      const int j = lane * 17 + i;
      float x = 0.f;
      if (j < 1024) x = clf[(size_t)j * 8 + hd]; else if (j < 1056) x = nlf[(size_t)(j - 1024) * 8 + hd];
      s += x; cs[j] = s;
    }
    float inc = s;
#pragma unroll
    for (int o = 1; o < 64; o <<= 1) { const float tt = __shfl_up(inc, o); if (lane >= o) inc += tt; }
    const float ex = inc - s;
    for (int i = 0; i < 17; ++i) cs[lane * 17 + i] += ex;
  }
  __syncthreads();
  for (int qi = qg * 8 + wave * 2; qi < qg * 8 + wave * 2 + 2; ++qi) {
    qs[wave * 64 + lane] = QS[(size_t)qi * 512 + hd * 64 + lane];
    __syncthreads();
    const int nkeys = 1024 + qi + 1;
    const float cq = cs[1024 + qi];
    float mx = -INFINITY;
#pragma unroll 2
    for (int n = 0; n < 17; ++n) {
      const int j = lane + 64 * n;
      float sv = -INFINITY;
      if (j < nkeys) {
        const float* kr = (j < 1024) ? (ck + (size_t)j * 512 + hd * 64) : (nk + (size_t)(j - 1024) * 512 + hd * 64);
        float d = 0.f;
#pragma unroll
        for (int c4 = 0; c4 < 16; ++c4) {
          const f32x4 kk = *(const f32x4*)(kr + c4 * 4);
          const f32x4 qq = *(const f32x4*)(qs + wave * 64 + c4 * 4);
          d += kk[0] * qq[0] + kk[1] * qq[1] + kk[2] * qq[2] + kk[3] * qq[3];
        }
        sv = d * 0.125f + cq - cs[j];
      }
      ps[wave * 1088 + j] = sv; mx = fmaxf(mx, sv);
    }
    mx = wave_max(mx);
    float sum = 0.f;
    for (int n = 0; n < 17; ++n) {
      const int j = lane + 64 * n;
      const float pv = (j < nkeys) ? __expf(ps[wave * 1088 + j] - mx) : 0.f;
      sum += pv;
      ps[wave * 1088 + j] = pv;
    }
    sum = wave_sum(sum);
    __syncthreads();
    float acc0 = 0.f, acc1 = 0.f, acc2 = 0.f, acc3 = 0.f;
    const float* cvh = cv + hd * 64 + lane;
#pragma unroll 4
    for (int j = 0; j < 1024; j += 4) {
      const f32x4 pp = *(const f32x4*)(ps + wave * 1088 + j);
      acc0 += pp[0] * cvh[(size_t)(j + 0) * 512];
      acc1 += pp[1] * cvh[(size_t)(j + 1) * 512];
      acc2 += pp[2] * cvh[(size_t)(j + 2) * 512];
      acc3 += pp[3] * cvh[(size_t)(j + 3) * 512];
    }
    for (int j = 1024; j < nkeys; ++j) acc0 += ps[wave * 1088 + j] * nv[(size_t)(j - 1024) * 512 + hd * 64 + lane];
    const float acc = (acc0 + acc1) + (acc2 + acc3);
    MIX[(size_t)(MP + sb * 32 + qi) * 1024 + hd * 64 + lane] = f2bf(acc / sum);
    __syncthreads();
  }
}

DEV void gdn_gate_phase(const P& p) {
  const int tid_ = ltid();
  const int lane = tid_ & 63, wave = tid_ >> 6;
  const float* ORAW = (const float*)(p.ws + R_GB);
  bf16_t* MIX = (bf16_t*)(p.ws + R_MIX);
  const float* ng = p.in[18];
  const f32x2 g2 = *(const f32x2*)(ng + 2 * lane);
  for (int it = blockIdx.x * 4 + wave; it < M * 4; it += gridDim.x * 4) {
    const int row = it >> 2, h = it & 3;
    const f32x2 ov = *(const f32x2*)(ORAW + (size_t)row * 512 + h * 128 + 2 * lane);
    unsigned* zp = (unsigned*)(MIX + (size_t)row * 1024 + 512 + h * 128 + 2 * lane);
    const unsigned zz = *zp;
    const float z0 = bf2f((bf16_t)(zz & 0xffff)), z1 = bf2f((bf16_t)(zz >> 16));
    const float ss = wave_sum(ov[0] * ov[0] + ov[1] * ov[1]);
    const float rs = rsqrtf(ss * (1.f / 128.f) + 1e-6f);
    *zp = pack2(ov[0] * rs * g2[0] * silu_f(z0), ov[1] * rs * g2[1] * silu_f(z1));
  }
}

template <int PASS>
DEV void s5_item(const P& p, int item, unsigned char* smem) {
  const int tid = ltid(), lane = tid & 63, wave = tid >> 6;
  const int r = lane & 31, hh = lane >> 5, r16 = lane & 15, q4 = lane >> 4;
  bf16_t* HB = (bf16_t*)smem + wave * 64 * 136;
  const float* U = (const float*)(p.ws + R_U);
  bf16_t* ZZB = (bf16_t*)(p.ws + R_ZZB);
  f32x2* E = (f32x2*)(p.ws + R_E);
  const f32x2* LAMB = (const f32x2*)(p.ws + W_LAMB);
  const f32x2* LAM256 = (const f32x2*)(p.ws + W_LAM256);
  const bf16_t* Bp = (const bf16_t*)(p.ws + W_S5B);
  const bf16_t* Cp = (const bf16_t*)(p.ws + W_S5C);
  int g, seq, span, row0, nchunk, ntok; bool samp;
  if (item < 2048) { samp = false; const int gq = item & 15; span = (item >> 4) & 63; seq = item >> 10; g = gq * 4 + wave; row0 = seq * T + span * 256; nchunk = 4; ntok = 64; }
  else { samp = true; const int it = item - 2048; const int gq = it & 15; seq = it >> 4; span = 0; g = gq * 4 + wave; row0 = MP + seq * 32; nchunk = 1; ntok = 32; }
  const f32x2 lam = LAMB[g * 64 + lane];
  float hr = 0.f, hi = 0.f;
  if (PASS == 2) {
    if (samp) { hr = p.in[7][(size_t)(seq * 64 + g) * 64 + lane]; hi = p.in[8][(size_t)(seq * 64 + g) * 64 + lane]; }
    else {
      const f32x2 l256 = LAM256[g * 64 + lane];
#pragma unroll 8
      for (int j = 0; j < span; ++j) {
        const f32x2 e = E[((size_t)(seq * 64 + j) * 64 + g) * 64 + lane];
        const float nr = l256[0] * hr - l256[1] * hi + e[0];
        const float ni = l256[0] * hi + l256[1] * hr + e[1];
        hr = nr; hi = ni;
      }
    }
  }
  bf16x8 bfr[4];
#pragma unroll
  for (int nt = 0; nt < 4; ++nt) bfr[nt] = *(const bf16x8*)(Bp + ((size_t)g * 128 + nt * 32 + r) * 16 + hh * 8);
  bf16x8 cfr[4];
#pragma unroll
  for (int ks = 0; ks < 4; ++ks) cfr[ks] = *(const bf16x8*)(Cp + ((size_t)g * 16 + r16) * 128 + ks * 32 + q4 * 8);
  const float dd = p.in[28][g * 16 + r16];
  for (int ch = 0; ch < nchunk; ++ch) {
    const int rowc = row0 + ch * 64;
#pragma unroll
    for (int mt = 0; mt < 2; ++mt) {
      bf16x8 uf;
      if (mt * 32 < ntok) {
        const float* up = U + (size_t)(rowc + mt * 32 + r) * D + g * 16 + hh * 8;
        const f32x4 u0 = *(const f32x4*)up, u1 = *(const f32x4*)(up + 4);
        uf[0] = (short)f2bf(u0[0]); uf[1] = (short)f2bf(u0[1]); uf[2] = (short)f2bf(u0[2]); uf[3] = (short)f2bf(u0[3]);
        uf[4] = (short)f2bf(u1[0]); uf[5] = (short)f2bf(u1[1]); uf[6] = (short)f2bf(u1[2]); uf[7] = (short)f2bf(u1[3]);
      } else {
#pragma unroll
        for (int j = 0; j < 8; ++j) uf[j] = 0;
      }
#pragma unroll
      for (int nt = 0; nt < 4; ++nt) {
        f32x16 acc;
#pragma unroll
        for (int q = 0; q < 16; ++q) acc[q] = 0.f;
        acc = mfma32(uf, bfr[nt], acc);
#pragma unroll
        for (int q = 0; q < 16; ++q) HB[(mt * 32 + (q & 3) + 8 * (q >> 2) + 4 * hh) * 136 + nt * 32 + r] = f2bf(acc[q]);
      }
    }
    __syncthreads();
    for (int t = 0; t < ntok; ++t) {
      const float br = bf2f(HB[t * 136 + lane]), bi = bf2f(HB[t * 136 + 64 + lane]);
      const float nr = lam[0] * hr - lam[1] * hi + br;
      const float ni = lam[0] * hi + lam[1] * hr + bi;
      hr = nr; hi = ni;
      if (PASS == 2) { HB[t * 136 + lane] = f2bf(hr); HB[t * 136 + 64 + lane] = f2bf(hi); }
    }
    __syncthreads();
    if (PASS == 2) {
#pragma unroll
      for (int m4 = 0; m4 < 4; ++m4) {
        if (m4 * 16 < ntok) {
          f32x4 y = {0.f, 0.f, 0.f, 0.f};
#pragma unroll
          for (int ks = 0; ks < 4; ++ks) {
            const bf16x8 hf = *(const bf16x8*)(HB + (m4 * 16 + r16) * 136 + ks * 32 + q4 * 8);
            y = mfma16(hf, cfr[ks], y);
          }
#pragma unroll
          for (int e = 0; e < 4; ++e) {
            const size_t idx = (size_t)(rowc + m4 * 16 + q4 * 4 + e) * D + g * 16 + r16;
            const float yy = y[e] + dd * U[idx];
            ZZB[idx] = f2bf(gelu_tanh(yy));
          }
        }
      }
      __syncthreads();
    }
  }
  if (PASS == 1) E[((size_t)(seq * 64 + span) * 64 + g) * 64 + lane] = (f32x2){hr, hi};
  else {
    if (samp) { p.out[O_S5RS + (size_t)(seq * 64 + g) * 64 + lane] = hr; p.out[O_S5IS + (size_t)(seq * 64 + g) * 64 + lane] = hi; }
    else if (span == 63) { p.out[O_S5RP + (size_t)(seq * 64 + g) * 64 + lane] = hr; p.out[O_S5IP + (size_t)(seq * 64 + g) * 64 + lane] = hi; }
  }
}

DEV void gsync(unsigned* bar, unsigned& epoch) {
  epoch += 1;
  asm volatile("s_waitcnt vmcnt(0) lgkmcnt(0)" ::: "memory");
  __syncthreads();
  if (threadIdx.x == 0) {
    __builtin_amdgcn_fence(__ATOMIC_RELEASE, "agent");
    const unsigned g = blockIdx.x & 7, nbg = gridDim.x >> 3;
    const unsigned old = __hip_atomic_fetch_add(bar + 32 * (1 + g), 1u, __ATOMIC_RELAXED, __HIP_MEMORY_SCOPE_AGENT);
    if (old + 1 == epoch * nbg) __hip_atomic_fetch_add(bar, 1u, __ATOMIC_RELAXED, __HIP_MEMORY_SCOPE_AGENT);
    while (__hip_atomic_load(bar, __ATOMIC_RELAXED, __HIP_MEMORY_SCOPE_AGENT) < epoch * 8u) __builtin_amdgcn_s_sleep(1);
    __builtin_amdgcn_fence(__ATOMIC_ACQUIRE, "agent");
    asm volatile("s_waitcnt vmcnt(0) lgkmcnt(0)" ::: "memory");
  }
  __syncthreads();
}
#ifndef MINW
#define MINW 2
#endif
__global__ void __launch_bounds__(256, MINW) fwd_mega(P p) {
  extern __shared__ __attribute__((aligned(16))) unsigned char smem[];
  cg::grid_group grid = cg::this_grid();
  const int tid = threadIdx.x;
  float* X = p.out + O_Y;
  bf16_t* Xb = (bf16_t*)(p.ws + A_XB);
  bf16_t* ACT = (bf16_t*)(p.ws + R_ACT);

#ifndef NO_P0
  unsigned* bar = (unsigned*)(p.ws + W_CTR + 1024);
  unsigned epoch = 0;
  phase0(p, smem);
#endif
  grid.sync();
  gsync(bar, epoch);

#pragma unroll 1
  for (int layer = 0; layer < 2; ++layer) {
#pragma unroll 1
    for (int f = 0; f < 2; ++f) {
      if (f == 1) {
        if (layer == 0) {
#ifndef NO_EVENIN
          gemm_phase(Xb, 1024, (const bf16_t*)(p.ws + W_EVEN_IN), 1024, 29, EpiEvenIn{p}, smem);
#endif
          gsync(bar, epoch);
#ifndef NO_CUM
          if (blockIdx.x < 2) cumsum_prompt(p, blockIdx.x, smem);
#endif
#ifndef NO_PREP
          for (int it = blockIdx.x; it < NPREP; it += gridDim.x) gdn_prep_item(p, it, smem);
#endif
          gsync(bar, epoch);
          {
            unsigned* ctr = (unsigned*)(p.ws + W_CTR);
            int* sh = (int*)(smem + LDS_BYTES - 16);
            for (;;) {
              if (tid == 0) *sh = (int)atomicAdd(ctr, 1u);
              __syncthreads();
              const int it = *sh;
              __syncthreads();
              if (it >= 64 + 256 + 256) break;
              if (it < 64) gdn_scan_chain(p, it, smem);
              else if (it < 64 + 256) attn_sample_item(p, it - 64, smem);
              else gdn_scan_chain(p, 64 + (it - 64 - 256), smem);
            }
            for (int sx = 0; sx < 8; ++sx) {
              const int x = ((blockIdx.x & 7) + sx) & 7;
              for (;;) {
                if (tid == 0) *sh = (int)atomicAdd(ctr + 8 + x, 1u);
                __syncthreads();
                const int it = *sh;
                __syncthreads();
                if (it >= 256) break;
                attn_prompt_item(p, 2 * x + (it & 1), 127 - (it >> 1), smem);
              }
            }
          }
          gsync(bar, epoch);
          gdn_gate_phase(p);
          gsync(bar, epoch);
          gemm_phase((const bf16_t*)(p.ws + R_MIX), 1024, (const bf16_t*)(p.ws + W_EVEN_OUT), 1024, 8, EpiElem<FResidX>{FResidX{X, 1.0f}}, smem);
          gsync(bar, epoch);
        } else {
          gemm_phase(Xb, 1024, (const bf16_t*)(p.ws + W_ODD_IN), 1024, 8, EpiElem<FStoreF32>{FStoreF32{(float*)(p.ws + R_U)}}, smem);
          gsync(bar, epoch);
#ifndef NO_S5
          for (int it = blockIdx.x; it < 2048; it += gridDim.x) if (((it >> 4) & 63) != 63) s5_item<1>(p, it, smem);
#endif
          gsync(bar, epoch);
#ifndef NO_S5
          for (int it = blockIdx.x; it < 2048 + 128; it += gridDim.x) s5_item<2>(p, it, smem);
#endif
          gsync(bar, epoch);
          gemm_phase((const bf16_t*)(p.ws + R_ZZB), 1024, (const bf16_t*)(p.ws + W_GLU), 1024, 8,
                     EpiElem<FGlu>{FGlu{(const bf16_t*)(p.ws + R_ZZB), p.in[30], (bf16_t*)(p.ws + A_GATED)}}, smem);
          gsync(bar, epoch);
          gemm_phase((const bf16_t*)(p.ws + A_GATED), 1024, (const bf16_t*)(p.ws + W_ODD_OUT), 1024, 8, EpiElem<FResid>{FResid{X, Xb, 1.0f}}, smem);
          gsync(bar, epoch);
        }
        ln_phase(X, Xb, p.in[11] + (layer * 3 + 1) * D, p.in[12] + (layer * 3 + 1) * D, true, false);
        gsync(bar, epoch);
      }
      const int idx = layer * 2 + f;
      gemm_phase(Xb, 1024, (const bf16_t*)(p.ws + W_FFN_IN + idx * SZ_FFN_IN), 1024, 44, EpiSwiglu{ACT}, smem);
      gsync(bar, epoch);
      gemm_phase(ACT, DFF, (const bf16_t*)(p.ws + W_FFN_OUT + idx * SZ_FFN_OUT), DFF, 8, EpiElem<FResid>{FResid{X, Xb, 0.5f}}, smem);
      gsync(bar, epoch);
      const bool last = (layer == 1 && f == 1);
      ln_phase(X, Xb, p.in[11] + (layer * 3 + f * 2) * D, p.in[12] + (layer * 3 + f * 2) * D, !last, last || (layer == 0 && f == 0));
      if (!last) gsync(bar, epoch);
    }
  }
}

extern "C" void kernel_launch(void* const* d_in, const int* in_sizes, int n_in, void* d_out, int out_size, void* d_ws, size_t ws_size,
                              hipStream_t stream) {
  static int grid_blocks = 0;
  if (grid_blocks == 0) {
    int dev = 0, cus = 0, per_cu = 0;
    (void)hipGetDevice(&dev);
    (void)hipDeviceGetAttribute(&cus, hipDeviceAttributeMultiprocessorCount, dev);
    if (hipFuncSetAttribute((const void*)fwd_mega, hipFuncAttributeMaxDynamicSharedMemorySize, LDS_BYTES) != hipSuccess) {
      fprintf(stderr, "hipFuncSetAttribute failed\n");
    }
    (void)hipOccupancyMaxActiveBlocksPerMultiprocessor(&per_cu, (const void*)fwd_mega, 256, LDS_BYTES);
    if (per_cu < 1) per_cu = 1;
    if (per_cu > MINW) per_cu = MINW;
    grid_blocks = cus * per_cu;
    if (ws_size < WS_NEED) fprintf(stderr, "workspace too small: %zu < %zu\n", ws_size, (size_t)WS_NEED);
  }
  P p{};
  for (int i = 0; i < 32; ++i) p.in[i] = (const float*)d_in[i];
  p.out = (float*)d_out;
  p.ws = (unsigned char*)d_ws;
  (void)hipMemsetAsync((unsigned char*)d_ws + W_CTR + 1024, 0, 2048, stream);
  void* args[] = {&p};
  hipError_t e = hipLaunchCooperativeKernel((const void*)fwd_mega, dim3(grid_blocks), dim3(256), args, LDS_BYTES, stream);
  if (e != hipSuccess) fprintf(stderr, "cooperative launch failed: %s (grid %d)\n", hipGetErrorString(e), grid_blocks);
}
```

```cpp
#include <hip/hip_runtime.h>
#include <hip/hip_cooperative_groups.h>
#include <cstdio>
#include <cstdint>
namespace cg = cooperative_groups;

typedef unsigned short bf16_t;
typedef short bf16x8 __attribute__((ext_vector_type(8)));
typedef short bf16x4 __attribute__((ext_vector_type(4)));
typedef float f32x4 __attribute__((ext_vector_type(4)));
typedef float f32x2 __attribute__((ext_vector_type(2)));
typedef float f32x16 __attribute__((ext_vector_type(16)));
typedef unsigned u32x4 __attribute__((ext_vector_type(4)));
typedef unsigned u32x2 __attribute__((ext_vector_type(2)));

#define DEV __device__ __forceinline__

constexpr int D = 1024, T = 16384, MP = 32768, MS = 256, M = MP + MS, DFF = 2816;
constexpr int MT = M / 128;
constexpr float ALPHA = 1.41421356237f;
constexpr float LOG2E = 1.44269504089f;
constexpr int LDS_BYTES = 73728;
constexpr int NPREP = 2048 + 32;

constexpr size_t O_Y = 0;
constexpr size_t O_FKP = 33816576, O_FVP = 50593792, O_FLP = 67371008, O_GSP = 67633152, O_GCP = 67764224;
constexpr size_t O_S5RP = 67773440, O_S5IP = 67781632, O_FKS = 67789824, O_FVS = 67920896, O_FLS = 68051968;
constexpr size_t O_GSS = 68054016, O_GCS = 68578304, O_S5RS = 68615168, O_S5IS = 68647936;

constexpr size_t MB = 1u << 20;
constexpr size_t W_FFN_IN = 0;
constexpr size_t SZ_FFN_IN = (size_t)5632 * 1024 * 2;
constexpr size_t W_FFN_OUT = W_FFN_IN + 4 * SZ_FFN_IN;
constexpr size_t SZ_FFN_OUT = (size_t)1024 * 2816 * 2;
constexpr size_t W_EVEN_IN = W_FFN_OUT + 4 * SZ_FFN_OUT;
constexpr size_t W_EVEN_OUT = W_EVEN_IN + (size_t)3712 * 1024 * 2;
constexpr size_t W_ODD_IN = W_EVEN_OUT + 2 * MB;
constexpr size_t W_GLU = W_ODD_IN + 2 * MB;
constexpr size_t W_ODD_OUT = W_GLU + 2 * MB;
constexpr size_t W_S5B = W_ODD_OUT + 2 * MB;
constexpr size_t W_S5C = W_S5B + 262144;
constexpr size_t W_LAMB = W_S5C + 262144;
constexpr size_t W_LAM256 = W_LAMB + 32768;
constexpr size_t W_CTR = W_LAM256 + 32768;
constexpr size_t W_END = W_CTR + 4096;
static_assert(W_END < 90 * MB, "weights region");
constexpr size_t A_XB = 90 * MB;
constexpr size_t SZ_XB = (size_t)M * 1024 * 2;
constexpr size_t A_PW = A_XB;
constexpr size_t A_PQG = A_PW + (size_t)NPREP * 8192 * 2;
constexpr size_t A_PKDT = A_PQG + (size_t)NPREP * 8192 * 2;
constexpr size_t A_PUT = A_PKDT + (size_t)NPREP * 8192 * 2;
constexpr size_t A_PATT = A_PUT + (size_t)NPREP * 8192 * 2;
constexpr size_t A_PGL = A_PATT + (size_t)NPREP * 4096 * 2;
constexpr size_t A_PEND = A_PGL + 16384;
constexpr size_t A_GATED = A_XB + 70 * MB;
static_assert(A_PEND < 90 * MB + 154 * MB, "prep region");
static_assert(A_GATED + SZ_XB < 90 * MB + 154 * MB, "gated region");
constexpr size_t R0 = 244 * MB;
constexpr size_t R_ACT = R0;
constexpr size_t R_MIX = R0;
constexpr size_t R_KB = R_MIX + SZ_XB;
constexpr size_t R_VT = R_KB + (size_t)M * 512 * 2;
constexpr size_t R_GB = R_VT + (size_t)16 * 64 * 16384 * 2;
constexpr size_t R_LOGF = R_GB + (size_t)M * 1536 * 2;
constexpr size_t R_CUM = R_LOGF + (size_t)M * 8 * 4;
constexpr size_t R_GG = R_CUM + (size_t)M * 8 * 4;
constexpr size_t R_BETA = R_GG + (size_t)M * 4 * 4;
constexpr size_t R_QS = R_BETA + (size_t)M * 4 * 4;
constexpr size_t R_EVEN_END = R_QS + (size_t)256 * 512 * 4;
constexpr size_t R_U = R0;
constexpr size_t R_ZZB = R_U + (size_t)M * 1024 * 4;
constexpr size_t R_E = R_ZZB + SZ_XB;
constexpr size_t R_ODD_END = R_E + (size_t)2 * 64 * 4096 * 8;
constexpr size_t WS_NEED = 490 * MB;
static_assert(R_EVEN_END < WS_NEED && R_ODD_END < WS_NEED && R_ACT + (size_t)M * DFF * 2 < WS_NEED, "ws");

struct P {
  const float* in[32];
  float* out;
  unsigned char* ws;
};

DEV int ltid() { int t = threadIdx.x; asm volatile("" : "+v"(t)); return t; }
typedef __bf16 hbf16x2 __attribute__((ext_vector_type(2)));
DEV unsigned pack2(float a, float b) {
  f32x2 v = {a, b};
  hbf16x2 h = __builtin_convertvector(v, hbf16x2);
  return __builtin_bit_cast(unsigned, h);
}
DEV bf16_t f2bf(float f) { return (bf16_t)(pack2(f, 0.f) & 0xffffu); }
DEV float bf2f(bf16_t h) { return __uint_as_float(((unsigned)h) << 16); }
DEV float fexp2(float x) { return __builtin_amdgcn_exp2f(x); }
DEV float frcp(float x) { return __builtin_amdgcn_rcpf(x); }
DEV float silu_f(float x) { return x * frcp(1.f + fexp2(-LOG2E * x)); }
DEV float sigmoid_f(float x) { return frcp(1.f + fexp2(-LOG2E * x)); }
DEV float softplus_f(float x) { return fmaxf(x, 0.f) + log1pf(__expf(-fabsf(x))); }
DEV float gelu_tanh(float x) {
  float u = 0.7978845608028654f * (x + 0.044715f * x * x * x);
  float t = 1.f - 2.f / (1.f + __expf(2.f * u));
  return 0.5f * x * (1.f + t);
}
DEV float wave_sum(float v) {
#pragma unroll
  for (int o = 32; o >= 1; o >>= 1) v += __shfl_xor(v, o);
  return v;
}
DEV float wave_max(float v) {
#pragma unroll
  for (int o = 32; o >= 1; o >>= 1) v = fmaxf(v, __shfl_xor(v, o));
  return v;
}
DEV f32x16 mfma32(bf16x8 a, bf16x8 b, f32x16 c) { return __builtin_amdgcn_mfma_f32_32x32x16_bf16(a, b, c, 0, 0, 0); }
DEV f32x4 mfma16(bf16x8 a, bf16x8 b, f32x4 c) { return __builtin_amdgcn_mfma_f32_16x16x32_bf16(a, b, c, 0, 0, 0); }

struct MapId { DEV int operator()(int n) const { return n; } };
struct MapFfnIn {
  DEV int operator()(int n) const {
    int t = n >> 7, w = n & 127;
    int wn = w >> 6, nt = (w >> 5) & 1, c = w & 31;
    return nt * DFF + t * 64 + wn * 32 + c;
  }
};
struct MapEvenIn {
  DEV int operator()(int n) const {
    if (n < 1536) return n;
    if (n < 3072) return 1544 + (n - 1536);
    if (n < 3584) return 3088 + (n - 3072);
    if (n < 3592) return 1536 + (n - 3584);
    if (n < 3600) return 3080 + (n - 3592);
    return -1;
  }
};

template <class Map>
DEV void conv_t(const float* __restrict__ src, int Nsrc, int K, bf16_t* __restrict__ dst, int Np, Map map, unsigned char* smem) {
  float* tile = (float*)smem;
  const int tid = ltid();
  const int ntn = Np >> 6, ntk = K >> 6;
  for (int t = blockIdx.x; t < ntn * ntk; t += gridDim.x) {
    const int tn = t % ntn, tk = t / ntn;
    {
      const int n4 = (tid & 15) * 4, k0 = tid >> 4;
      const int sc = map(tn * 64 + n4);
#pragma unroll
      for (int i = 0; i < 4; ++i) {
        const int k = k0 + 16 * i;
        f32x4 v = {0.f, 0.f, 0.f, 0.f};
        if (sc >= 0) v = *(const f32x4*)(src + (size_t)(tk * 64 + k) * Nsrc + sc);
        *(f32x4*)(tile + k * 68 + n4) = v;
      }
    }
    __syncthreads();
    {
      const int n = tid >> 2, kq = (tid & 3) * 16;
      u32x4 o0, o1;
#pragma unroll
      for (int j = 0; j < 4; ++j) {
        o0[j] = pack2(tile[(kq + 2 * j) * 68 + n], tile[(kq + 2 * j + 1) * 68 + n]);
        o1[j] = pack2(tile[(kq + 8 + 2 * j) * 68 + n], tile[(kq + 8 + 2 * j + 1) * 68 + n]);
      }
      bf16_t* dp = dst + (size_t)(tn * 64 + n) * K + tk * 64 + kq;
      *(u32x4*)dp = o0;
      *(u32x4*)(dp + 8) = o1;
    }
    __syncthreads();
  }
}

DEV void phase0(const P& p, unsigned char* smem) {
  const int tid = ltid();
  const size_t gt = (size_t)blockIdx.x * 256 + tid, gn = (size_t)gridDim.x * 256;
  {
    bf16_t* Xb = (bf16_t*)(p.ws + A_XB);
    const size_t n4p = (size_t)MP * D / 4, n4 = (size_t)M * D / 4;
    for (size_t i = gt; i < n4; i += gn) {
      f32x4 v = (i < n4p) ? ((const f32x4*)p.in[0])[i] : ((const f32x4*)p.in[1])[i - n4p];
      u32x2 o; o[0] = pack2(v[0], v[1]); o[1] = pack2(v[2], v[3]);
      ((u32x2*)Xb)[i] = o;
    }
  }
  for (int l = 0; l < 2; ++l)
    for (int f = 0; f < 2; ++f) {
      const int idx = l * 2 + f;
      conv_t(p.in[9] + (size_t)idx * 1024 * 5632, 5632, 1024, (bf16_t*)(p.ws + W_FFN_IN + idx * SZ_FFN_IN), 5632, MapFfnIn(), smem);
      conv_t(p.in[10] + (size_t)idx * 2816 * 1024, 1024, 2816, (bf16_t*)(p.ws + W_FFN_OUT + idx * SZ_FFN_OUT), 1024, MapId(), smem);
    }
  conv_t(p.in[13], 3600, 1024, (bf16_t*)(p.ws + W_EVEN_IN), 3712, MapEvenIn(), smem);
  conv_t(p.in[19], 1024, 1024, (bf16_t*)(p.ws + W_EVEN_OUT), 1024, MapId(), smem);
  conv_t(p.in[20], 1024, 1024, (bf16_t*)(p.ws + W_ODD_IN), 1024, MapId(), smem);
  conv_t(p.in[29], 1024, 1024, (bf16_t*)(p.ws + W_GLU), 1024, MapId(), smem);
  conv_t(p.in[31], 1024, 1024, (bf16_t*)(p.ws + W_ODD_OUT), 1024, MapId(), smem);
  if (gt < 4096) {
    const int g = (int)gt >> 6, pp = (int)gt & 63;
    const float step = expf(p.in[23][g]);
    const float lr = p.in[21][gt], li = p.in[22][gt];
    const float a = lr * step, b = li * step;
    const float ea = expf(a);
    float sb, cb; sincosf(b, &sb, &cb);
    const float lbr = ea * cb, lbi = ea * sb;
    const float sh = sinf(0.5f * b);
    const float nr = expm1f(a) * cb - 2.f * sh * sh, ni = lbi;
    const float dd = lr * lr + li * li;
    const float cr = (nr * lr + ni * li) / dd, ci = (ni * lr - nr * li) / dd;
    bf16_t* Bp = (bf16_t*)(p.ws + W_S5B);
    bf16_t* Cp = (bf16_t*)(p.ws + W_S5C);
    for (int c = 0; c < 16; ++c) {
      const float br = p.in[24][gt * 16 + c], bi = p.in[25][gt * 16 + c];
      Bp[((size_t)g * 128 + pp) * 16 + c] = f2bf(cr * br - ci * bi);
      Bp[((size_t)g * 128 + 64 + pp) * 16 + c] = f2bf(cr * bi + ci * br);
      Cp[((size_t)g * 16 + c) * 128 + pp] = f2bf(p.in[26][((size_t)g * 16 + c) * 64 + pp]);
      Cp[((size_t)g * 16 + c) * 128 + 64 + pp] = f2bf(-p.in[27][((size_t)g * 16 + c) * 64 + pp]);
    }
    ((f32x2*)(p.ws + W_LAMB))[gt] = (f32x2){lbr, lbi};
    float xr = lbr, xi = lbi;
    for (int i = 0; i < 8; ++i) { const float nr2 = xr * xr - xi * xi, ni2 = 2.f * xr * xi; xr = nr2; xi = ni2; }
    ((f32x2*)(p.ws + W_LAM256))[gt] = (f32x2){xr, xi};
  }
  if (gt < 64) ((unsigned*)(p.ws + W_CTR))[gt] = 0u;
}

template <class Epi>
DEV void gemm_phase(const bf16_t* __restrict__ A, int lda, const bf16_t* __restrict__ Wt, int K, int NT, Epi epi, unsigned char* smem) {
  const int tid = ltid(), lane = tid & 63, wave = tid >> 6, wm = wave >> 1, wn = wave & 1;
  const int r = lane & 31, hh = lane >> 5;
  bf16_t* As = (bf16_t*)smem;
  bf16_t* Bs = As + 2 * 128 * 72;
  const int nk = K >> 6;
  const int lrow = tid >> 3, lcc = tid & 7;
  const int xcd = blockIdx.x & 7, jx = blockIdx.x >> 3, nb = gridDim.x >> 3;
  const int U = (64 + nb - 1) / nb;
  const int n8 = NT >> 3, remc = NT & 7, has4 = (remc >= 4) ? 1 : 0, rem1 = remc - 4 * has4;
  const int NP = n8 * 32 + has4 * 16 + rem1 * 4;
  const int nPI = (xcd < NP) ? ((NP - xcd + 7) >> 3) * U : 0;
  const int nS = (blockIdx.x < 2 * NT) ? (2 * NT - blockIdx.x + gridDim.x - 1) / gridDim.x : 0;
  for (int w = 0; w < nPI + nS; ++w) {
    int tm, tn;
    if (w < nPI) {
      const int q = xcd + 8 * (w / U), jj = jx + nb * (w % U);
      if (jj >= 64) continue;
      if (q < n8 * 32) { const int c = q >> 5, lp = q & 31; tm = lp * 8 + (jj & 7); tn = c * 8 + (jj >> 3); }
      else {
        const int q2 = q - n8 * 32;
        if (has4 && q2 < 16) { tm = q2 * 16 + (jj & 15); tn = n8 * 8 + (jj >> 4); }
        else { const int q3 = q2 - has4 * 16; tm = (q3 & 3) * 64 + jj; tn = n8 * 8 + has4 * 4 + (q3 >> 2); }
      }
    } else {
      const int sidx = blockIdx.x + (w - nPI) * gridDim.x;
      tm = 256 + (sidx & 1); tn = sidx >> 1;
    }
    const int swz = (((wave & 1) << 2) + (lane >> 4)) & 7;
    const int csrc = ((lane & 7) ^ swz) * 8;
    const bf16_t* Ag = A + (size_t)(tm * 128 + wave * 8 + (lane >> 3)) * lda + csrc;
    const bf16_t* Bg = Wt + (size_t)(tn * 128 + wave * 8 + (lane >> 3)) * K + csrc;
    f32x16 acc[2][2];
#pragma unroll
    for (int i = 0; i < 2; ++i)
#pragma unroll
      for (int j = 0; j < 2; ++j)
#pragma unroll
        for (int q = 0; q < 16; ++q) acc[i][j][q] = 0.f;
    const int rsw = (r >> 1) & 7;
#define G_STAGE(BUF, KT)                                                                                         \
    _Pragma("unroll") for (int i = 0; i < 4; ++i) {                                                             \
      __builtin_amdgcn_global_load_lds((const unsigned*)(Ag + (size_t)(32 * i) * lda + (KT) * 64),               \
                                       (unsigned*)(smem + (BUF) * 32768 + (wave + 4 * i) * 1024), 16, 0, 0);     \
      __builtin_amdgcn_global_load_lds((const unsigned*)(Bg + (size_t)(32 * i) * K + (KT) * 64),                 \
                                       (unsigned*)(smem + (BUF) * 32768 + 16384 + (wave + 4 * i) * 1024), 16, 0, 0); }
#define G_COMPUTE(BUF)                                                                                           \
    _Pragma("unroll") for (int ks = 0; ks < 4; ++ks) {                                                          \
      bf16x8 af[2], bfr[2];                                                                                      \
      const int co = (((2 * ks + hh) ^ rsw) << 4);                                                               \
      _Pragma("unroll") for (int i = 0; i < 2; ++i) {                                                           \
        af[i] = *(const bf16x8*)(smem + (BUF) * 32768 + (wm * 64 + i * 32 + r) * 128 + co);                      \
        bfr[i] = *(const bf16x8*)(smem + (BUF) * 32768 + 16384 + (wn * 64 + i * 32 + r) * 128 + co); }           \
      _Pragma("unroll") for (int i = 0; i < 2; ++i)                                                             \
        _Pragma("unroll") for (int j = 0; j < 2; ++j) acc[i][j] = mfma32(af[i], bfr[j], acc[i][j]); }
    G_STAGE(0, 0)
    asm volatile("s_waitcnt vmcnt(0)" ::: "memory");
    __syncthreads();
    for (int kt = 0; kt < nk; kt += 2) {
      G_STAGE(1, kt + 1)
      G_COMPUTE(0)
      asm volatile("s_waitcnt vmcnt(0)" ::: "memory");
      __syncthreads();
      if (kt + 2 < nk) { G_STAGE(0, kt + 2) }
      G_COMPUTE(1)
      asm volatile("s_waitcnt vmcnt(0)" ::: "memory");
      __syncthreads();
    }
#undef G_STAGE
#undef G_COMPUTE
    epi(acc, tm * 128 + wm * 64, tn, wn, lane);
    __syncthreads();
  }
}

struct EpiSwiglu {
  bf16_t* act;
  DEV void operator()(const f32x16 (&acc)[2][2], int row0, int tn, int wn, int lane) const {
    const int r = lane & 31, hh = lane >> 5;
    const int col = tn * 64 + wn * 32 + r;
#pragma unroll
    for (int mt = 0; mt < 2; ++mt)
#pragma unroll
      for (int q = 0; q < 16; ++q) {
        const int row = row0 + mt * 32 + (q & 3) + 8 * (q >> 2) + 4 * hh;
        const float a = acc[mt][0][q], b = acc[mt][1][q];
        act[(size_t)row * DFF + col] = f2bf(silu_f(a) * b);
      }
  }
};
template <class F>
struct EpiElem {
  F f;
  DEV void operator()(const f32x16 (&acc)[2][2], int row0, int tn, int wn, int lane) const {
    const int r = lane & 31, hh = lane >> 5;
#pragma unroll
    for (int mt = 0; mt < 2; ++mt)
#pragma unroll
      for (int nt = 0; nt < 2; ++nt)
#pragma unroll
        for (int q = 0; q < 16; ++q) {
          const int row = row0 + mt * 32 + (q & 3) + 8 * (q >> 2) + 4 * hh;
          const int col = tn * 128 + wn * 64 + nt * 32 + r;
          f(row, col, acc[mt][nt][q]);
        }
  }
};
struct FResidX {
  const float* X; bf16_t* Xb; float scale;
  DEV void operator()(int row, int col, float v) const {
    const size_t i = (size_t)row * D + col;
    Xb[i] = f2bf(ALPHA * X[i] + scale * v);
  }
};
struct FResid {
  bf16_t* Xb; float scale;
  DEV void operator()(int row, int col, float v) const {
    const size_t i = (size_t)row * D + col;
    Xb[i] = f2bf(ALPHA * bf2f(Xb[i]) + scale * v);
  }
};
struct FStoreF32 {
  float* U;
  DEV void operator()(int row, int col, float v) const { U[(size_t)row * D + col] = v; }
};
struct FGlu {
  const bf16_t* zz; const float* bias; bf16_t* out;
  DEV void operator()(int row, int col, float v) const {
    const size_t i = (size_t)row * D + col;
    out[i] = f2bf(bf2f(zz[i]) * sigmoid_f(v + bias[col]));
  }
};
#define EACH_TILE(FN) FN(acc[0][0], 0, 0); FN(acc[0][1], 0, 1); FN(acc[1][0], 1, 0); FN(acc[1][1], 1, 1);
struct EpiEvenIn {
  P p;
  DEV void operator()(const f32x16 (&acc)[2][2], int row0, int tn, int wn, int lane) const {
    const int r = lane & 31, hh = lane >> 5;
    const bool samp = row0 >= MP;
    const int clb = wn * 64 + r;
    if (tn < 4) {
      bf16_t* MIX = (bf16_t*)(p.ws + R_MIX);
      float* QS = (float*)(p.ws + R_QS);
      auto fn = [&](const f32x16& a, int mt, int nt) {
        const int col = tn * 128 + clb + nt * 32;
#pragma unroll
        for (int q = 0; q < 16; ++q) {
          const int row = row0 + mt * 32 + (q & 3) + 8 * (q >> 2) + 4 * hh;
          MIX[(size_t)row * 1024 + col] = f2bf(a[q]);
          if (samp) QS[(size_t)(row - MP) * 512 + col] = a[q];
        }
      };
      EACH_TILE(fn)
    } else if (tn < 8) {
      bf16_t* KB = (bf16_t*)(p.ws + R_KB);
      float* ok = samp ? (p.out + O_FKS - (size_t)MP * 512) : (p.out + O_FKP);
      auto fn = [&](const f32x16& a, int mt, int nt) {
        const int col = (tn - 4) * 128 + clb + nt * 32;
#pragma unroll
        for (int q = 0; q < 16; ++q) {
          const int row = row0 + mt * 32 + (q & 3) + 8 * (q >> 2) + 4 * hh;
          KB[(size_t)row * 512 + col] = f2bf(a[q]);
          ok[(size_t)row * 512 + col] = a[q];
        }
      };
      EACH_TILE(fn)
    } else if (tn < 12) {
      if (!samp) {
        bf16_t* VT = (bf16_t*)(p.ws + R_VT);
        auto fn = [&](const f32x16& a, int mt, int nt) {
          const int col = (tn - 8) * 128 + clb + nt * 32;
          const int hd = col >> 6, dh = col & 63;
#pragma unroll
          for (int g = 0; g < 4; ++g) {
            const int row = row0 + mt * 32 + 8 * g + 4 * hh;
            const int b = row >> 14, tt = row & (T - 1);
            u32x2 o; o[0] = pack2(a[4 * g], a[4 * g + 1]); o[1] = pack2(a[4 * g + 2], a[4 * g + 3]);
            *(u32x2*)(VT + ((size_t)(b * 8 + hd) * 64 + dh) * T + tt) = o;
#pragma unroll
            for (int e = 0; e < 4; ++e) p.out[O_FVP + (size_t)(row + e) * 512 + col] = a[4 * g + e];
          }
        };
        EACH_TILE(fn)
      } else {
        auto fn = [&](const f32x16& a, int mt, int nt) {
          const int col = (tn - 8) * 128 + clb + nt * 32;
#pragma unroll
          for (int q = 0; q < 16; ++q) {
            const int row = row0 + mt * 32 + (q & 3) + 8 * (q >> 2) + 4 * hh;
            p.out[O_FVS + (size_t)(row - MP) * 512 + col] = a[q];
          }
        };
        EACH_TILE(fn)
      }
    } else if (tn < 24) {
      bf16_t* GB = (bf16_t*)(p.ws + R_GB);
      auto fn = [&](const f32x16& a, int mt, int nt) {
        const int col = (tn - 12) * 128 + clb + nt * 32;
#pragma unroll
        for (int q = 0; q < 16; ++q) {
          const int row = row0 + mt * 32 + (q & 3) + 8 * (q >> 2) + 4 * hh;
          const float v = a[q];
          GB[(size_t)row * 1536 + col] = f2bf(v);
          if (!samp) {
            const int tt = row & (T - 1);
            if (tt >= T - 3) p.out[O_GCP + (size_t)((row >> 14) * 3 + (tt - (T - 3))) * 1536 + col] = v;
          } else {
            const int tt = (row - MP) & 31;
            if (tt >= 29) p.out[O_GCS + (size_t)(((row - MP) >> 5) * 3 + (tt - 29)) * 1536 + col] = v;
          }
        }
      };
      EACH_TILE(fn)
    } else if (tn < 28) {
      bf16_t* MIX = (bf16_t*)(p.ws + R_MIX);
      auto fn = [&](const f32x16& a, int mt, int nt) {
        const int col = (tn - 24) * 128 + clb + nt * 32;
#pragma unroll
        for (int q = 0; q < 16; ++q) {
          const int row = row0 + mt * 32 + (q & 3) + 8 * (q >> 2) + 4 * hh;
          MIX[(size_t)row * 1024 + 512 + col] = f2bf(a[q]);
        }
      };
      EACH_TILE(fn)
    } else {
      float* LOGF = (float*)(p.ws + R_LOGF);
      float* GG = (float*)(p.ws + R_GG);
      float* BETA = (float*)(p.ws + R_BETA);
      if (wn == 0 && r < 16) {
        const int cl = r;
        float* ol = samp ? (p.out + O_FLS - (size_t)MP * 8) : (p.out + O_FLP);
        const float bias = (cl < 8) ? p.in[14][cl] : ((cl < 12) ? p.in[17][cl - 8] : 0.f);
        const float ea = (cl >= 8 && cl < 12) ? __expf(p.in[16][cl - 8]) : 0.f;
        auto fn = [&](const f32x16& a, int mt, int nt) {
          if (nt == 0) {
#pragma unroll
            for (int q = 0; q < 16; ++q) {
              const int row = row0 + mt * 32 + (q & 3) + 8 * (q >> 2) + 4 * hh;
              const float v = a[q];
              if (cl < 8) {
                const float lf = -softplus_f(-(v + bias));
                LOGF[(size_t)row * 8 + cl] = lf;
                ol[(size_t)row * 8 + cl] = lf;
              } else if (cl < 12) {
                GG[(size_t)row * 4 + (cl - 8)] = -ea * softplus_f(v + bias);
              } else {
                BETA[(size_t)row * 4 + (cl - 12)] = sigmoid_f(v);
              }
            }
          }
        };
        EACH_TILE(fn)
      }
    }
  }
};

DEV void ln_phase(float* __restrict__ X, bf16_t* __restrict__ Xb, const float* __restrict__ g, const float* __restrict__ b, bool write_bf, bool write_x) {
  const int tid_ = ltid();
  const int lane = tid_ & 63, wave = tid_ >> 6;
  const int gw = blockIdx.x * 4 + wave, nw = gridDim.x * 4;
  f32x4 gv[4], bv[4];
#pragma unroll
  for (int h = 0; h < 2; ++h)
#pragma unroll
    for (int q = 0; q < 2; ++q) {
      gv[h * 2 + q] = *(const f32x4*)(g + h * 512 + lane * 8 + q * 4);
      bv[h * 2 + q] = *(const f32x4*)(b + h * 512 + lane * 8 + q * 4);
    }
  for (int row = gw; row < M; row += nw) {
    bf16_t* xb = Xb + (size_t)row * D;
    f32x4 v[4];
    float s = 0.f;
#pragma unroll
    for (int h = 0; h < 2; ++h) {
      const u32x4 raw = *(const u32x4*)(xb + h * 512 + lane * 8);
#pragma unroll
      for (int q = 0; q < 2; ++q) {
        f32x4 t;
        t[0] = __uint_as_float(raw[2 * q] << 16); t[1] = __uint_as_float(raw[2 * q] & 0xffff0000u);
        t[2] = __uint_as_float(raw[2 * q + 1] << 16); t[3] = __uint_as_float(raw[2 * q + 1] & 0xffff0000u);
        v[h * 2 + q] = t;
        s += (t[0] + t[1]) + (t[2] + t[3]);
      }
    }
    const float mu = wave_sum(s) * (1.f / D);
    float qq = 0.f;
#pragma unroll
    for (int i = 0; i < 4; ++i) { v[i] = v[i] - mu; qq += (v[i][0] * v[i][0] + v[i][1] * v[i][1]) + (v[i][2] * v[i][2] + v[i][3] * v[i][3]); }
    const float rs = rsqrtf(wave_sum(qq) * (1.f / D) + 1e-5f);
#pragma unroll
    for (int h = 0; h < 2; ++h) {
      const f32x4 o0 = v[h * 2] * rs * gv[h * 2] + bv[h * 2];
      const f32x4 o1 = v[h * 2 + 1] * rs * gv[h * 2 + 1] + bv[h * 2 + 1];
      if (write_x) {
        float* xr = X + (size_t)row * D + h * 512 + lane * 8;
        *(f32x4*)xr = o0; *(f32x4*)(xr + 4) = o1;
      }
      if (write_bf) {
        u32x4 pk; pk[0] = pack2(o0[0], o0[1]); pk[1] = pack2(o0[2], o0[3]); pk[2] = pack2(o1[0], o1[1]); pk[3] = pack2(o1[2], o1[3]);
        *(u32x4*)(xb + h * 512 + lane * 8) = pk;
      }
    }
  }
}

DEV void cumsum_prompt(const P& p, int b, unsigned char* smem) {
  const float* LOGF = (const float*)(p.ws + R_LOGF) + (size_t)b * T * 8;
  float* CUM = (float*)(p.ws + R_CUM) + (size_t)b * T * 8;
  float* tot = (float*)smem;
  const int tid = ltid();
  float s[8];
#pragma unroll
  for (int h = 0; h < 8; ++h) s[h] = 0.f;
  for (int i = 0; i < 64; ++i) {
    const f32x4* r = (const f32x4*)(LOGF + (size_t)(tid * 64 + i) * 8);
    f32x4 a = r[0], c = r[1];
    s[0] += a[0]; s[1] += a[1]; s[2] += a[2]; s[3] += a[3]; s[4] += c[0]; s[5] += c[1]; s[6] += c[2]; s[7] += c[3];
  }
#pragma unroll
  for (int h = 0; h < 8; ++h) tot[tid * 8 + h] = s[h];
  __syncthreads();
  if (tid < 8) {
    float run = 0.f;
    for (int i = 0; i < 256; ++i) { const float v = tot[i * 8 + tid]; tot[i * 8 + tid] = run; run += v; }
  }
  __syncthreads();
#pragma unroll
  for (int h = 0; h < 8; ++h) s[h] = tot[tid * 8 + h];
  for (int i = 0; i < 64; ++i) {
    const f32x4* r = (const f32x4*)(LOGF + (size_t)(tid * 64 + i) * 8);
    f32x4 a = r[0], c = r[1];
    s[0] += a[0]; s[1] += a[1]; s[2] += a[2]; s[3] += a[3]; s[4] += c[0]; s[5] += c[1]; s[6] += c[2]; s[7] += c[3];
    f32x4* w = (f32x4*)(CUM + (size_t)(tid * 64 + i) * 8);
    w[0] = (f32x4){s[0], s[1], s[2], s[3]};
    w[1] = (f32x4){s[4], s[5], s[6], s[7]};
  }
  __syncthreads();
}

DEV void gdn_prep_item(const P& p, int item, unsigned char* smem) {
  const int tid = ltid(), lane = tid & 63, wave = tid >> 6;
  float* Kf = (float*)smem;
  float* Qf = Kf + 64 * 132;
  float* gc = Qf + 64 * 132;
  float* bt = gc + 64;
  float* eg = bt + 64;
  float* rk = eg + 64;
  float* rq = rk + 64;
  const bf16_t* GB = (const bf16_t*)(p.ws + R_GB);
  const float* GG = (const float*)(p.ws + R_GG);
  const float* BETA = (const float*)(p.ws + R_BETA);
  const float* cw = p.in[15];
  const bool samp = item >= 2048;
  const int h = item & 3;
  int row0, L; bool has_prev; const float* cbuf = nullptr;
  if (!samp) { const int chunk = (item >> 2) & 255, b = item >> 10; row0 = b * T + chunk * 64; L = 64; has_prev = chunk > 0; }
  else { const int sb = (item - 2048) >> 2; row0 = MP + sb * 32; L = 32; has_prev = false; cbuf = p.in[6] + (size_t)sb * 3 * 1536; }
  auto getx = [&](int i, int colg) -> float {
    if (i >= 0) return (i < L) ? bf2f(GB[(size_t)(row0 + i) * 1536 + colg]) : 0.f;
    if (samp) return cbuf[(3 + i) * 1536 + colg];
    return has_prev ? bf2f(GB[(size_t)(row0 + i) * 1536 + colg]) : 0.f;
  };
  const int c = tid & 127;
  const int half = tid >> 7;
  {
    const int colk = 512 + h * 128 + c, colq = h * 128 + c;
    const float k0 = cw[colk], k1 = cw[1536 + colk], k2 = cw[2 * 1536 + colk], k3 = cw[3 * 1536 + colk];
    const float q0 = cw[colq], q1 = cw[1536 + colq], q2 = cw[2 * 1536 + colq], q3 = cw[3 * 1536 + colq];
    const int i0 = half * 32;
    float a3 = getx(i0 - 3, colk), a2 = getx(i0 - 2, colk), a1 = getx(i0 - 1, colk);
    float b3 = getx(i0 - 3, colq), b2 = getx(i0 - 2, colq), b1 = getx(i0 - 1, colq);
#pragma unroll 8
    for (int ii = 0; ii < 32; ++ii) {
      const int i = i0 + ii;
      const float xa = getx(i, colk), xb = getx(i, colq);
      float ya = k0 * a3 + k1 * a2 + k2 * a1 + k3 * xa;
      float yb = q0 * b3 + q1 * b2 + q2 * b1 + q3 * xb;
      ya = (i < L) ? silu_f(ya) : 0.f;
      yb = (i < L) ? silu_f(yb) : 0.f;
      Kf[i * 132 + c] = ya;
      Qf[i * 132 + c] = yb;
      a3 = a2; a2 = a1; a1 = xa;
      b3 = b2; b2 = b1; b1 = xb;
    }
  }
  __syncthreads();
  for (int i = wave * 16; i < wave * 16 + 16; ++i) {
    const float a0 = Kf[i * 132 + lane], a1 = Kf[i * 132 + 64 + lane];
    const float sk = wave_sum(a0 * a0 + a1 * a1);
    const float b0 = Qf[i * 132 + lane], b1 = Qf[i * 132 + 64 + lane];
    const float sq = wave_sum(b0 * b0 + b1 * b1);
    if (lane == 0) { rk[i] = rsqrtf(sk + 1e-6f); rq[i] = rsqrtf(sq + 1e-6f) * 0.08838834764831845f; }
  }
  if (wave == 0) {
    float gi = (lane < L) ? GG[(size_t)(row0 + lane) * 4 + h] : 0.f;
    const float bi = (lane < L) ? BETA[(size_t)(row0 + lane) * 4 + h] : 0.f;
#pragma unroll
    for (int o = 1; o < 64; o <<= 1) { const float tt = __shfl_up(gi, o); if (lane >= o) gi += tt; }
    gc[lane] = gi; eg[lane] = __expf(gi); bt[lane] = bi;
  }
  __syncthreads();
  {
#pragma unroll 4
    for (int ii = 0; ii < 32; ++ii) {
      const int i = half * 32 + ii;
      Kf[i * 132 + c] *= rk[i];
      Qf[i * 132 + c] *= rq[i];
    }
  }
  __syncthreads();
  bf16_t* PW = (bf16_t*)(p.ws + A_PW) + (size_t)item * 8192;
  bf16_t* PQG = (bf16_t*)(p.ws + A_PQG) + (size_t)item * 8192;
  bf16_t* PKDT = (bf16_t*)(p.ws + A_PKDT) + (size_t)item * 8192;
  bf16_t* PUT = (bf16_t*)(p.ws + A_PUT) + (size_t)item * 8192;
  bf16_t* PATT = (bf16_t*)(p.ws + A_PATT) + (size_t)item * 4096;
  float* PGL = (float*)(p.ws + A_PGL);
  const float gl = gc[63];
  {
#pragma unroll 4
    for (int ii = 0; ii < 32; ++ii) {
      const int i = half * 32 + ii;
      PQG[i * 128 + c] = f2bf(Qf[i * 132 + c] * eg[i]);
    }
#pragma unroll
    for (int j8 = 0; j8 < 4; ++j8) {
      const int j0 = half * 32 + j8 * 8;
      float e[8];
#pragma unroll
      for (int t = 0; t < 8; ++t) e[t] = Kf[(j0 + t) * 132 + c] * __expf(gl - gc[j0 + t]);
      u32x4 o;
      o[0] = pack2(e[0], e[1]); o[1] = pack2(e[2], e[3]); o[2] = pack2(e[4], e[5]); o[3] = pack2(e[6], e[7]);
      *(u32x4*)(PKDT + c * 64 + j0) = o;
    }
    if (tid == 0) PGL[item] = __expf(gl);
  }
  const int ti = tid >> 4, tj = tid & 15;
  {
    float accA[4][4], accN[4][4];
#pragma unroll
    for (int a = 0; a < 4; ++a)
#pragma unroll
      for (int b = 0; b < 4; ++b) { accA[a][b] = 0.f; accN[a][b] = 0.f; }
#pragma unroll 2
    for (int cc = 0; cc < 128; cc += 4) {
      f32x4 qi[4], ki[4], kj[4];
#pragma unroll
      for (int a = 0; a < 4; ++a) {
        qi[a] = *(const f32x4*)(Qf + (ti + 16 * a) * 132 + cc);
        ki[a] = *(const f32x4*)(Kf + (ti + 16 * a) * 132 + cc);
        kj[a] = *(const f32x4*)(Kf + (tj + 16 * a) * 132 + cc);
      }
#pragma unroll
      for (int a = 0; a < 4; ++a)
#pragma unroll
        for (int b = 0; b < 4; ++b) {
          accA[a][b] += qi[a][0] * kj[b][0] + qi[a][1] * kj[b][1] + qi[a][2] * kj[b][2] + qi[a][3] * kj[b][3];
          accN[a][b] += ki[a][0] * kj[b][0] + ki[a][1] * kj[b][1] + ki[a][2] * kj[b][2] + ki[a][3] * kj[b][3];
        }
    }
    __syncthreads();
    float* Nl = Qf;
#pragma unroll
    for (int a = 0; a < 4; ++a)
#pragma unroll
      for (int b = 0; b < 4; ++b) {
        const int i = ti + 16 * a, j = tj + 16 * b;
        const float dec = (j <= i) ? __expf(gc[i] - gc[j]) : 0.f;
        PATT[i * 64 + j] = f2bf((j <= i) ? accA[a][b] * dec : 0.f);
        Nl[i * 68 + j] = (j < i) ? accN[a][b] * bt[i] * dec : 0.f;
      }
  }
  __syncthreads();
  {
    const float* Nl = Qf;
    float col[64];
    if (tid < 128) {
      const int colg = 1024 + h * 128 + c;
      const float w0 = cw[colg], w1 = cw[1536 + colg], w2 = cw[2 * 1536 + colg], w3 = cw[3 * 1536 + colg];
      float x3 = getx(-3, colg), x2 = getx(-2, colg), x1 = getx(-1, colg);
#pragma unroll
      for (int i = 0; i < 64; ++i) {
        const float x = getx(i, colg);
        float y = w0 * x3 + w1 * x2 + w2 * x1 + w3 * x;
        y = (i < L) ? silu_f(y) : 0.f;
        col[i] = y * bt[i];
        x3 = x2; x2 = x1; x1 = x;
      }
    } else {
#pragma unroll
      for (int i = 0; i < 64; ++i) col[i] = Kf[i * 132 + c] * bt[i] * eg[i];
    }
#pragma unroll
    for (int i = 1; i < 64; ++i) {
      float sacc = 0.f;
#pragma unroll
      for (int j4 = 0; j4 < (i + 3) / 4; ++j4) {
        const f32x4 nv = *(const f32x4*)(Nl + i * 68 + j4 * 4);
#pragma unroll
        for (int e = 0; e < 4; ++e)
          if (j4 * 4 + e < i) sacc += nv[e] * col[j4 * 4 + e];
      }
      col[i] -= sacc;
    }
    if (tid < 128) {
#pragma unroll
      for (int j8 = 0; j8 < 8; ++j8) {
        u32x4 o;
        o[0] = pack2(col[j8 * 8 + 0], col[j8 * 8 + 1]); o[1] = pack2(col[j8 * 8 + 2], col[j8 * 8 + 3]);
        o[2] = pack2(col[j8 * 8 + 4], col[j8 * 8 + 5]); o[3] = pack2(col[j8 * 8 + 6], col[j8 * 8 + 7]);
        *(u32x4*)(PUT + c * 64 + j8 * 8) = o;
      }
    } else {
#pragma unroll
      for (int i = 0; i < 64; ++i) PW[i * 128 + c] = f2bf(col[i]);
    }
  }
  __syncthreads();
}

struct GdnFr { bf16x8 w[4], qg[4], att[2], kd[2][2]; u32x2 u; float gl; };
DEV void gdn_load(GdnFr& f, const P& p, int item, int sl, int wave, int lane) {
  const int r16 = lane & 15, q4 = lane >> 4;
  const bf16_t* PW = (const bf16_t*)(p.ws + A_PW) + (size_t)item * 8192;
  const bf16_t* PQG = (const bf16_t*)(p.ws + A_PQG) + (size_t)item * 8192;
  const bf16_t* PKDT = (const bf16_t*)(p.ws + A_PKDT) + (size_t)item * 8192;
  const bf16_t* PUT = (const bf16_t*)(p.ws + A_PUT) + (size_t)item * 8192;
  const bf16_t* PATT = (const bf16_t*)(p.ws + A_PATT) + (size_t)item * 4096;
#pragma unroll
  for (int ks = 0; ks < 4; ++ks) {
    f.w[ks] = *(const bf16x8*)(PW + (wave * 16 + r16) * 128 + ks * 32 + q4 * 8);
    f.qg[ks] = *(const bf16x8*)(PQG + (wave * 16 + r16) * 128 + ks * 32 + q4 * 8);
  }
#pragma unroll
  for (int ks = 0; ks < 2; ++ks) {
    f.att[ks] = *(const bf16x8*)(PATT + (wave * 16 + r16) * 64 + ks * 32 + q4 * 8);
#pragma unroll
    for (int mt = 0; mt < 2; ++mt) f.kd[mt][ks] = *(const bf16x8*)(PKDT + (wave * 32 + mt * 16 + r16) * 64 + ks * 32 + q4 * 8);
  }
  f.u = *(const u32x2*)(PUT + (sl * 16 + r16) * 64 + wave * 16 + q4 * 4);
  f.gl = ((const float*)(p.ws + A_PGL))[item];
}

DEV void gdn_scan_chain(const P& p, int chain, unsigned char* smem) {
  const int tid = ltid(), lane = tid & 63, wave = tid >> 6;
  const int r16 = lane & 15, q4 = lane >> 4;
  bf16_t* Sb = (bf16_t*)smem;
  bf16_t* Vn = Sb + 16 * 136;
  float* ORAW = (float*)(p.ws + R_GB);
  int sl, h, nchunks, item0, rowbase, nvalid; float* sout; const float* s0 = nullptr;
  if (chain < 64) { sl = chain & 7; h = (chain >> 3) & 3; const int b = chain >> 5; nchunks = 256; item0 = b * 1024 + h; rowbase = b * T; nvalid = 64;
    sout = p.out + O_GSP + (size_t)(b * 4 + h) * 16384; }
  else { const int cs = chain - 64; sl = cs & 7; h = (cs >> 3) & 3; const int sb = cs >> 5; nchunks = 1; item0 = 2048 + sb * 4 + h; rowbase = MP + sb * 32; nvalid = 32;
    sout = p.out + O_GSS + (size_t)(sb * 4 + h) * 16384; s0 = p.in[5] + (size_t)(sb * 4 + h) * 16384; }
  f32x4 S[2];
#pragma unroll
  for (int mt = 0; mt < 2; ++mt)
#pragma unroll
    for (int e = 0; e < 4; ++e) S[mt][e] = s0 ? s0[(size_t)(wave * 32 + mt * 16 + q4 * 4 + e) * 128 + sl * 16 + r16] : 0.f;
#pragma unroll
  for (int mt = 0; mt < 2; ++mt) {
    u32x2 o; o[0] = pack2(S[mt][0], S[mt][1]); o[1] = pack2(S[mt][2], S[mt][3]);
    *(u32x2*)(Sb + r16 * 136 + wave * 32 + mt * 16 + q4 * 4) = o;
  }
  __builtin_amdgcn_s_setprio(3);
  GdnFr cur, nxt;
  gdn_load(cur, p, item0, sl, wave, lane);
  __syncthreads();
  for (int ch = 0; ch < nchunks; ++ch) {
    if (ch + 1 < nchunks) gdn_load(nxt, p, item0 + (ch + 1) * 4, sl, wave, lane);
    f32x4 ws = {0.f, 0.f, 0.f, 0.f}, ws2 = {0.f, 0.f, 0.f, 0.f}, qs = {0.f, 0.f, 0.f, 0.f}, qs2 = {0.f, 0.f, 0.f, 0.f};
    {
      bf16x8 sf[4];
#pragma unroll
      for (int ks = 0; ks < 4; ++ks) sf[ks] = *(const bf16x8*)(Sb + r16 * 136 + ks * 32 + q4 * 8);
      ws = mfma16(cur.w[0], sf[0], ws);
      ws2 = mfma16(cur.w[1], sf[1], ws2);
      ws = mfma16(cur.w[2], sf[2], ws);
      ws2 = mfma16(cur.w[3], sf[3], ws2);
      qs = mfma16(cur.qg[0], sf[0], qs);
      qs2 = mfma16(cur.qg[1], sf[1], qs2);
      qs = mfma16(cur.qg[2], sf[2], qs);
      qs2 = mfma16(cur.qg[3], sf[3], qs2);
    }
    ws = ws + ws2;
    qs = qs + qs2;
    f32x4 vn;
    vn[0] = bf2f((bf16_t)(cur.u[0] & 0xffff)) - ws[0];
    vn[1] = bf2f((bf16_t)(cur.u[0] >> 16)) - ws[1];
    vn[2] = bf2f((bf16_t)(cur.u[1] & 0xffff)) - ws[2];
    vn[3] = bf2f((bf16_t)(cur.u[1] >> 16)) - ws[3];
    {
      u32x2 o; o[0] = pack2(vn[0], vn[1]); o[1] = pack2(vn[2], vn[3]);
      *(u32x2*)(Vn + r16 * 72 + wave * 16 + q4 * 4) = o;
    }
    __syncthreads();
    bf16x8 vf[2];
#pragma unroll
    for (int ks = 0; ks < 2; ++ks) vf[ks] = *(const bf16x8*)(Vn + r16 * 72 + ks * 32 + q4 * 8);
#pragma unroll
    for (int ks = 0; ks < 2; ++ks) qs = mfma16(cur.att[ks], vf[ks], qs);
#pragma unroll
    for (int e = 0; e < 4; ++e) {
      const int i = wave * 16 + q4 * 4 + e;
      if (i < nvalid) ORAW[(size_t)(rowbase + ch * 64 + i) * 512 + h * 128 + sl * 16 + r16] = qs[e];
    }
#pragma unroll
    for (int mt = 0; mt < 2; ++mt) {
      f32x4 sn = S[mt] * cur.gl;
#pragma unroll
      for (int ks = 0; ks < 2; ++ks) sn = mfma16(cur.kd[mt][ks], vf[ks], sn);
      S[mt] = sn;
      u32x2 o; o[0] = pack2(sn[0], sn[1]); o[1] = pack2(sn[2], sn[3]);
      *(u32x2*)(Sb + r16 * 136 + wave * 32 + mt * 16 + q4 * 4) = o;
    }
    __syncthreads();
    if (ch + 1 < nchunks) cur = nxt;
  }
#pragma unroll
  for (int mt = 0; mt < 2; ++mt)
#pragma unroll
    for (int e = 0; e < 4; ++e) sout[(size_t)(wave * 32 + mt * 16 + q4 * 4 + e) * 128 + sl * 16 + r16] = S[mt][e];
  __builtin_amdgcn_s_setprio(0);
  __syncthreads();
}

struct TagTrue { static constexpr bool value = true; };
struct TagFalse { static constexpr bool value = false; };
DEV void attn_prompt_item(const P& p, int bh, int qb, unsigned char* smem) {
  const int tid = ltid(), lane = tid & 63, wave = tid >> 6;
  const int r = lane & 31, hh = lane >> 5;
  const int b = bh >> 3, hd = bh & 7;
  bf16_t* Ks = (bf16_t*)smem;
  bf16_t* Vs = Ks + 2 * 64 * 72;
  float* Bi = (float*)(Vs + 2 * 64 * 72);
  bf16_t* MIX = (bf16_t*)(p.ws + R_MIX);
  const bf16_t* KB = (const bf16_t*)(p.ws + R_KB);
  const bf16_t* VT = (const bf16_t*)(p.ws + R_VT);
  const float* CUM = (const float*)(p.ws + R_CUM);
  const int qpos = qb * 128 + wave * 32 + r;
  const size_t qrow = (size_t)b * T + qpos;
  bf16x8 qf[4];
#pragma unroll
  for (int ks = 0; ks < 4; ++ks) qf[ks] = *(const bf16x8*)(MIX + qrow * 1024 + hd * 64 + ks * 16 + hh * 8);
  f32x16 o[2];
#pragma unroll
  for (int dt = 0; dt < 2; ++dt)
#pragma unroll
    for (int q = 0; q < 16; ++q) o[dt][q] = 0.f;
  float m = -INFINITY, moff = 0.f, lsum = 0.f;
  const int nkt = qb * 2 + 2;
  const int lrow = tid >> 3, lcc = tid & 7;
  const bf16_t* Kg = KB + ((size_t)b * T + lrow) * 512 + hd * 64 + lcc * 8;
  const bf16_t* Vg = VT + ((size_t)bh * 64 + lrow) * T + lcc * 8;
  const int qlast = qb * 128 + wave * 32 + 31, qfirst = qb * 128 + wave * 32;
  constexpr float SC = 0.125f * LOG2E, RSC = 1.f / SC;
  auto tile_body = [&](const bf16_t* ks_, const bf16_t* vs_, const float* bi_, int kt, auto masked_tag) {
    constexpr bool MASKED = decltype(masked_tag)::value;
    f32x16 s[2];
    f32x4 bbv[2][4];
#pragma unroll
    for (int k2 = 0; k2 < 2; ++k2)
#pragma unroll
      for (int g = 0; g < 4; ++g) bbv[k2][g] = *(const f32x4*)(bi_ + 32 * k2 + 8 * g + 4 * hh);
    __builtin_amdgcn_sched_barrier(0);
    const float sinit = -moff * RSC;
#pragma unroll
    for (int k2 = 0; k2 < 2; ++k2) {
#pragma unroll
      for (int q = 0; q < 16; ++q) s[k2][q] = sinit;
#pragma unroll
      for (int ks = 0; ks < 4; ++ks) {
        const bf16x8 kf = *(const bf16x8*)(ks_ + (32 * k2 + r) * 72 + ks * 16 + hh * 8);
        s[k2] = mfma32(kf, qf[ks], s[k2]);
      }
    }
    float mx = -INFINITY;
#pragma unroll
    for (int k2 = 0; k2 < 2; ++k2)
#pragma unroll
      for (int g = 0; g < 4; ++g) {
        const f32x4 bb = bbv[k2][g];
#pragma unroll
        for (int e = 0; e < 4; ++e) {
          float tv = s[k2][4 * g + e] * SC + bb[e];
          if (MASKED) { const int key = kt * 64 + 32 * k2 + 8 * g + 4 * hh + e; if (key > qpos) tv = -INFINITY; }
          s[k2][4 * g + e] = tv;
          mx = fmaxf(mx, tv);
        }
      }
    mx = fmaxf(mx, __shfl_xor(mx, 32));
    float ps = 0.f;
    bf16x8 pb[2][2];
    auto make_p = [&](float sub, auto sub_tag) {
      constexpr bool SUB = decltype(sub_tag)::value;
#pragma unroll
      for (int k2 = 0; k2 < 2; ++k2)
#pragma unroll
        for (int s2 = 0; s2 < 2; ++s2) {
          u32x4 pk;
#pragma unroll
          for (int j = 0; j < 4; ++j) {
            float x0 = s[k2][8 * s2 + 2 * j], x1 = s[k2][8 * s2 + 2 * j + 1];
            if (SUB) { x0 -= sub; x1 -= sub; }
            const float p0 = fexp2(x0), p1 = fexp2(x1);
            ps += p0 + p1;
            pk[j] = pack2(p0, p1);
          }
          pb[k2][s2] = __builtin_bit_cast(bf16x8, pk);
        }
    };
    if (__builtin_amdgcn_ballot_w64(mx + moff > m + 8.f) != 0ull) {
      const float mnew = fmaxf(m, mx + moff);
      const float alpha = fexp2(m - mnew);
      m = mnew;
      lsum *= alpha;
#pragma unroll
      for (int dt = 0; dt < 2; ++dt) o[dt] = o[dt] * alpha;
      const float sub = mnew - moff;
      moff = mnew;
      make_p(sub, TagTrue{});
    } else {
      make_p(0.f, TagFalse{});
    }
    lsum += ps;
#pragma unroll
    for (int dt = 0; dt < 2; ++dt) {
#pragma unroll
      for (int k2 = 0; k2 < 2; ++k2)
#pragma unroll
        for (int s2 = 0; s2 < 2; ++s2) {
          const bf16_t* vp = vs_ + (32 * dt + r) * 72 + 32 * k2 + 16 * s2 + 4 * hh;
          const bf16x4 lo = *(const bf16x4*)vp, hi = *(const bf16x4*)(vp + 8);
          bf16x8 vf;
          vf[0] = lo[0]; vf[1] = lo[1]; vf[2] = lo[2]; vf[3] = lo[3]; vf[4] = hi[0]; vf[5] = hi[1]; vf[6] = hi[2]; vf[7] = hi[3];
          o[dt] = mfma32(vf, pb[k2][s2], o[dt]);
        }
    }
  };
  u32x4 rk0[2], rv0[2], rk1[2], rv1[2]; float rb0 = 0.f, rb1 = 0.f;
#define A_LOAD(RK, RV, RB, KT)                                                                \
  { _Pragma("unroll") for (int i = 0; i < 2; ++i) {                                           \
      RK[i] = *(const u32x4*)(Kg + (size_t)((KT) * 64 + 32 * i) * 512);                        \
      RV[i] = *(const u32x4*)(Vg + (size_t)(32 * i) * T + (KT) * 64); }                        \
    if (tid < 64) RB = -CUM[((size_t)b * T + (KT) * 64 + tid) * 8 + hd] * LOG2E; }
#define A_WRITE(RK, RV, RB, BUF)                                                              \
  { _Pragma("unroll") for (int i = 0; i < 2; ++i) {                                           \
      *(u32x4*)(Ks + (BUF) * 64 * 72 + (lrow + 32 * i) * 72 + lcc * 8) = RK[i];                \
      *(u32x4*)(Vs + (BUF) * 64 * 72 + (lrow + 32 * i) * 72 + lcc * 8) = RV[i]; }              \
    if (tid < 64) Bi[(BUF) * 64 + tid] = RB; }
#define A_COMPUTE(BUF, KT)                                                                    \
  if ((KT) * 64 <= qlast) {                                                                   \
    if ((KT) * 64 + 63 > qfirst) tile_body(Ks + (BUF) * 64 * 72, Vs + (BUF) * 64 * 72, Bi + (BUF) * 64, (KT), TagTrue{});   \
    else tile_body(Ks + (BUF) * 64 * 72, Vs + (BUF) * 64 * 72, Bi + (BUF) * 64, (KT), TagFalse{}); }
  A_LOAD(rk0, rv0, rb0, 0)
  A_WRITE(rk0, rv0, rb0, 0)
  A_LOAD(rk0, rv0, rb0, 1)
  if (nkt > 2) A_LOAD(rk1, rv1, rb1, 2)
  __syncthreads();
  for (int kt = 0; kt < nkt; kt += 2) {
    A_WRITE(rk0, rv0, rb0, 1)
    if (kt + 3 < nkt) A_LOAD(rk0, rv0, rb0, kt + 3)
    __builtin_amdgcn_sched_barrier(0);
    A_COMPUTE(0, kt)
    __syncthreads();
    if (kt + 2 < nkt) A_WRITE(rk1, rv1, rb1, 0)
    if (kt + 4 < nkt) A_LOAD(rk1, rv1, rb1, kt + 4)
    __builtin_amdgcn_sched_barrier(0);
    A_COMPUTE(1, kt + 1)
    __syncthreads();
  }
#undef A_LOAD
#undef A_WRITE
#undef A_COMPUTE
  lsum += __shfl_xor(lsum, 32);
  const float inv = 1.f / lsum;
#pragma unroll
  for (int dt = 0; dt < 2; ++dt)
#pragma unroll
    for (int g = 0; g < 4; ++g) {
      u32x2 ov; ov[0] = pack2(o[dt][4 * g] * inv, o[dt][4 * g + 1] * inv); ov[1] = pack2(o[dt][4 * g + 2] * inv, o[dt][4 * g + 3] * inv);
      *(u32x2*)(MIX + qrow * 1024 + hd * 64 + 32 * dt + 8 * g + 4 * hh) = ov;
    }
  __syncthreads();
}

DEV void attn_sample_item(const P& p, int item, unsigned char* smem) {
  const int tid = ltid(), lane = tid & 63, wave = tid >> 6;
  const int qg = item & 3, hd = (item >> 2) & 7, sb = item >> 5;
  float* cs = (float*)smem;
  float* qs = cs + 1088;
  float* ps = qs + 256;
  const float* ck = p.in[2] + (size_t)sb * 1024 * 512;
  const float* cv = p.in[3] + (size_t)sb * 1024 * 512;
  const float* clf = p.in[4] + (size_t)sb * 1024 * 8;
  const float* nk = p.out + O_FKS + (size_t)sb * 32 * 512;
  const float* nv = p.out + O_FVS + (size_t)sb * 32 * 512;
  const float* nlf = (const float*)(p.ws + R_LOGF) + (size_t)(MP + sb * 32) * 8;
  const float* QS = (const float*)(p.ws + R_QS) + (size_t)sb * 32 * 512;
  bf16_t* MIX = (bf16_t*)(p.ws + R_MIX);
  if (wave == 0) {
    float s = 0.f;
    for (int i = 0; i < 17; ++i) {
      const int j = lane * 17 + i;
      float x = 0.f;
      if (j < 1024) x = clf[(size_t)j * 8 + hd]; else if (j < 1056) x = nlf[(size_t)(j - 1024) * 8 + hd];
      s += x; cs[j] = s;
    }
    float inc = s;
#pragma unroll
    for (int o = 1; o < 64; o <<= 1) { const float tt = __shfl_up(inc, o); if (lane >= o) inc += tt; }
    const float ex = inc - s;
    for (int i = 0; i < 17; ++i) cs[lane * 17 + i] += ex;
  }
  __syncthreads();
  for (int qi = qg * 8 + wave * 2; qi < qg * 8 + wave * 2 + 2; ++qi) {
    qs[wave * 64 + lane] = QS[(size_t)qi * 512 + hd * 64 + lane];
    __syncthreads();
    const int nkeys = 1024 + qi + 1;
    const float cq = cs[1024 + qi];
    float mx = -INFINITY;
#pragma unroll 2
    for (int n = 0; n < 17; ++n) {
      const int j = lane + 64 * n;
      float sv = -INFINITY;
      if (j < nkeys) {
        const float* kr = (j < 1024) ? (ck + (size_t)j * 512 + hd * 64) : (nk + (size_t)(j - 1024) * 512 + hd * 64);
        float d = 0.f;
#pragma unroll
        for (int c4 = 0; c4 < 16; ++c4) {
          const f32x4 kk = *(const f32x4*)(kr + c4 * 4);
          const f32x4 qq = *(const f32x4*)(qs + wave * 64 + c4 * 4);
          d += kk[0] * qq[0] + kk[1] * qq[1] + kk[2] * qq[2] + kk[3] * qq[3];
        }
        sv = d * 0.125f + cq - cs[j];
      }
      ps[wave * 1088 + j] = sv; mx = fmaxf(mx, sv);
    }
    mx = wave_max(mx);
    float sum = 0.f;
    for (int n = 0; n < 17; ++n) {
      const int j = lane + 64 * n;
      const float pv = (j < nkeys) ? __expf(ps[wave * 1088 + j] - mx) : 0.f;
      sum += pv;
      ps[wave * 1088 + j] = pv;
    }
    sum = wave_sum(sum);
    __syncthreads();
    float acc0 = 0.f, acc1 = 0.f, acc2 = 0.f, acc3 = 0.f;
    const float* cvh = cv + hd * 64 + lane;
#pragma unroll 4
    for (int j = 0; j < 1024; j += 4) {
      const f32x4 pp = *(const f32x4*)(ps + wave * 1088 + j);
      acc0 += pp[0] * cvh[(size_t)(j + 0) * 512];
      acc1 += pp[1] * cvh[(size_t)(j + 1) * 512];
      acc2 += pp[2] * cvh[(size_t)(j + 2) * 512];
      acc3 += pp[3] * cvh[(size_t)(j + 3) * 512];
    }
    for (int j = 1024; j < nkeys; ++j) acc0 += ps[wave * 1088 + j] * nv[(size_t)(j - 1024) * 512 + hd * 64 + lane];
    const float acc = (acc0 + acc1) + (acc2 + acc3);
    MIX[(size_t)(MP + sb * 32 + qi) * 1024 + hd * 64 + lane] = f2bf(acc / sum);
    __syncthreads();
  }
}

DEV void gdn_gate_phase(const P& p) {
  const int tid_ = ltid();
  const int lane = tid_ & 63, wave = tid_ >> 6;
  const float* ORAW = (const float*)(p.ws + R_GB);
  bf16_t* MIX = (bf16_t*)(p.ws + R_MIX);
  const float* ng = p.in[18];
  const f32x2 g2 = *(const f32x2*)(ng + 2 * lane);
  for (int it = blockIdx.x * 4 + wave; it < M * 4; it += gridDim.x * 4) {
    const int row = it >> 2, h = it & 3;
    const f32x2 ov = *(const f32x2*)(ORAW + (size_t)row * 512 + h * 128 + 2 * lane);
    unsigned* zp = (unsigned*)(MIX + (size_t)row * 1024 + 512 + h * 128 + 2 * lane);
    const unsigned zz = *zp;
    const float z0 = bf2f((bf16_t)(zz & 0xffff)), z1 = bf2f((bf16_t)(zz >> 16));
    const float ss = wave_sum(ov[0] * ov[0] + ov[1] * ov[1]);
    const float rs = rsqrtf(ss * (1.f / 128.f) + 1e-6f);
    *zp = pack2(ov[0] * rs * g2[0] * silu_f(z0), ov[1] * rs * g2[1] * silu_f(z1));
  }
}

template <int PASS>
DEV void s5_item(const P& p, int item, unsigned char* smem) {
  const int tid = ltid(), lane = tid & 63, wave = tid >> 6;
  const int r = lane & 31, hh = lane >> 5, r16 = lane & 15, q4 = lane >> 4;
  bf16_t* HB = (bf16_t*)smem + wave * 64 * 136;
  const float* U = (const float*)(p.ws + R_U);
  bf16_t* ZZB = (bf16_t*)(p.ws + R_ZZB);
  f32x2* E = (f32x2*)(p.ws + R_E);
  const f32x2* LAMB = (const f32x2*)(p.ws + W_LAMB);
  const f32x2* LAM256 = (const f32x2*)(p.ws + W_LAM256);
  const bf16_t* Bp = (const bf16_t*)(p.ws + W_S5B);
  const bf16_t* Cp = (const bf16_t*)(p.ws + W_S5C);
  int g, seq, span, row0, nchunk, ntok; bool samp;
  if (item < 2048) { samp = false; const int gq = item & 15; span = (item >> 4) & 63; seq = item >> 10; g = gq * 4 + wave; row0 = seq * T + span * 256; nchunk = 4; ntok = 64; }
  else { samp = true; const int it = item - 2048; const int gq = it & 15; seq = it >> 4; span = 0; g = gq * 4 + wave; row0 = MP + seq * 32; nchunk = 1; ntok = 32; }
  const f32x2 lam = LAMB[g * 64 + lane];
  float hr = 0.f, hi = 0.f;
  if (PASS == 2) {
    if (samp) { hr = p.in[7][(size_t)(seq * 64 + g) * 64 + lane]; hi = p.in[8][(size_t)(seq * 64 + g) * 64 + lane]; }
    else {
      const f32x2 l256 = LAM256[g * 64 + lane];
#pragma unroll 8
      for (int j = 0; j < span; ++j) {
        const f32x2 e = E[((size_t)(seq * 64 + j) * 64 + g) * 64 + lane];
        const float nr = l256[0] * hr - l256[1] * hi + e[0];
        const float ni = l256[0] * hi + l256[1] * hr + e[1];
        hr = nr; hi = ni;
      }
    }
  }
  bf16x8 bfr[4];
#pragma unroll
  for (int nt = 0; nt < 4; ++nt) bfr[nt] = *(const bf16x8*)(Bp + ((size_t)g * 128 + nt * 32 + r) * 16 + hh * 8);
  bf16x8 cfr[4];
#pragma unroll
  for (int ks = 0; ks < 4; ++ks) cfr[ks] = *(const bf16x8*)(Cp + ((size_t)g * 16 + r16) * 128 + ks * 32 + q4 * 8);
  const float dd = p.in[28][g * 16 + r16];
  for (int ch = 0; ch < nchunk; ++ch) {
    const int rowc = row0 + ch * 64;
#pragma unroll
    for (int mt = 0; mt < 2; ++mt) {
      bf16x8 uf;
      if (mt * 32 < ntok) {
        const float* up = U + (size_t)(rowc + mt * 32 + r) * D + g * 16 + hh * 8;
        const f32x4 u0 = *(const f32x4*)up, u1 = *(const f32x4*)(up + 4);
        uf[0] = (short)f2bf(u0[0]); uf[1] = (short)f2bf(u0[1]); uf[2] = (short)f2bf(u0[2]); uf[3] = (short)f2bf(u0[3]);
        uf[4] = (short)f2bf(u1[0]); uf[5] = (short)f2bf(u1[1]); uf[6] = (short)f2bf(u1[2]); uf[7] = (short)f2bf(u1[3]);
      } else {
#pragma unroll
        for (int j = 0; j < 8; ++j) uf[j] = 0;
      }
#pragma unroll
      for (int nt = 0; nt < 4; ++nt) {
        f32x16 acc;
#pragma unroll
        for (int q = 0; q < 16; ++q) acc[q] = 0.f;
        acc = mfma32(uf, bfr[nt], acc);
#pragma unroll
        for (int q = 0; q < 16; ++q) HB[(mt * 32 + (q & 3) + 8 * (q >> 2) + 4 * hh) * 136 + nt * 32 + r] = f2bf(acc[q]);
      }
    }
    __syncthreads();
    for (int t = 0; t < ntok; ++t) {
      const float br = bf2f(HB[t * 136 + lane]), bi = bf2f(HB[t * 136 + 64 + lane]);
      const float nr = lam[0] * hr - lam[1] * hi + br;
      const float ni = lam[0] * hi + lam[1] * hr + bi;
      hr = nr; hi = ni;
      if (PASS == 2) { HB[t * 136 + lane] = f2bf(hr); HB[t * 136 + 64 + lane] = f2bf(hi); }
    }
    __syncthreads();
    if (PASS == 2) {
#pragma unroll
      for (int m4 = 0; m4 < 4; ++m4) {
        if (m4 * 16 < ntok) {
          f32x4 y = {0.f, 0.f, 0.f, 0.f};
#pragma unroll
          for (int ks = 0; ks < 4; ++ks) {
            const bf16x8 hf = *(const bf16x8*)(HB + (m4 * 16 + r16) * 136 + ks * 32 + q4 * 8);
            y = mfma16(hf, cfr[ks], y);
          }
#pragma unroll
          for (int e = 0; e < 4; ++e) {
            const size_t idx = (size_t)(rowc + m4 * 16 + q4 * 4 + e) * D + g * 16 + r16;
            const float yy = y[e] + dd * U[idx];
            ZZB[idx] = f2bf(gelu_tanh(yy));
          }
        }
      }
      __syncthreads();
    }
  }
  if (PASS == 1) E[((size_t)(seq * 64 + span) * 64 + g) * 64 + lane] = (f32x2){hr, hi};
  else {
    if (samp) { p.out[O_S5RS + (size_t)(seq * 64 + g) * 64 + lane] = hr; p.out[O_S5IS + (size_t)(seq * 64 + g) * 64 + lane] = hi; }
    else if (span == 63) { p.out[O_S5RP + (size_t)(seq * 64 + g) * 64 + lane] = hr; p.out[O_S5IP + (size_t)(seq * 64 + g) * 64 + lane] = hi; }
  }
}

DEV void gsync(unsigned* bar, unsigned& epoch) {
  epoch += 1;
  asm volatile("s_waitcnt vmcnt(0) lgkmcnt(0)" ::: "memory");
  __syncthreads();
  if (threadIdx.x == 0) {
    __builtin_amdgcn_fence(__ATOMIC_RELEASE, "agent");
    const unsigned g = blockIdx.x & 7, nbg = gridDim.x >> 3;
    const unsigned old = __hip_atomic_fetch_add(bar + 32 * (1 + g), 1u, __ATOMIC_RELAXED, __HIP_MEMORY_SCOPE_AGENT);
    if (old + 1 == epoch * nbg) __hip_atomic_fetch_add(bar, 1u, __ATOMIC_RELAXED, __HIP_MEMORY_SCOPE_AGENT);
    while (__hip_atomic_load(bar, __ATOMIC_RELAXED, __HIP_MEMORY_SCOPE_AGENT) < epoch * 8u) __builtin_amdgcn_s_sleep(1);
    __builtin_amdgcn_fence(__ATOMIC_ACQUIRE, "agent");
    asm volatile("s_waitcnt vmcnt(0) lgkmcnt(0)" ::: "memory");
  }
  __syncthreads();
}
#ifndef MINW
#define MINW 2
#endif
__global__ void __launch_bounds__(256, MINW) fwd_mega(P p) {
  extern __shared__ __attribute__((aligned(16))) unsigned char smem[];
  cg::grid_group grid = cg::this_grid();
  const int tid = threadIdx.x;
  float* X = p.out + O_Y;
  bf16_t* Xb = (bf16_t*)(p.ws + A_XB);
  bf16_t* ACT = (bf16_t*)(p.ws + R_ACT);

#ifndef NO_P0
  unsigned* bar = (unsigned*)(p.ws + W_CTR + 1024);
  unsigned epoch = 0;
  phase0(p, smem);
#endif
  grid.sync();
  gsync(bar, epoch);

#pragma unroll 1
  for (int layer = 0; layer < 2; ++layer) {
#pragma unroll 1
    for (int f = 0; f < 2; ++f) {
      if (f == 1) {
        if (layer == 0) {
#ifndef NO_EVENIN
          gemm_phase(Xb, 1024, (const bf16_t*)(p.ws + W_EVEN_IN), 1024, 29, EpiEvenIn{p}, smem);
#endif
          gsync(bar, epoch);
#ifndef NO_CUM
          if (blockIdx.x < 2) cumsum_prompt(p, blockIdx.x, smem);
#endif
#ifndef NO_PREP
          for (int it = blockIdx.x; it < NPREP; it += gridDim.x) gdn_prep_item(p, it, smem);
#endif
          gsync(bar, epoch);
          {
            unsigned* ctr = (unsigned*)(p.ws + W_CTR);
            int* sh = (int*)(smem + LDS_BYTES - 16);
            for (;;) {
              if (tid == 0) *sh = (int)atomicAdd(ctr, 1u);
              __syncthreads();
              const int it = *sh;
              __syncthreads();
              if (it >= 64 + 256 + 256) break;
              if (it < 64) gdn_scan_chain(p, it, smem);
              else if (it < 64 + 256) attn_sample_item(p, it - 64, smem);
              else gdn_scan_chain(p, 64 + (it - 64 - 256), smem);
            }
            for (int sx = 0; sx < 8; ++sx) {
              const int x = ((blockIdx.x & 7) + sx) & 7;
              for (;;) {
                if (tid == 0) *sh = (int)atomicAdd(ctr + 8 + x, 1u);
                __syncthreads();
                const int it = *sh;
                __syncthreads();
                if (it >= 256) break;
                attn_prompt_item(p, 2 * x + (it & 1), 127 - (it >> 1), smem);
              }
            }
          }
          gsync(bar, epoch);
          gdn_gate_phase(p);
          gsync(bar, epoch);
          gemm_phase((const bf16_t*)(p.ws + R_MIX), 1024, (const bf16_t*)(p.ws + W_EVEN_OUT), 1024, 8, EpiElem<FResidX>{FResidX{X, Xb, 1.0f}}, smem);
          gsync(bar, epoch);
        } else {
          gemm_phase(Xb, 1024, (const bf16_t*)(p.ws + W_ODD_IN), 1024, 8, EpiElem<FStoreF32>{FStoreF32{(float*)(p.ws + R_U)}}, smem);
          gsync(bar, epoch);
#ifndef NO_S5
          for (int it = blockIdx.x; it < 2048; it += gridDim.x) if (((it >> 4) & 63) != 63) s5_item<1>(p, it, smem);
#endif
          gsync(bar, epoch);
#ifndef NO_S5
          for (int it = blockIdx.x; it < 2048 + 128; it += gridDim.x) s5_item<2>(p, it, smem);
#endif
          gsync(bar, epoch);
          gemm_phase((const bf16_t*)(p.ws + R_ZZB), 1024, (const bf16_t*)(p.ws + W_GLU), 1024, 8,
                     EpiElem<FGlu>{FGlu{(const bf16_t*)(p.ws + R_ZZB), p.in[30], (bf16_t*)(p.ws + A_GATED)}}, smem);
          gsync(bar, epoch);
          gemm_phase((const bf16_t*)(p.ws + A_GATED), 1024, (const bf16_t*)(p.ws + W_ODD_OUT), 1024, 8, EpiElem<FResid>{FResid{Xb, 1.0f}}, smem);
          gsync(bar, epoch);
        }
        ln_phase(X, Xb, p.in[11] + (layer * 3 + 1) * D, p.in[12] + (layer * 3 + 1) * D, true, false);
        gsync(bar, epoch);
      }
      const int idx = layer * 2 + f;
      gemm_phase(Xb, 1024, (const bf16_t*)(p.ws + W_FFN_IN + idx * SZ_FFN_IN), 1024, 44, EpiSwiglu{ACT}, smem);
      gsync(bar, epoch);
      gemm_phase(ACT, DFF, (const bf16_t*)(p.ws + W_FFN_OUT + idx * SZ_FFN_OUT), DFF, 8, EpiElem<FResid>{FResid{Xb, 0.5f}}, smem);
      gsync(bar, epoch);
      const bool last = (layer == 1 && f == 1);
      ln_phase(X, Xb, p.in[11] + (layer * 3 + f * 2) * D, p.in[12] + (layer * 3 + f * 2) * D, !last, last || (layer == 0 && f == 0));
      if (!last) gsync(bar, epoch);
    }
  }
}

extern "C" void kernel_launch(void* const* d_in, const int* in_sizes, int n_in, void* d_out, int out_size, void* d_ws, size_t ws_size,
                              hipStream_t stream) {
  static int grid_blocks = 0;
  if (grid_blocks == 0) {
    int dev = 0, cus = 0, per_cu = 0;
    (void)hipGetDevice(&dev);
    (void)hipDeviceGetAttribute(&cus, hipDeviceAttributeMultiprocessorCount, dev);
    if (hipFuncSetAttribute((const void*)fwd_mega, hipFuncAttributeMaxDynamicSharedMemorySize, LDS_BYTES) != hipSuccess) {
      fprintf(stderr, "hipFuncSetAttribute failed\n");
    }
    (void)hipOccupancyMaxActiveBlocksPerMultiprocessor(&per_cu, (const void*)fwd_mega, 256, LDS_BYTES);
    if (per_cu < 1) per_cu = 1;
    if (per_cu > MINW) per_cu = MINW;
    grid_blocks = cus * per_cu;
    if (ws_size < WS_NEED) fprintf(stderr, "workspace too small: %zu < %zu\n", ws_size, (size_t)WS_NEED);
  }
  P p{};
  for (int i = 0; i < 32; ++i) p.in[i] = (const float*)d_in[i];
  p.out = (float*)d_out;
  p.ws = (unsigned char*)d_ws;
  (void)hipMemsetAsync((unsigned char*)d_ws + W_CTR + 1024, 0, 2048, stream);
  void* args[] = {&p};
  hipError_t e = hipLaunchCooperativeKernel((const void*)fwd_mega, dim3(grid_blocks), dim3(256), args, LDS_BYTES, stream);
  if (e != hipSuccess) fprintf(stderr, "cooperative launch failed: %s (grid %d)\n", hipGetErrorString(e), grid_blocks);
}
```
